# Optimizing an MI355X kernel written in HIP

```python
import jax
import jax.numpy as jnp
from jax import lax
import numpy as np

D_MODEL = 2048
BATCH = 8
SEQ = 2048
DEPTH = 2

N_A_LAYERS = DEPTH // 2
N_B_LAYERS = DEPTH - N_A_LAYERS
NORM_EPS = 1e-6

GDN_HEAD_DIM = 128
GDN_K_HEADS = D_MODEL // 128
GDN_V_HEADS = 2 * GDN_K_HEADS
GDN_KDIM = GDN_K_HEADS * GDN_HEAD_DIM
GDN_VDIM = GDN_V_HEADS * GDN_HEAD_DIM
GDN_CONV_CH = 2 * GDN_KDIM + GDN_VDIM
GDN_IN_DIM = GDN_CONV_CH + GDN_VDIM + 2 * GDN_V_HEADS
GDN_CONV = 4
GDN_CHUNK = 64

SB_HEAD_DIM = 128
SB_HEADS = D_MODEL // 128
SB_DIM = SB_HEADS * SB_HEAD_DIM
SB_BLOCK = 128

MOE_GROUPS = 4
MOE_EXPERTS_PER_GROUP = 8
MOE_EXPERTS = MOE_GROUPS * MOE_EXPERTS_PER_GROUP
MOE_TOP_K = 2
MOE_HIDDEN = 3 * D_MODEL // 8
MOE_BLOCK = 128

kernel_name = 'yoco_gdn_stickbreak_hmoe'


def rms_norm(x, gain):
    xf = x.astype(jnp.float32)
    y = xf * lax.rsqrt(jnp.mean(xf * xf, axis=-1, keepdims=True) + NORM_EPS)
    return (y * gain.astype(jnp.float32)).astype(x.dtype)


def l2_norm(x):
    return x * lax.rsqrt(jnp.sum(x * x, axis=-1, keepdims=True) + NORM_EPS)


def causal_depthwise_conv(x, w):
    taps, seq = w.shape[0], x.shape[1]
    xp = jnp.pad(x, ((0, 0), (taps - 1, 0), (0, 0)))
    y = xp[:, 0:seq] * w[0]
    for j in range(1, taps):
        y = y + xp[:, j:j + seq] * w[j]
    return y


def chunk_gated_delta_rule(q, k, v, g, beta):
    b, h, s, dk = q.shape
    dv = v.shape[-1]
    n, c = s // GDN_CHUNK, GDN_CHUNK
    q = (q * dk ** -0.5).reshape(b, h, n, c, dk)
    k = k.reshape(b, h, n, c, dk)
    v = v.reshape(b, h, n, c, dv)
    beta = beta.reshape(b, h, n, c)
    g = jnp.cumsum(g.reshape(b, h, n, c), axis=-1)
    incl = jnp.tril(jnp.ones((c, c), dtype=bool))
    strict = jnp.tril(jnp.ones((c, c), dtype=bool), -1)
    diff = g[..., :, None] - g[..., None, :]
    decay = jnp.where(incl, jnp.exp(jnp.where(incl, diff, 0.0)), 0.0)
    k_beta = k * beta[..., None]
    lower = jnp.where(strict, jnp.einsum('bhnid,bhnjd->bhnij', k_beta, k) * decay, 0.0)
    eye = jnp.broadcast_to(jnp.eye(c, dtype=q.dtype), lower.shape)
    t_inv = lax.linalg.triangular_solve(eye + lower, eye, left_side=True, lower=True, unit_diagonal=True)
    u = jnp.einsum('bhnij,bhnjv->bhniv', t_inv, v * beta[..., None])
    w = jnp.einsum('bhnij,bhnjd->bhnid', t_inv, k_beta * jnp.exp(g)[..., None])
    intra = jnp.where(incl, jnp.einsum('bhnid,bhnjd->bhnij', q, k) * decay, 0.0)

    def step(state, inp):
        q_c, k_c, u_c, w_c, a_c, g_c = inp
        v_new = u_c - jnp.einsum('bhcd,bhdv->bhcv', w_c, state)
        o_c = (jnp.einsum('bhcd,bhdv->bhcv', q_c * jnp.exp(g_c)[..., None], state)
               + jnp.einsum('bhcj,bhjv->bhcv', a_c, v_new))
        g_last = g_c[..., -1:]
        k_dec = k_c * jnp.exp(g_last - g_c)[..., None]
        state = state * jnp.exp(g_last)[..., None] + jnp.einsum('bhcd,bhcv->bhdv', k_dec, v_new)
        return state, o_c

    chunk_first = lambda t: jnp.moveaxis(t, 2, 0)
    state0 = jnp.zeros((b, h, dk, dv), q.dtype)
    _, o = lax.scan(step, state0, (chunk_first(q), chunk_first(k), chunk_first(u),
                                   chunk_first(w), chunk_first(intra), chunk_first(g)))
    return jnp.moveaxis(o, 0, 2).reshape(b, h, s, dv)


def gated_deltanet(h, w_in, conv_w, a_log, dt_bias, out_gain, w_out):
    b, s, _ = h.shape
    proj = h @ w_in
    qkv, z, beta_logit, a = jnp.split(
        proj, [GDN_CONV_CH, GDN_CONV_CH + GDN_VDIM, GDN_CONV_CH + GDN_VDIM + GDN_V_HEADS], axis=-1)
    qkv = jax.nn.silu(causal_depthwise_conv(qkv, conv_w)).astype(jnp.float32)
    q, k, v = jnp.split(qkv, [GDN_KDIM, 2 * GDN_KDIM], axis=-1)
    rep = GDN_V_HEADS // GDN_K_HEADS
    q = jnp.repeat(l2_norm(q.reshape(b, s, GDN_K_HEADS, GDN_HEAD_DIM)), rep, axis=2)
    k = jnp.repeat(l2_norm(k.reshape(b, s, GDN_K_HEADS, GDN_HEAD_DIM)), rep, axis=2)
    v = v.reshape(b, s, GDN_V_HEADS, GDN_HEAD_DIM)
    beta = jax.nn.sigmoid(beta_logit.astype(jnp.float32))
    g = -jnp.exp(a_log.astype(jnp.float32)) * jax.nn.softplus(
        a.astype(jnp.float32) + dt_bias.astype(jnp.float32))
    heads_first = lambda t: jnp.swapaxes(t, 1, 2)
    o = chunk_gated_delta_rule(heads_first(q), heads_first(k), heads_first(v),
                               heads_first(g), heads_first(beta))
    o = jnp.swapaxes(o, 1, 2)
    gate = jax.nn.silu(z.astype(jnp.float32)).reshape(b, s, GDN_V_HEADS, GDN_HEAD_DIM)
    o = rms_norm(o, out_gain) * gate
    return o.reshape(b, s, GDN_VDIM).astype(h.dtype) @ w_out


def shared_kv(h, norm_gain, w_kv, k_gain):
    b, s, _ = h.shape
    kv = rms_norm(h, norm_gain) @ w_kv
    k, v = jnp.split(kv, 2, axis=-1)
    k = rms_norm(k.reshape(b, s, SB_HEADS, SB_HEAD_DIM), k_gain)
    v = v.reshape(b, s, SB_HEADS, SB_HEAD_DIM)
    return jnp.swapaxes(k, 1, 2).astype(jnp.float32), jnp.swapaxes(v, 1, 2).astype(jnp.float32)


def stick_breaking_attention(q, k, v):
    s = q.shape[2]
    scale = q.shape[-1] ** -0.5
    outs = []
    for blk in range(s // SB_BLOCK):
        q0 = blk * SB_BLOCK
        q1 = q0 + SB_BLOCK
        kb, vb = k[:, :, :q1], v[:, :, :q1]
        z = jnp.einsum('bhqd,bhkd->bhqk', q[:, :, q0:q1], kb) * scale
        causal = jnp.arange(q1)[None, :] < (q0 + jnp.arange(SB_BLOCK))[:, None]
        log_fail = jnp.where(causal, -jax.nn.softplus(z), 0.0)
        later = lax.cumsum(log_fail, axis=3, reverse=True) - log_fail
        weight = jnp.where(causal, jnp.exp(jax.nn.log_sigmoid(z) + later), 0.0)
        outs.append(jnp.einsum('bhqk,bhkd->bhqd', weight, vb))
    return jnp.concatenate(outs, axis=2)


def stick_breaking_layer(h, w_q, q_gain, k, v, w_out):
    b, s, _ = h.shape
    q = rms_norm((h @ w_q).reshape(b, s, SB_HEADS, SB_HEAD_DIM), q_gain)
    q = jnp.swapaxes(q, 1, 2).astype(jnp.float32)
    o = stick_breaking_attention(q, k, v)
    o = jnp.swapaxes(o, 1, 2).reshape(b, s, SB_DIM).astype(h.dtype)
    return o @ w_out


def hierarchical_moe(h, w_rg, b_rg, w_re, b_re, w_gate, w_up, w_down):
    b, s, d = h.shape
    t = b * s
    xt = h.reshape(t, d)
    p_group = jax.nn.softmax((xt @ w_rg).astype(jnp.float32) + b_rg.astype(jnp.float32), axis=-1)
    g_val, g_idx = lax.top_k(p_group, 1)
    logits_e = ((xt @ w_re).astype(jnp.float32) + b_re.astype(jnp.float32)).reshape(
        t, MOE_GROUPS, MOE_EXPERTS_PER_GROUP)
    logits_sel = logits_e[jnp.arange(t), g_idx[:, 0]]
    e_val, e_idx = lax.top_k(jax.nn.softmax(logits_sel, axis=-1), MOE_TOP_K)
    gate = g_val * e_val / jnp.sum(e_val, axis=-1, keepdims=True)
    eid = (g_idx * MOE_EXPERTS_PER_GROUP + e_idx).reshape(-1)
    tok = jnp.repeat(jnp.arange(t, dtype=jnp.int32), MOE_TOP_K)
    wts = gate.reshape(-1)
    n_assign = t * MOE_TOP_K
    order = jnp.argsort(eid)
    eid_s, tok_s, wts_s = eid[order], tok[order], wts[order]
    counts = jnp.bincount(eid, length=MOE_EXPERTS)
    padded = (counts + MOE_BLOCK - 1) // MOE_BLOCK * MOE_BLOCK
    pad_end = jnp.cumsum(padded)
    pad_start = pad_end - padded
    start = jnp.cumsum(counts) - counts
    dest = pad_start[eid_s] + jnp.arange(n_assign, dtype=jnp.int32) - start[eid_s]
    n_blocks = -(-n_assign // MOE_BLOCK) + MOE_EXPERTS
    n_slots = n_blocks * MOE_BLOCK
    slot_tok = jnp.full((n_slots,), t, dtype=jnp.int32).at[dest].set(tok_s)
    x_ext = jnp.concatenate([xt, jnp.zeros((1, d), xt.dtype)], axis=0)
    xs = x_ext[slot_tok].reshape(n_blocks, MOE_BLOCK, d)
    blk_expert = jnp.minimum(
        jnp.searchsorted(pad_end, jnp.arange(n_blocks) * MOE_BLOCK, side='right'), MOE_EXPERTS - 1)

    def run_block(args):
        xb, e = args
        hb = jax.nn.silu(xb @ w_gate[e]) * (xb @ w_up[e])
        return hb @ w_down[e]

    ys = lax.map(run_block, (xs, blk_expert)).reshape(n_slots, d)
    contrib = ys[dest] * wts_s[:, None].astype(ys.dtype)
    out = jnp.zeros((t, d), ys.dtype).at[tok_s].add(contrib)
    return out.reshape(b, s, d)


def setup_inputs(seed: int = 0) -> dict:
    key = jax.random.key(seed)
    ks = jax.random.split(key, 23)
    d = D_MODEL
    nrm = lambda k, shape, scale: jax.random.normal(k, shape, jnp.float32) * scale
    gain = lambda k, shape: 1.0 + 0.02 * jax.random.normal(k, shape, jnp.float32)
    return {
        'x': nrm(ks[0], (BATCH, SEQ, d), 1.0),
        'norm_a': gain(ks[1], (N_A_LAYERS, d)),
        'w_in_a': nrm(ks[2], (N_A_LAYERS, d, GDN_IN_DIM), d ** -0.5),
        'conv_a': nrm(ks[3], (N_A_LAYERS, GDN_CONV, GDN_CONV_CH), GDN_CONV ** -0.5),
        'a_log_a': jnp.log(jax.random.uniform(ks[4], (N_A_LAYERS, GDN_V_HEADS), jnp.float32, 1.0, 16.0)),
        'dt_bias_a': nrm(ks[5], (N_A_LAYERS, GDN_V_HEADS), 0.1),
        'out_norm_a': gain(ks[6], (N_A_LAYERS, GDN_HEAD_DIM)),
        'w_out_a': nrm(ks[7], (N_A_LAYERS, GDN_VDIM, d), GDN_VDIM ** -0.5),
        'norm_kv': gain(ks[8], (d,)),
        'w_kv': nrm(ks[9], (d, 2 * SB_DIM), d ** -0.5),
        'k_norm_b': gain(ks[10], (SB_HEAD_DIM,)),
        'norm_b': gain(ks[11], (N_B_LAYERS, d)),
        'w_q_b': nrm(ks[12], (N_B_LAYERS, d, SB_DIM), d ** -0.5),
        'q_norm_b': gain(ks[13], (N_B_LAYERS, SB_HEAD_DIM)),
        'w_out_b': nrm(ks[14], (N_B_LAYERS, SB_DIM, d), SB_DIM ** -0.5),
        'norm_moe': gain(ks[15], (DEPTH, d)),
        'w_router_group': nrm(ks[16], (DEPTH, d, MOE_GROUPS), d ** -0.5),
        'b_router_group': nrm(ks[17], (DEPTH, MOE_GROUPS), 0.01),
        'w_router_expert': nrm(ks[18], (DEPTH, d, MOE_EXPERTS), d ** -0.5),
        'b_router_expert': nrm(ks[19], (DEPTH, MOE_EXPERTS), 0.01),
        'w_gate': nrm(ks[20], (DEPTH, MOE_EXPERTS, d, MOE_HIDDEN), d ** -0.5),
        'w_up': nrm(ks[21], (DEPTH, MOE_EXPERTS, d, MOE_HIDDEN), d ** -0.5),
        'w_down': nrm(ks[22], (DEPTH, MOE_EXPERTS, MOE_HIDDEN, d), MOE_HIDDEN ** -0.5),
    }


def reference(x, norm_a, w_in_a, conv_a, a_log_a, dt_bias_a, out_norm_a, w_out_a,
              norm_kv, w_kv, k_norm_b, norm_b, w_q_b, q_norm_b, w_out_b,
              norm_moe, w_router_group, b_router_group, w_router_expert, b_router_expert,
              w_gate, w_up, w_down):
    h = x
    k_shared = None
    v_shared = None
    for layer in range(DEPTH):
        if layer < N_A_LAYERS:
            i = layer
            h = h + gated_deltanet(rms_norm(h, norm_a[i]), w_in_a[i], conv_a[i], a_log_a[i],
                                   dt_bias_a[i], out_norm_a[i], w_out_a[i])
        else:
            i = layer - N_A_LAYERS
            if i == 0:
                k_shared, v_shared = shared_kv(h, norm_kv, w_kv, k_norm_b)
            h = h + stick_breaking_layer(rms_norm(h, norm_b[i]), w_q_b[i], q_norm_b[i],
                                         k_shared, v_shared, w_out_b[i])
        h = h + hierarchical_moe(rms_norm(h, norm_moe[layer]), w_router_group[layer],
                                 b_router_group[layer], w_router_expert[layer],
                                 b_router_expert[layer], w_gate[layer], w_up[layer], w_down[layer])
    return h
```

```cpp
#include <hip/hip_runtime.h>
#include <cstdio>

#ifndef MK_ONE_LAUNCH
#define MK_ONE_LAUNCH 1
#endif
#ifndef MK_REP_PHASE
#define MK_REP_PHASE -1
#endif
#ifndef MK_LAST_PHASE
#define MK_LAST_PHASE 18
#endif

#define GAS __attribute__((address_space(1)))
#define LAS __attribute__((address_space(3)))
typedef unsigned short bf16_t;
typedef short bf16x8 __attribute__((ext_vector_type(8)));
typedef float f32x4 __attribute__((ext_vector_type(4)));
typedef float f32x2 __attribute__((ext_vector_type(2)));
typedef unsigned u32x4 __attribute__((ext_vector_type(4)));
typedef unsigned u32x2 __attribute__((ext_vector_type(2)));

constexpr int D = 2048, BATCH = 8, SEQ = 2048, T = BATCH * SEQ;
constexpr int HD = 128;
constexpr int GKH = 16, GVH = 32, GKDIM = 2048, GVDIM = 4096, GCONV = 8192, GIN = 12352, GIN_PAD = 12544;
constexpr int SBH = 16, SBDIM = 2048, KVQ = 6144;
constexpr int NGRP = 4, EPG = 8, NE = 32, HID = 768;
constexpr float EPS = 1e-6f;
constexpr int MAXSLOTS = T * 2 + NE * 256;

constexpr size_t MiB = 1u << 20;
constexpr size_t WS_CTL = 0, CTL_ZERO_BYTES = 1 * MiB;
constexpr size_t WS_MISC = 1 * MiB;
constexpr size_t WS_WIN = 2 * MiB, WS_WOUTA = 51 * MiB, WS_WKVQ = 67 * MiB, WS_WOUTB = 91 * MiB, WS_WGU = 99 * MiB, WS_WD = 483 * MiB;
constexpr size_t WS_XN = 675 * MiB, WS_OG = 739 * MiB, WS_BIG = 867 * MiB, WS_WR = 1259 * MiB, WS_END = 1260 * MiB;
constexpr int WRN = 48;
constexpr size_t WS_XS = WS_BIG, WS_HB = WS_BIG + 160 * MiB, WS_YS = WS_BIG + 220 * MiB;
constexpr size_t WS_KVQ = WS_BIG, WS_AO = WS_BIG + 192 * MiB;
static_assert((size_t)GIN_PAD * D * 2 <= 49 * MiB && (size_t)T * GIN_PAD * 2 <= 392 * MiB, "map");
static_assert((size_t)MAXSLOTS * D * 2 <= 160 * MiB && (size_t)MAXSLOTS * HID * 2 <= 60 * MiB, "map");
constexpr size_t MI_BLKCNT = 0, MI_PADSTART = 32768, MI_TOKE = 65536, MI_TOKW = 65536 + 131072, MI_TOKSLOT = 65536 + 262144;
constexpr int CW_BAR = 4096, CW_TICKET = 64;

constexpr int RING_BYTES = 131072;
constexpr int LDS_BYTES = 163840;
constexpr int LDSCTL_OFF = LDS_BYTES - 1024;

#define LDS_WAIT() asm volatile("s_waitcnt lgkmcnt(0)" ::: "memory")
#define VM_WAIT() asm volatile("s_waitcnt vmcnt(0)" ::: "memory")
__device__ __forceinline__ float bf2f(unsigned b) { return __uint_as_float(b << 16); }
__device__ __forceinline__ unsigned f2bf(float f) { unsigned u = __float_as_uint(f); return (u + 0x7fffu + ((u >> 16) & 1u)) >> 16; }
typedef __bf16 bf16v2_t __attribute__((ext_vector_type(2)));
__device__ __forceinline__ unsigned pk2(float lo, float hi) { bf16v2_t v = __builtin_convertvector((f32x2){lo, hi}, bf16v2_t); return __builtin_bit_cast(unsigned, v); }
__device__ __forceinline__ float wave_sum(float v) {
#pragma unroll
    for (int o = 1; o < 64; o <<= 1) v += __shfl_xor(v, o);
    return v;
}
__device__ __forceinline__ float silu_f(float x) { return x * __builtin_amdgcn_rcpf(1.0f + __builtin_amdgcn_exp2f(-1.4426950408889634f * x)); }
__device__ __forceinline__ float sigmoid_f(float x) { return __builtin_amdgcn_rcpf(1.0f + __builtin_amdgcn_exp2f(-1.4426950408889634f * x)); }
__device__ __forceinline__ float softplus_f(float x) { return fmaxf(x, 0.f) + __logf(1.0f + __expf(-fabsf(x))); }

#define XB_TMO      128
#define XB_XCNT(j)  (256  + 64 * (j))
#define XB_XSUB(j)  (1280 + 64 * (j))
#define XB_XGEN(j)  (2304 + 64 * (j))
#define XB_TOP      3328
#define XB_TOPGEN   3392
#define XCD_BAR_WORDS 3456
#define XB_SPIN_CAP (1u << 20)
__device__ __forceinline__ unsigned xb_ld(unsigned* p)              { return __hip_atomic_load(p, __ATOMIC_RELAXED, __HIP_MEMORY_SCOPE_AGENT); }
__device__ __forceinline__ unsigned xb_add(unsigned* p, unsigned v) { return __hip_atomic_fetch_add(p, v, __ATOMIC_RELAXED, __HIP_MEMORY_SCOPE_AGENT); }
__device__ __forceinline__ unsigned xb_xcc_id() { return (unsigned)__builtin_amdgcn_s_getreg((3 << 11) | 20) & 0xFu; }
#define XB_SPIN(cond, bar) do { unsigned _sp = 0; while (cond) { __builtin_amdgcn_s_sleep(1); \
    if ((++_sp & 255u) == 0u) { if (xb_ld(&(bar)[XB_TMO])) break; if (_sp > XB_SPIN_CAP) { atomicAdd(&(bar)[XB_TMO], 1u); break; } } } } while (0)
struct XcdBarrier { unsigned* bar; unsigned x; volatile LAS unsigned* st; };
__device__ __forceinline__ XcdBarrier xcd_barrier_post(unsigned* bar, volatile LAS unsigned* st) {
    XcdBarrier b; b.bar = bar; b.x = xb_xcc_id(); b.st = st;
    if (threadIdx.x == 0) (void)xb_add(&bar[XB_XCNT(b.x)], 1u);
    return b;
}
__device__ __forceinline__ void xcd_barrier_complete(unsigned* bar, unsigned x, unsigned& nloc, unsigned& nx) {
    const unsigned G = gridDim.x * gridDim.y * gridDim.z;
    unsigned sum, cnt, mine, sp = 0u;
    for (;;) {
        sum = 0u; cnt = 0u; mine = 0u;
#pragma unroll
        for (unsigned j = 0; j < 16; ++j) { const unsigned c = xb_ld(&bar[XB_XCNT(j)]); sum += c; cnt += (c > 0u) ? 1u : 0u; mine = (j == x) ? c : mine; }
        if (sum == G) break;
        __builtin_amdgcn_s_sleep(1);
        if ((++sp & 255u) == 0u) { if (xb_ld(&bar[XB_TMO])) break; if (sp > XB_SPIN_CAP) { atomicAdd(&bar[XB_TMO], 1u); break; } }
    }
    nloc = mine > 0u ? mine : 1u; nx = cnt > 0u ? cnt : 1u;
}
__device__ __forceinline__ void xcd_barrier(const XcdBarrier& b) {
    asm volatile("s_waitcnt vmcnt(0)" ::: "memory");
    __syncthreads();
    if (threadIdx.x == 0) {
        unsigned* bar = b.bar;
        __builtin_amdgcn_s_waitcnt(0);
        unsigned nloc = b.st[0], nx = b.st[1];
        if (nloc == 0u) { xcd_barrier_complete(bar, b.x, nloc, nx); b.st[0] = nloc; b.st[1] = nx; }
        const unsigned old = xb_add(&bar[XB_XSUB(b.x)], 1u);
        const unsigned gen = old / nloc;
        if (old + 1u == (gen + 1u) * nloc) {
            __builtin_amdgcn_fence(__ATOMIC_RELEASE, "agent");
            asm volatile("s_waitcnt vmcnt(0)" ::: "memory");
            const unsigned og = xb_add(&bar[XB_TOP], 1u);
            const unsigned tg = og / nx;
            if (og + 1u == (tg + 1u) * nx) xb_add(&bar[XB_TOPGEN], 1u);
            else XB_SPIN(xb_ld(&bar[XB_TOPGEN]) == tg, bar);
            __builtin_amdgcn_fence(__ATOMIC_ACQUIRE, "agent");
            xb_add(&bar[XB_XGEN(b.x)], 1u);
            asm volatile("s_waitcnt vmcnt(0)" ::: "memory");
        } else {
            XB_SPIN(xb_ld(&bar[XB_XGEN(b.x)]) == gen, bar);
            __builtin_amdgcn_fence(__ATOMIC_ACQUIRE, "agent");
            asm volatile("s_waitcnt vmcnt(0)" ::: "memory");
        }
    }
    __syncthreads();
}

namespace pg8 {
constexpr int BM = 256, BK = 64, HALF = 128, HTB = HALF * BK * 2, STAGE_BYTES = 8 * HTB, NXCD = 8, WGM = 8;
__host__ __device__ __forceinline__ int lds_byte(int r, int c) { const int st = (r >> 4) * 2 + (c >> 5), rr = r & 15, cc = c & 31, ob = rr * 64 + cc * 2; return st * 1024 + (ob ^ (((ob >> 9) & 1) << 5)); }
__host__ __device__ __forceinline__ void stage_rc(int b, int& R, int& C) { const int st = b / 1024, sb = b % 1024, swz = sb ^ (((sb >> 9) & 1) << 5); R = (st >> 1) * 16 + swz / 64; C = (st & 1) * 32 + (swz % 64) / 2; }
__host__ __device__ __forceinline__ int perm32(int rho) { const int n = rho >> 4, i = rho & 15; return 8 * (i >> 2) + 4 * n + (i & 3); }

struct Unit { int pm, pn, pb; };
struct Gemm { const bf16_t* A; const bf16_t* Bt; int K; };

struct StaticOrder {
    int nM, nN, nwg, G, c;
    __device__ void init(int M, int N, int G_, int c_) { nM = M / BM; nN = N / BM; nwg = nM * nN; G = G_; c = c_; }
    __device__ bool next(int i, Unit& u) const {
        const long L = (long)i * G + c; if (L >= nwg) return false;
        int wgid = (int)L; { const int q = nwg / NXCD, r = nwg % NXCD, xcd = wgid % NXCD, off = wgid / NXCD; wgid = (xcd < r ? xcd * (q + 1) : r * (q + 1) + (xcd - r) * q) + off; }
        const int nig = WGM * nN, gid = wgid / nig, fm = gid * WGM, gsz = (nM - fm) < WGM ? (nM - fm) : WGM;
        u.pm = fm + ((wgid % nig) % gsz); u.pn = (wgid % nig) / gsz; u.pb = u.pn; return true;
    }
};
struct ListOrder {
    int n, d0, d1, d2, d3, d4, d5, d6, d7;
    __device__ bool next(int i, Unit& u) const {
        if (i >= n) return false;
        const int d = i == 0 ? d0 : i == 1 ? d1 : i == 2 ? d2 : i == 3 ? d3 : i == 4 ? d4 : i == 5 ? d5 : i == 6 ? d6 : d7;
        u.pm = d & 0xfff; u.pn = (d >> 12) & 0xf; u.pb = d >> 16; return true;
    }
};

__device__ __forceinline__ unsigned cvt_pk_bf16(float lo, float hi) { return pk2(lo, hi); }

struct EpiBf16 {
    static constexpr bool PERM = true;
    bf16_t* O; int ldc;
    __device__ __forceinline__ void operator()(const f32x4 (&acc)[2][2][4][2], const Unit& u, int wr, int wc, int fr, int fq) const {
        const int row0 = u.pm * BM + wr * 64 + fr, col0 = u.pn * BM + wc * 32 + 8 * fq;
#pragma unroll
        for (int ai = 0; ai < 2; ++ai)
#pragma unroll
            for (int m = 0; m < 4; ++m) { bf16_t* rowp = O + (size_t)(row0 + ai * HALF + m * 16) * ldc + col0;
#pragma unroll
                for (int bj = 0; bj < 2; ++bj) { const f32x4 v0 = acc[ai][bj][m][0], v1 = acc[ai][bj][m][1];
                    u32x4 w; w.x = cvt_pk_bf16(v0[0], v0[1]); w.y = cvt_pk_bf16(v0[2], v0[3]); w.z = cvt_pk_bf16(v1[0], v1[1]); w.w = cvt_pk_bf16(v1[2], v1[3]);
                    *(u32x4*)(rowp + bj * HALF) = w; } }
    }
};
struct EpiKvqNorm {
    static constexpr bool PERM = true;
    bf16_t* O; const float* k_gain; const float* q_gain; LAS float* xch;
    __device__ __forceinline__ void operator()(const f32x4 (&acc)[2][2][4][2], const Unit& u, int wr, int wc, int fr, int fq) const {
        const int row0 = u.pm * BM + wr * 64 + fr, col0 = u.pn * BM + wc * 32 + 8 * fq;
        const bool isk = u.pn < 8, isq = u.pn >= 16;
        float rs[2][4][2];
        if (isk || isq) {
#pragma unroll
            for (int ai = 0; ai < 2; ++ai)
#pragma unroll
                for (int m = 0; m < 4; ++m)
#pragma unroll
                    for (int bj = 0; bj < 2; ++bj) { const f32x4 a = acc[ai][bj][m][0], b = acc[ai][bj][m][1];
                        float s = (a[0] * a[0] + a[1] * a[1]) + (a[2] * a[2] + a[3] * a[3]) + (b[0] * b[0] + b[1] * b[1]) + (b[2] * b[2] + b[3] * b[3]);
                        s += __shfl_xor(s, 16); s += __shfl_xor(s, 32);
                        if (fq == 0) xch[((ai * HALF + wr * 64 + m * 16 + fr) * 2 + bj) * 4 + wc] = s; }
            asm volatile("s_waitcnt lgkmcnt(0)" ::: "memory"); __builtin_amdgcn_s_barrier(); asm volatile("" ::: "memory");
            const float* g = isk ? k_gain : q_gain; const float qs = isq ? 0.12751743082459868f : 1.0f;
#pragma unroll
            for (int ai = 0; ai < 2; ++ai)
#pragma unroll
                for (int m = 0; m < 4; ++m)
#pragma unroll
                    for (int bj = 0; bj < 2; ++bj) { const f32x4 p = *(const LAS f32x4*)(xch + ((ai * HALF + wr * 64 + m * 16 + fr) * 2 + bj) * 4);
                        rs[ai][m][bj] = qs / sqrtf(((p[0] + p[1]) + (p[2] + p[3])) * (1.f / HD) + EPS); }
        }
        f32x4 g0 = {1.f, 1.f, 1.f, 1.f}, g1 = g0;
        if (isk || isq) { const float* g = isk ? k_gain : q_gain; g0 = *(const f32x4*)(g + wc * 32 + 8 * fq); g1 = *(const f32x4*)(g + wc * 32 + 8 * fq + 4); }
#pragma unroll
        for (int ai = 0; ai < 2; ++ai)
#pragma unroll
            for (int m = 0; m < 4; ++m) { bf16_t* rowp = O + (size_t)(row0 + ai * HALF + m * 16) * KVQ + col0;
#pragma unroll
                for (int bj = 0; bj < 2; ++bj) { f32x4 v0 = acc[ai][bj][m][0], v1 = acc[ai][bj][m][1];
                    if (isk || isq) { const float r = rs[ai][m][bj]; v0 = v0 * r * g0; v1 = v1 * r * g1; }
                    u32x4 w; w.x = cvt_pk_bf16(v0[0], v0[1]); w.y = cvt_pk_bf16(v0[2], v0[3]); w.z = cvt_pk_bf16(v1[0], v1[1]); w.w = cvt_pk_bf16(v1[2], v1[3]);
                    *(u32x4*)(rowp + bj * HALF) = w; } }
    }
};
struct EpiResF32 {
    static constexpr bool PERM = false;
    const float* base; float* out; int ldc;
    __device__ __forceinline__ void operator()(const f32x4 (&acc)[2][2][4][2], const Unit& u, int wr, int wc, int fr, int fq) const {
        const int row0 = u.pm * BM + wr * 64 + fr, col0 = u.pn * BM + wc * 32 + 4 * fq;
        const float* __restrict__ bp = base; float* __restrict__ op = out;
#pragma unroll
        for (int ai = 0; ai < 2; ++ai)
#pragma unroll
            for (int mp = 0; mp < 2; ++mp) {
                f32x4 b[2][2][2];
#pragma unroll
                for (int mm = 0; mm < 2; ++mm) { const size_t ro = (size_t)(row0 + ai * HALF + (2 * mp + mm) * 16) * ldc + col0;
#pragma unroll
                    for (int bj = 0; bj < 2; ++bj)
#pragma unroll
                        for (int n = 0; n < 2; ++n) b[mm][bj][n] = *(const f32x4*)(bp + ro + bj * HALF + n * 16); }
#pragma unroll
                for (int mm = 0; mm < 2; ++mm) { const size_t ro = (size_t)(row0 + ai * HALF + (2 * mp + mm) * 16) * ldc + col0;
#pragma unroll
                    for (int bj = 0; bj < 2; ++bj)
#pragma unroll
                        for (int n = 0; n < 2; ++n) *(f32x4*)(op + ro + bj * HALF + n * 16) = acc[ai][bj][2 * mp + mm][n] + b[mm][bj][n]; }
            }
    }
};
struct EpiSwiGLU {
    static constexpr bool PERM = true;
    bf16_t* O; int ldc;
    __device__ __forceinline__ void operator()(const f32x4 (&acc)[2][2][4][2], const Unit& u, int wr, int wc, int fr, int fq) const {
        const int row0 = u.pm * BM + wr * 64 + fr, col0 = u.pn * HALF + wc * 32 + 8 * fq;
#pragma unroll
        for (int ai = 0; ai < 2; ++ai)
#pragma unroll
            for (int m = 0; m < 4; ++m) { bf16_t* rowp = O + (size_t)(row0 + ai * HALF + m * 16) * ldc + col0;
                float h[8];
#pragma unroll
                for (int n = 0; n < 2; ++n)
#pragma unroll
                    for (int j = 0; j < 4; ++j) { const float g = acc[ai][0][m][n][j], up = acc[ai][1][m][n][j]; h[n * 4 + j] = g * __builtin_amdgcn_rcpf(1.0f + __expf(-g)) * up; }
                u32x4 w; w.x = cvt_pk_bf16(h[0], h[1]); w.y = cvt_pk_bf16(h[2], h[3]); w.z = cvt_pk_bf16(h[4], h[5]); w.w = cvt_pk_bf16(h[6], h[7]);
                *(u32x4*)rowp = w; }
    }
};

template <class Epi, class Sched>
__device__ __forceinline__ void gemm_phase(LAS unsigned char* lds, const Gemm g, const Sched& S, const Epi& E) {
    const int tid = threadIdx.x, wid = __builtin_amdgcn_readfirstlane(tid >> 6), lane = tid & 63, wr = wid >> 2, wc = wid & 3, fr = lane & 15, fq = lane >> 4;
    const int K = g.K, nt = K / BK;
    unsigned voffA[2], voffB[2];
#pragma unroll
    for (int i = 0; i < 2; ++i) { int R, C; stage_rc(tid * 16 + i * 8192, R, C); const int Rb = Epi::PERM ? ((R & ~31) + perm32(R & 31)) : R;
        voffA[i] = (unsigned)(R * K + C) * 2u; voffB[i] = (unsigned)(Rb * K + C) * 2u; }
    const size_t kstep = (size_t)(BK * 2);
    const size_t hstep = (size_t)HALF * K * 2;
    const size_t tstep = 2 * hstep;
    const unsigned ldsw = (unsigned)wid * 1024u;
    const int aoff = lds_byte(wr * 64 + fr, fq * 8), boff = lds_byte(wc * 32 + fr, fq * 8);
#define PG8_SA(b, h) (((b) * 2 + (h)) * HTB)
#define PG8_SB(b, h) ((4 + (b) * 2 + (h)) * HTB)
#define PG8_STAGE(bufoff, gbase, voff) do { _Pragma("unroll") for (int _i = 0; _i < 2; ++_i) \
        __builtin_amdgcn_global_load_lds((const unsigned*)((const char*)(gbase) + (voff)[_i]), (LAS unsigned*)(lds + (bufoff) + ldsw + _i * 8192), 16, 0, 0); } while (0)
#define PG8_LDA(dst, b, h) do { _Pragma("unroll") for (int m = 0; m < 4; ++m) _Pragma("unroll") for (int k = 0; k < 2; ++k) dst[m][k] = *(const LAS bf16x8*)(lds + PG8_SA(b, h) + aoff + m * 2048 + k * 1024); } while (0)
#define PG8_LDB(dst, b, h) do { _Pragma("unroll") for (int n = 0; n < 2; ++n) _Pragma("unroll") for (int k = 0; k < 2; ++k) dst[n][k] = *(const LAS bf16x8*)(lds + PG8_SB(b, h) + boff + n * 2048 + k * 1024); } while (0)
#define PG8_MMA(ai, bj, At, Bt) do { __builtin_amdgcn_s_setprio(1); _Pragma("unroll") for (int m = 0; m < 4; ++m) _Pragma("unroll") for (int n = 0; n < 2; ++n) _Pragma("unroll") for (int k = 0; k < 2; ++k) \
        acc[ai][bj][m][n] = __builtin_amdgcn_mfma_f32_16x16x32_bf16(Bt[n][k], At[m][k], acc[ai][bj][m][n], 0, 0, 0); __builtin_amdgcn_s_setprio(0); } while (0)
#define PG8_WAIT_V(n) asm volatile("s_waitcnt vmcnt(" #n ")" ::: "memory")
#define PG8_WAIT_L(n) asm volatile("s_waitcnt lgkmcnt(" #n ")" ::: "memory")
#define PG8_BAR __builtin_amdgcn_s_barrier()
#define PG8_SCHED __builtin_amdgcn_sched_barrier(0)
    Unit cur, nxt; int ui = 0;
    if (!S.next(0, cur)) return;
    f32x4 acc[2][2][4][2];
#pragma unroll
    for (int a = 0; a < 2; ++a)
#pragma unroll
        for (int b = 0; b < 2; ++b)
#pragma unroll
            for (int m = 0; m < 4; ++m)
#pragma unroll
                for (int n = 0; n < 2; ++n) acc[a][b][m][n] = (f32x4){0.f, 0.f, 0.f, 0.f};
    bf16x8 At[4][2], B0[2][2], B1[2][2];
    const char* cA = (const char*)g.A + (size_t)cur.pm * tstep; const char* cB = (const char*)g.Bt + (size_t)cur.pb * tstep;
    PG8_STAGE(PG8_SB(0, 0), cB, voffB); PG8_STAGE(PG8_SA(0, 0), cA, voffA); PG8_STAGE(PG8_SB(0, 1), cB + hstep, voffB); PG8_STAGE(PG8_SA(0, 1), cA + hstep, voffA);
    if (wr == 1) PG8_BAR;
    PG8_WAIT_V(4); PG8_BAR;
    PG8_STAGE(PG8_SB(1, 0), cB + kstep, voffB); PG8_STAGE(PG8_SA(1, 0), cA + kstep, voffA); PG8_STAGE(PG8_SB(1, 1), cB + hstep + kstep, voffB);
    PG8_WAIT_V(6); PG8_BAR;
    for (;;) {
        const bool has_next = S.next(ui + 1, nxt);
        const char* nA = has_next ? (const char*)g.A + (size_t)nxt.pm * tstep : cA; const char* nB = has_next ? (const char*)g.Bt + (size_t)nxt.pb * tstep : cB;
        for (int t = 0; t < nt; t += 2) {
            const bool last = (t == nt - 2);
            const char* a1 = cA + (size_t)(t + 1) * kstep;
            const char* a2 = last ? nA : cA + (size_t)(t + 2) * kstep; const char* b2 = last ? nB : cB + (size_t)(t + 2) * kstep;
            const char* a3 = a2 + kstep; const char* b3 = b2 + kstep;
            PG8_LDB(B0, 0, 0); PG8_SCHED; PG8_LDA(At, 0, 0); PG8_STAGE(PG8_SA(1, 1), a1 + hstep, voffA);
            PG8_WAIT_L(8); PG8_BAR; PG8_WAIT_L(0); PG8_MMA(0, 0, At, B0); PG8_BAR; PG8_SCHED;
            PG8_LDB(B1, 0, 1); PG8_STAGE(PG8_SB(0, 0), b2, voffB);
            PG8_BAR; PG8_WAIT_L(0); PG8_MMA(0, 1, At, B1); PG8_BAR;
            PG8_LDA(At, 0, 1); PG8_STAGE(PG8_SA(0, 0), a2, voffA);
            PG8_BAR; PG8_WAIT_L(0); PG8_MMA(1, 0, At, B0); PG8_BAR; PG8_SCHED;
            PG8_STAGE(PG8_SB(0, 1), b2 + hstep, voffB);
            PG8_WAIT_V(6); PG8_BAR; PG8_MMA(1, 1, At, B1); PG8_BAR;
            PG8_LDB(B0, 1, 0); PG8_SCHED; PG8_LDA(At, 1, 0); PG8_STAGE(PG8_SA(0, 1), a2 + hstep, voffA);
            PG8_WAIT_L(8); PG8_BAR; PG8_WAIT_L(0); PG8_MMA(0, 0, At, B0); PG8_BAR; PG8_SCHED;
            PG8_LDB(B1, 1, 1); PG8_STAGE(PG8_SB(1, 0), b3, voffB);
            PG8_BAR; PG8_WAIT_L(0); PG8_MMA(0, 1, At, B1); PG8_BAR;
            PG8_LDA(At, 1, 1); PG8_STAGE(PG8_SA(1, 0), a3, voffA);
            PG8_BAR; PG8_WAIT_L(0); PG8_MMA(1, 0, At, B0); PG8_BAR; PG8_SCHED;
            PG8_STAGE(PG8_SB(1, 1), b3 + hstep, voffB);
            PG8_WAIT_V(6); PG8_BAR; PG8_MMA(1, 1, At, B1); PG8_BAR;
        }
        E(acc, cur, wr, wc, fr, fq);
        if (!has_next) break;
#pragma unroll
        for (int a = 0; a < 2; ++a)
#pragma unroll
            for (int b = 0; b < 2; ++b)
#pragma unroll
                for (int m = 0; m < 4; ++m)
#pragma unroll
                    for (int n = 0; n < 2; ++n) acc[a][b][m][n] = (f32x4){0.f, 0.f, 0.f, 0.f};
        cur = nxt; cA = nA; cB = nB; ++ui;
    }
    PG8_WAIT_V(0);
    if (wr == 0) PG8_BAR;
    PG8_BAR;
#undef PG8_SA
#undef PG8_SB
#undef PG8_STAGE
#undef PG8_LDA
#undef PG8_LDB
#undef PG8_MMA
#undef PG8_WAIT_V
#undef PG8_WAIT_L
#undef PG8_BAR
#undef PG8_SCHED
}
template <class Epi, class Sched>
__device__ __forceinline__ void gemm_phase_gather(LAS unsigned char* lds, const Gemm g, const Sched& S, const Epi& E, const LAS int* rowtok) {
    const int tid = threadIdx.x, wid = __builtin_amdgcn_readfirstlane(tid >> 6), lane = tid & 63, wr = wid >> 2, wc = wid & 3, fr = lane & 15, fq = lane >> 4;
    const int K = g.K, nt = K / BK;
    unsigned voffB[2]; unsigned cofA[2]; int rofA[2];
#pragma unroll
    for (int i = 0; i < 2; ++i) { int R, C; stage_rc(tid * 16 + i * 8192, R, C); const int Rb = Epi::PERM ? ((R & ~31) + perm32(R & 31)) : R;
        cofA[i] = (unsigned)C * 2u; rofA[i] = R; voffB[i] = (unsigned)(Rb * K + C) * 2u; }
    unsigned ga[2][2], gn[2][2];
#define PG8_ROWS(dst, u_) do { _Pragma("unroll") for (int h_ = 0; h_ < 2; ++h_) _Pragma("unroll") for (int i_ = 0; i_ < 2; ++i_) \
        dst[h_][i_] = (unsigned)rowtok[(u_) * 256 + h_ * HALF + rofA[i_]] * (unsigned)(K * 2) + cofA[i_]; } while (0)
    const size_t kstep = (size_t)(BK * 2);
    const size_t hstep = (size_t)HALF * K * 2;
    const size_t tstep = 2 * hstep;
    const unsigned ldsw = (unsigned)wid * 1024u;
    const int aoff = lds_byte(wr * 64 + fr, fq * 8), boff = lds_byte(wc * 32 + fr, fq * 8);
#define PG8_SA(b, h) (((b) * 2 + (h)) * HTB)
#define PG8_SB(b, h) ((4 + (b) * 2 + (h)) * HTB)
#define PG8_STAGE(bufoff, gbase, voff) do { _Pragma("unroll") for (int _i = 0; _i < 2; ++_i) \
        __builtin_amdgcn_global_load_lds((const unsigned*)((const char*)(gbase) + (voff)[_i]), (LAS unsigned*)(lds + (bufoff) + ldsw + _i * 8192), 16, 0, 0); } while (0)
#define PG8_LDA(dst, b, h) do { _Pragma("unroll") for (int m = 0; m < 4; ++m) _Pragma("unroll") for (int k = 0; k < 2; ++k) dst[m][k] = *(const LAS bf16x8*)(lds + PG8_SA(b, h) + aoff + m * 2048 + k * 1024); } while (0)
#define PG8_LDB(dst, b, h) do { _Pragma("unroll") for (int n = 0; n < 2; ++n) _Pragma("unroll") for (int k = 0; k < 2; ++k) dst[n][k] = *(const LAS bf16x8*)(lds + PG8_SB(b, h) + boff + n * 2048 + k * 1024); } while (0)
#define PG8_MMA(ai, bj, At, Bt) do { __builtin_amdgcn_s_setprio(1); _Pragma("unroll") for (int m = 0; m < 4; ++m) _Pragma("unroll") for (int n = 0; n < 2; ++n) _Pragma("unroll") for (int k = 0; k < 2; ++k) \
        acc[ai][bj][m][n] = __builtin_amdgcn_mfma_f32_16x16x32_bf16(Bt[n][k], At[m][k], acc[ai][bj][m][n], 0, 0, 0); __builtin_amdgcn_s_setprio(0); } while (0)
#define PG8_WAIT_V(n) asm volatile("s_waitcnt vmcnt(" #n ")" ::: "memory")
#define PG8_WAIT_L(n) asm volatile("s_waitcnt lgkmcnt(" #n ")" ::: "memory")
#define PG8_BAR __builtin_amdgcn_s_barrier()
#define PG8_SCHED __builtin_amdgcn_sched_barrier(0)
    Unit cur, nxt; int ui = 0;
    if (!S.next(0, cur)) return;
    f32x4 acc[2][2][4][2];
#pragma unroll
    for (int a = 0; a < 2; ++a)
#pragma unroll
        for (int b = 0; b < 2; ++b)
#pragma unroll
            for (int m = 0; m < 4; ++m)
#pragma unroll
                for (int n = 0; n < 2; ++n) acc[a][b][m][n] = (f32x4){0.f, 0.f, 0.f, 0.f};
    bf16x8 At[4][2], B0[2][2], B1[2][2];
    const char* cA = (const char*)g.A; const char* cB = (const char*)g.Bt + (size_t)cur.pb * tstep;
    PG8_ROWS(ga, 0);
    PG8_STAGE(PG8_SB(0, 0), cB, voffB); PG8_STAGE(PG8_SA(0, 0), cA, ga[0]); PG8_STAGE(PG8_SB(0, 1), cB + hstep, voffB); PG8_STAGE(PG8_SA(0, 1), cA, ga[1]);
    if (wr == 1) PG8_BAR;
    PG8_WAIT_V(4); PG8_BAR;
    PG8_STAGE(PG8_SB(1, 0), cB + kstep, voffB); PG8_STAGE(PG8_SA(1, 0), cA + kstep, ga[0]); PG8_STAGE(PG8_SB(1, 1), cB + hstep + kstep, voffB);
    PG8_WAIT_V(6); PG8_BAR;
    for (;;) {
        const bool has_next = S.next(ui + 1, nxt);
        const char* nB = has_next ? (const char*)g.Bt + (size_t)nxt.pb * tstep : cB;
        if (has_next) PG8_ROWS(gn, ui + 1); else { gn[0][0] = ga[0][0]; gn[0][1] = ga[0][1]; gn[1][0] = ga[1][0]; gn[1][1] = ga[1][1]; }
        for (int t = 0; t < nt; t += 2) {
            const bool last = (t == nt - 2);
            const char* a1 = cA + (size_t)(t + 1) * kstep;
            const char* a2 = last ? cA : cA + (size_t)(t + 2) * kstep; const char* b2 = last ? nB : cB + (size_t)(t + 2) * kstep;
            unsigned o2[2][2];
            _Pragma("unroll") for (int h_ = 0; h_ < 2; ++h_) _Pragma("unroll") for (int i_ = 0; i_ < 2; ++i_) o2[h_][i_] = last ? gn[h_][i_] : ga[h_][i_];
            const char* a3 = a2 + kstep; const char* b3 = b2 + kstep;
            PG8_LDB(B0, 0, 0); PG8_SCHED; PG8_LDA(At, 0, 0); PG8_STAGE(PG8_SA(1, 1), a1, ga[1]);
            PG8_WAIT_L(8); PG8_BAR; PG8_WAIT_L(0); PG8_MMA(0, 0, At, B0); PG8_BAR; PG8_SCHED;
            PG8_LDB(B1, 0, 1); PG8_STAGE(PG8_SB(0, 0), b2, voffB);
            PG8_BAR; PG8_WAIT_L(0); PG8_MMA(0, 1, At, B1); PG8_BAR;
            PG8_LDA(At, 0, 1); PG8_STAGE(PG8_SA(0, 0), a2, o2[0]);
            PG8_BAR; PG8_WAIT_L(0); PG8_MMA(1, 0, At, B0); PG8_BAR; PG8_SCHED;
            PG8_STAGE(PG8_SB(0, 1), b2 + hstep, voffB);
            PG8_WAIT_V(6); PG8_BAR; PG8_MMA(1, 1, At, B1); PG8_BAR;
            PG8_LDB(B0, 1, 0); PG8_SCHED; PG8_LDA(At, 1, 0); PG8_STAGE(PG8_SA(0, 1), a2, o2[1]);
            PG8_WAIT_L(8); PG8_BAR; PG8_WAIT_L(0); PG8_MMA(0, 0, At, B0); PG8_BAR; PG8_SCHED;
            PG8_LDB(B1, 1, 1); PG8_STAGE(PG8_SB(1, 0), b3, voffB);
            PG8_BAR; PG8_WAIT_L(0); PG8_MMA(0, 1, At, B1); PG8_BAR;
            PG8_LDA(At, 1, 1); PG8_STAGE(PG8_SA(1, 0), a3, o2[0]);
            PG8_BAR; PG8_WAIT_L(0); PG8_MMA(1, 0, At, B0); PG8_BAR; PG8_SCHED;
            PG8_STAGE(PG8_SB(1, 1), b3 + hstep, voffB);
            PG8_WAIT_V(6); PG8_BAR; PG8_MMA(1, 1, At, B1); PG8_BAR;
        }
        E(acc, cur, wr, wc, fr, fq);
        if (!has_next) break;
#pragma unroll
        for (int a = 0; a < 2; ++a)
#pragma unroll
            for (int b = 0; b < 2; ++b)
#pragma unroll
                for (int m = 0; m < 4; ++m)
#pragma unroll
                    for (int n = 0; n < 2; ++n) acc[a][b][m][n] = (f32x4){0.f, 0.f, 0.f, 0.f};
        cur = nxt; cB = nB; ++ui; ga[0][0] = gn[0][0]; ga[0][1] = gn[0][1]; ga[1][0] = gn[1][0]; ga[1][1] = gn[1][1];
    }
    PG8_WAIT_V(0);
    if (wr == 0) PG8_BAR;
    PG8_BAR;
#undef PG8_SA
#undef PG8_SB
#undef PG8_STAGE
#undef PG8_ROWS
#undef PG8_LDA
#undef PG8_LDB
#undef PG8_MMA
#undef PG8_WAIT_V
#undef PG8_WAIT_L
#undef PG8_BAR
#undef PG8_SCHED
}
}

struct Ctx {
    LAS unsigned char* lds;
    int tid, lane, wave, G, bid;
};

struct TrItem { const float* W; int N, k0, n0; bf16_t* WT; int ldk, drow0; const float* gain; };
template <bool NT>
__device__ __forceinline__ void tr_load(const TrItem& d, float (&v)[32], int lane) {
#pragma unroll
    for (int i = 0; i < 32; ++i) { const int kk = 2 * i + (lane >> 5); const float* p = &d.W[(size_t)(d.k0 + kk) * d.N + d.n0 + (lane & 31)]; v[i] = NT ? __builtin_nontemporal_load(p) : *p; }
}
template <bool NT>
__device__ __forceinline__ void tr_finish(const TrItem& d, float (&v)[32], LAS float* scr, int lane) {
    if (d.gain) {
#pragma unroll
        for (int i = 0; i < 32; ++i) v[i] *= d.gain[d.k0 + 2 * i + (lane >> 5)];
    }
#pragma unroll
    for (int i = 0; i < 32; ++i) scr[(2 * i + (lane >> 5)) * 33 + (lane & 31)] = v[i];
    LDS_WAIT(); asm volatile("" ::: "memory");
    const int c = lane & 7;
#pragma unroll
    for (int j = 0; j < 4; ++j) { const int n = (lane >> 3) + 8 * j; const LAS float* s = scr + (8 * c) * 33 + n;
        u32x4 o; o.x = pk2(s[0 * 33], s[1 * 33]); o.y = pk2(s[2 * 33], s[3 * 33]); o.z = pk2(s[4 * 33], s[5 * 33]); o.w = pk2(s[6 * 33], s[7 * 33]);
        u32x4* dp = (u32x4*)(d.WT + (size_t)(d.drow0 + n) * d.ldk + d.k0 + 8 * c); if (NT) __builtin_nontemporal_store(o, dp); else *dp = o; }
    LDS_WAIT(); asm volatile("" ::: "memory");
}
__device__ __forceinline__ void rms_row_to_bf16(const float* xrow, const float* gain, bf16_t* orow, int lane) {
    const f32x4* xr = (const f32x4*)xrow + 2 * lane;
    f32x4 v[8]; float s = 0.f;
#pragma unroll
    for (int j = 0; j < 8; ++j) { v[j] = xr[128 * (j >> 1) + (j & 1)]; s += (v[j].x * v[j].x + v[j].y * v[j].y) + (v[j].z * v[j].z + v[j].w * v[j].w); }
    const float r = 1.0f / sqrtf(wave_sum(s) * (1.f / D) + EPS);
    u32x4* o16 = (u32x4*)orow + lane;
#pragma unroll
    for (int j = 0; j < 4; ++j) {
        const f32x4 g0 = gain ? ((const f32x4*)gain)[128 * j + 2 * lane] : (f32x4){1.f, 1.f, 1.f, 1.f}, g1 = gain ? ((const f32x4*)gain)[128 * j + 2 * lane + 1] : (f32x4){1.f, 1.f, 1.f, 1.f};
        const f32x4 a = v[2 * j] * r * g0, b = v[2 * j + 1] * r * g1;
        o16[64 * j] = (u32x4){pk2(a.x, a.y), pk2(a.z, a.w), pk2(b.x, b.y), pk2(b.z, b.w)}; }
}

struct P0Args { const float *x, *norm_a, *w_in, *w_out_a, *norm_kv, *w_kv, *norm_b, *w_q, *w_out_b, *w_gate, *w_up, *w_down, *w_rg, *w_re; float* WR;
                bf16_t *Win_t, *Wouta_t, *Wkvq_t, *Woutb_t, *Wgu_t, *Wd_t, *XN; };
constexpr int I_IN = 32 * (GIN / 32), I_OA = 64 * 64, I_KV = 32 * 128, I_Q = 32 * 64, I_OB = 32 * 64, I_G1 = 32 * 24, I_D1 = 12 * 64;
constexpr int I_G = 64 * I_G1, I_DN = 64 * I_D1;
constexpr int NITEMS = I_IN + I_OA + I_KV + I_Q + I_OB + 2 * I_G + I_DN;
__device__ __forceinline__ TrItem p0_desc(const P0Args& a, int it) {
    int r = it;
    if (r < I_IN) { const int nnb = GIN / 32, kb = r / nnb, nb = r % nnb; return TrItem{a.w_in, GIN, 64 * kb, 32 * nb, a.Win_t, D, 32 * nb, nullptr}; } r -= I_IN;
    if (r < I_OA) { const int kb = r / 64, nb = r % 64; return TrItem{a.w_out_a, D, 64 * kb, 32 * nb, a.Wouta_t, GVDIM, 32 * nb, nullptr}; } r -= I_OA;
    if (r < I_KV) { const int kb = r / 128, nb = r % 128; return TrItem{a.w_kv, 2 * SBDIM, 64 * kb, 32 * nb, a.Wkvq_t, D, 32 * nb, a.norm_kv}; } r -= I_KV;
    if (r < I_Q) { const int kb = r / 64, nb = r % 64; return TrItem{a.w_q, SBDIM, 64 * kb, 32 * nb, a.Wkvq_t, D, 2 * SBDIM + 32 * nb, a.norm_b}; } r -= I_Q;
    if (r < I_OB) { const int kb = r / 64, nb = r % 64; return TrItem{a.w_out_b, D, 64 * kb, 32 * nb, a.Woutb_t, SBDIM, 32 * nb, nullptr}; } r -= I_OB;
    if (r < I_G) { const int mi = r / I_G1, q = r % I_G1, kb = q / 24, nb = q % 24, n0 = 32 * nb;
        return TrItem{a.w_gate + (size_t)mi * D * HID, HID, 64 * kb, n0, a.Wgu_t + (size_t)mi * 2 * HID * D, D, 256 * (n0 / 128) + (n0 % 128), nullptr}; } r -= I_G;
    if (r < I_G) { const int mi = r / I_G1, q = r % I_G1, kb = q / 24, nb = q % 24, n0 = 32 * nb;
        return TrItem{a.w_up + (size_t)mi * D * HID, HID, 64 * kb, n0, a.Wgu_t + (size_t)mi * 2 * HID * D, D, 256 * (n0 / 128) + 128 + (n0 % 128), nullptr}; } r -= I_G;
    { const int mi = r / I_D1, q = r % I_D1, kb = q / 64, nb = q % 64;
        return TrItem{a.w_down + (size_t)mi * HID * D, D, 64 * kb, 32 * nb, a.Wd_t + (size_t)mi * D * HID, HID, 32 * nb, nullptr}; }
}
__device__ __forceinline__ void p0_prologue(const Ctx& F, const P0Args& a) {
    LAS float* scr = (LAS float*)(F.lds + F.wave * 16384);
    const int gw = F.bid * 8 + F.wave, NGW = F.G * 8;
    for (int it = gw; it < I_IN; it += NGW) { const TrItem d = p0_desc(a, it); float v[32]; tr_load<false>(d, v, F.lane); tr_finish<false>(d, v, scr, F.lane); }
    for (int m = gw; m < T; m += NGW) rms_row_to_bf16(a.x + (size_t)m * D, a.norm_a, a.XN + (size_t)m * D, F.lane);
    for (int i = F.bid * 512 + F.tid; i < 2 * D * WRN; i += F.G * 512) { const int l = i / (D * WRN), q = i % (D * WRN), k = 4 * (q / (4 * WRN)) + (q & 3), n = (q / 4) % WRN;
        a.WR[i] = n < NGRP ? a.w_rg[(size_t)(l * D + k) * NGRP + n] : n < NGRP + NE ? a.w_re[(size_t)(l * D + k) * NE + (n - NGRP)] : 0.f; }
}
constexpr int P0_TK = 32;
__device__ __forceinline__ void p0_queue(const Ctx& F, const P0Args& a, unsigned* ticket) {
    LAS float* scr = (LAS float*)(F.lds + F.wave * 16384);
    constexpr int NREST = NITEMS - I_IN;
    for (;;) {
        unsigned t = 0;
        if (F.lane == 0) t = __hip_atomic_fetch_add(ticket, 1u, __ATOMIC_RELAXED, __HIP_MEMORY_SCOPE_AGENT);
        t = __builtin_amdgcn_readfirstlane(t);
        if ((long)t * P0_TK >= NREST) break;
        const int i0 = (int)t * P0_TK, i1 = i0 + P0_TK < NREST ? i0 + P0_TK : NREST;
        float va[32], vb[32];
        tr_load<true>(p0_desc(a, I_IN + i0), va, F.lane);
        for (int it = i0; it < i1; it += 2) {
            if (it + 1 < i1) tr_load<true>(p0_desc(a, I_IN + it + 1), vb, F.lane);
            { const TrItem d = p0_desc(a, I_IN + it); tr_finish<true>(d, va, scr, F.lane); }
            if (it + 2 < i1) tr_load<true>(p0_desc(a, I_IN + it + 2), va, F.lane);
            if (it + 1 < i1) { const TrItem d = p0_desc(a, I_IN + it + 1); tr_finish<true>(d, vb, scr, F.lane); }
        }
    }
}

constexpr int GCH = 32;
__device__ __forceinline__ void p2_gdn_ref(const Ctx& F, const bf16_t* proj, const float* conv_w, const float* a_log, const float* dt_bias, const float* out_gain, bf16_t* og) {
    LAS float* qs = (LAS float*)F.lds;
    LAS float* ks = qs + GCH * HD;
    LAS float* vs = ks + GCH * HD;
    LAS float* ob = vs + GCH * HD;
    LAS float* bet = ob + GCH * HD;
    LAS float* egs = bet + GCH;
    const int cl = F.lane & 15, qd = F.lane >> 4, c = F.wave * 16 + cl;
    for (int unit = F.bid; unit < BATCH * GVH; unit += F.G) {
        const int b = unit / GVH, hv = unit % GVH, hk = hv / 2;
        const float A = __expf(a_log[hv]), dtb = dt_bias[hv];
        float S[32];
#pragma unroll
        for (int i = 0; i < 32; ++i) S[i] = 0.f;
        for (int ch = 0; ch < SEQ / GCH; ++ch) {
            const int t0 = ch * GCH;
            for (int idx = F.tid; idx < 3 * GCH * HD; idx += 512) {
                const int which = idx / (GCH * HD), tl = (idx / HD) % GCH, cc = idx % HD;
                const int col = which == 0 ? hk * HD + cc : which == 1 ? GKDIM + hk * HD + cc : 2 * GKDIM + hv * HD + cc;
                float acc = 0.f;
#pragma unroll
                for (int j = 0; j < 4; ++j) { const int tt = t0 + tl - 3 + j; if (tt >= 0) acc += conv_w[j * GCONV + col] * bf2f(proj[(size_t)(b * SEQ + tt) * GIN_PAD + col]); }
                qs[which * GCH * HD + tl * HD + cc] = silu_f(acc);
            }
            if (F.tid < GCH) { const size_t row = (size_t)(b * SEQ + t0 + F.tid) * GIN_PAD;
                bet[F.tid] = sigmoid_f(bf2f(proj[row + GCONV + GVDIM + hv]));
                const float av = bf2f(proj[row + GCONV + GVDIM + GVH + hv]);
                egs[F.tid] = __expf(-A * softplus_f(av + dtb)); }
            __syncthreads();
            for (int tl = F.wave; tl < GCH; tl += 8) {
                const float q0 = qs[tl * HD + 2 * F.lane], q1 = qs[tl * HD + 2 * F.lane + 1], k0 = ks[tl * HD + 2 * F.lane], k1 = ks[tl * HD + 2 * F.lane + 1];
                const float rq = 1.0f / sqrtf(wave_sum(q0 * q0 + q1 * q1) + EPS) * 0.08838834764831845f, rk = 1.0f / sqrtf(wave_sum(k0 * k0 + k1 * k1) + EPS);
                qs[tl * HD + 2 * F.lane] = q0 * rq; qs[tl * HD + 2 * F.lane + 1] = q1 * rq; ks[tl * HD + 2 * F.lane] = k0 * rk; ks[tl * HD + 2 * F.lane + 1] = k1 * rk;
            }
            __syncthreads();
            for (int tl = 0; tl < GCH; ++tl) {
                const float e = egs[tl], bt = bet[tl];
                float dk = 0.f, dq = 0.f, kq = 0.f;
                const LAS f32x4* kp = (const LAS f32x4*)(ks + tl * HD + 32 * qd); const LAS f32x4* qp = (const LAS f32x4*)(qs + tl * HD + 32 * qd);
                f32x4 kv[8];
#pragma unroll
                for (int i = 0; i < 8; ++i) { kv[i] = kp[i]; const f32x4 qv = qp[i];
#pragma unroll
                    for (int j = 0; j < 4; ++j) { S[4 * i + j] *= e; dk += kv[i][j] * S[4 * i + j]; dq += qv[j] * S[4 * i + j]; kq += kv[i][j] * qv[j]; } }
                dk += __shfl_xor(dk, 16); dk += __shfl_xor(dk, 32);
                dq += __shfl_xor(dq, 16); dq += __shfl_xor(dq, 32);
                kq += __shfl_xor(kq, 16); kq += __shfl_xor(kq, 32);
                const float vn = bt * (vs[tl * HD + c] - dk);
#pragma unroll
                for (int i = 0; i < 8; ++i)
#pragma unroll
                    for (int j = 0; j < 4; ++j) S[4 * i + j] += kv[i][j] * vn;
                if (qd == 0) ob[tl * HD + c] = dq + kq * vn;
            }
            __syncthreads();
            for (int tl = F.wave; tl < GCH; tl += 8) {
                const float o0 = ob[tl * HD + 2 * F.lane], o1 = ob[tl * HD + 2 * F.lane + 1];
                const float r = 1.0f / sqrtf(wave_sum(o0 * o0 + o1 * o1) * (1.f / HD) + EPS);
                const size_t row = (size_t)(b * SEQ + t0 + tl);
                const unsigned zz = *(const unsigned*)(proj + row * GIN_PAD + GCONV + hv * HD + 2 * F.lane);
                const float z0 = bf2f(zz & 0xffffu), z1 = bf2f(zz >> 16);
                *(unsigned*)(og + row * GVDIM + hv * HD + 2 * F.lane) = pk2(o0 * r * out_gain[2 * F.lane] * silu_f(z0), o1 * r * out_gain[2 * F.lane + 1] * silu_f(z1));
            }
            __syncthreads();
        }
    }
}


namespace gdn {
typedef float f32x16 __attribute__((ext_vector_type(16)));
typedef short s16x4 __attribute__((ext_vector_type(4)));
__device__ __forceinline__ unsigned off_b(unsigned row, unsigned ch) { return 256u * row + 16u * (ch ^ (((row & 3) << 2) | ((row >> 2) & 3))); }
__device__ __forceinline__ unsigned off64(unsigned row, unsigned ch) { return 128u * row + 16u * (ch ^ (row & 7)); }
constexpr int L_KU = 0, L_QU = 16384, L_VNT = 16384, L_VV = 32768, L_ST = 49152, L_LP = 81920, L_RT = 81920, L_OB = 81920, L_TM = 98304, L_SSQ = 98304, L_AQ = 106496, L_VNTE = 114688;
constexpr int L_CW = RING_BYTES, L_SC = L_CW + 6144;
constexpr int L_TR = L_SC + 2560, L_TT = L_TR + 4096;
constexpr int SC_BETA = 0, SC_RK = 64, SC_RQ = 128, SC_G2 = 192, SC_AK = 256, SC_BQ = 320, SC_EV = 384, SC_DL = 448, SC_GAIN = 512;
static_assert(L_TT + 4096 <= LDSCTL_OFF, "gdn lds");
__device__ __forceinline__ int crow(int r, int hi) { return (r & 3) + 8 * (r >> 2) + 4 * hi; }
__device__ __forceinline__ unsigned cvtpk(float lo, float hi) { return pk2(lo, hi); }
__device__ __forceinline__ float dpp_add8(float v) {
    v += __int_as_float(__builtin_amdgcn_mov_dpp(__float_as_int(v), 0xB1, 0xF, 0xF, true));
    v += __int_as_float(__builtin_amdgcn_mov_dpp(__float_as_int(v), 0x4E, 0xF, 0xF, true));
    v += __int_as_float(__builtin_amdgcn_mov_dpp(__float_as_int(v), 0x141, 0xF, 0xF, true));
    return v;
}
__device__ __forceinline__ s16x4 tr_read(unsigned addr) { s16x4 r; asm volatile("ds_read_b64_tr_b16 %0, %1" : "=&v"(r) : "v"(addr) : "memory"); return r; }
}

__device__ __forceinline__ void p2_gdn(const Ctx& F, const bf16_t* proj, const float* conv_w, const float* a_log, const float* dt_bias, const float* out_gain, bf16_t* og) {
    using namespace gdn;
    LAS unsigned char* L = F.lds;
    const unsigned lbase = (unsigned)(size_t)L;
    LAS float* cw = (LAS float*)(L + L_CW);
    LAS float* sc = (LAS float*)(L + L_SC);
    LAS float* ssq = (LAS float*)(L + L_SSQ);
    int tid = F.tid, lane = F.lane, r32 = lane & 31, hi = lane >> 5;
    const int w = F.wave;
#define GDN_FRESH() do { asm volatile("" : "+v"(tid)); lane = tid & 63; r32 = lane & 31; hi = lane >> 5; } while (0)
    const int tb = w >> 2, vb = w & 3;
    const int kb = w >> 1, vbase = 2 * (w & 1);
    for (int unit = F.bid; unit < BATCH * GVH; unit += F.G) {
        const int b = unit / GVH, hv = unit % GVH, hk = hv / 2;
        const float Aexp = __expf(a_log[hv]), dtb = dt_bias[hv];
        __syncthreads();
        for (int idx = tid; idx < 4 * 384; idx += 512) { const int j = idx / 384, cl = idx % 384;
            const int col = cl < 128 ? hk * HD + cl : cl < 256 ? GKDIM + hk * HD + (cl - 128) : 2 * GKDIM + hv * HD + (cl - 256);
            cw[idx] = conv_w[j * GCONV + col]; }
        for (int idx = tid; idx < 32768 / 16; idx += 512) *(LAS u32x4*)(L + L_ST + idx * 16) = (u32x4){0u, 0u, 0u, 0u};
        f32x16 Sacc[2] = {};
        u32x4 pre[3][5];
#define GDN_LOADPRE(CH) do { _Pragma("unroll") for (int k_ = 0; k_ < 3; ++k_) { const int item_ = tid + 512 * k_, cc_ = item_ % 48, tok0_ = 2 * (item_ / 48); \
        const int col_ = cc_ < 16 ? hk * HD + cc_ * 8 : cc_ < 32 ? GKDIM + hk * HD + (cc_ - 16) * 8 : 2 * GKDIM + hv * HD + (cc_ - 32) * 8; \
        _Pragma("unroll") for (int rr_ = 0; rr_ < 5; ++rr_) { int tt_ = (CH) * 64 + tok0_ - 3 + rr_; tt_ = tt_ < 0 ? 0 : tt_; \
            pre[k_][rr_] = *(const u32x4*)(proj + (size_t)(b * SEQ + tt_) * GIN_PAD + col_); } } } while (0)
        GDN_LOADPRE(0);
        unsigned short braw = 0, araw = 0;
        if (w == 6) { const bf16_t* pr = proj + ((size_t)(b * SEQ) + lane) * GIN_PAD + GCONV + GVDIM; braw = pr[hv]; araw = pr[GVH + hv]; }
        for (int idx = tid; idx < HD; idx += 512) sc[SC_GAIN + idx] = out_gain[idx];
        __syncthreads();
        for (int ch = 0; ch < SEQ / 64; ++ch) {
            const int t0 = ch * 64;
            const size_t rowbase = (size_t)(b * SEQ + t0);
            GDN_FRESH();
            u32x4 zreg[2];
#pragma unroll
            for (int k = 0; k < 3; ++k) {
                const int item = tid + 512 * k, cc = item % 48, tok0 = 2 * (item / 48);
                float x[5][8];
#pragma unroll
                for (int rr = 0; rr < 5; ++rr) {
                    u32x4 u = pre[k][rr];
                    if (ch == 0 && rr < 3 && tok0 - 3 + rr < 0) u = (u32x4){0u, 0u, 0u, 0u};
                    x[rr][0] = bf2f(u.x & 0xffffu); x[rr][1] = bf2f(u.x >> 16); x[rr][2] = bf2f(u.y & 0xffffu); x[rr][3] = bf2f(u.y >> 16);
                    x[rr][4] = bf2f(u.z & 0xffffu); x[rr][5] = bf2f(u.z >> 16); x[rr][6] = bf2f(u.w & 0xffffu); x[rr][7] = bf2f(u.w >> 16);
                }
                float y[2][8];
#pragma unroll
                for (int e = 0; e < 8; ++e) { y[0][e] = 0.f; y[1][e] = 0.f; }
#pragma unroll
                for (int j = 0; j < 4; ++j) {
                    const f32x4 w0 = *(const LAS f32x4*)(cw + j * 384 + cc * 8), w1 = *(const LAS f32x4*)(cw + j * 384 + cc * 8 + 4);
#pragma unroll
                    for (int d = 0; d < 2; ++d) {
                        y[d][0] += w0.x * x[d + j][0]; y[d][1] += w0.y * x[d + j][1]; y[d][2] += w0.z * x[d + j][2]; y[d][3] += w0.w * x[d + j][3];
                        y[d][4] += w1.x * x[d + j][4]; y[d][5] += w1.y * x[d + j][5]; y[d][6] += w1.z * x[d + j][6]; y[d][7] += w1.w * x[d + j][7];
                    }
                }
                float s2[2];
#pragma unroll
                for (int d = 0; d < 2; ++d) {
                    s2[d] = 0.f;
#pragma unroll
                    for (int e = 0; e < 8; ++e) { y[d][e] = silu_f(y[d][e]); s2[d] += y[d][e] * y[d][e]; }
                    u32x4 o; o.x = cvtpk(y[d][0], y[d][1]); o.y = cvtpk(y[d][2], y[d][3]); o.z = cvtpk(y[d][4], y[d][5]); o.w = cvtpk(y[d][6], y[d][7]);
                    const int tile = cc < 16 ? L_QU : cc < 32 ? L_KU : L_VV;
                    *(LAS u32x4*)(L + tile + off_b(tok0 + d, cc & 15)) = o;
                }
                if (cc < 32) *(LAS f32x2*)(ssq + cc * 64 + tok0) = (f32x2){s2[0], s2[1]};
            }
            __syncthreads();
            GDN_FRESH();
            f32x16 accB = {};
            const int bblk = w % 3, bib = bblk == 0 ? 0 : 1, bjb = bblk == 2 ? 1 : 0;
            if (w < 6) {
                const int btile = w >= 3 ? L_QU : L_KU;
#pragma unroll
                for (int s = 0; s < 8; ++s) {
                    const bf16x8 a = *(const LAS bf16x8*)(L + L_KU + off_b(32 * bjb + r32, 2 * s + hi));
                    const bf16x8 bq = *(const LAS bf16x8*)(L + btile + off_b(32 * bib + r32, 2 * s + hi));
                    accB = __builtin_amdgcn_mfma_f32_32x32x16_bf16(a, bq, accB, 0, 0, 0);
                }
            } else if (w == 6) {
                float sq = 0.f, sk = 0.f;
#pragma unroll
                for (int c = 0; c < 16; ++c) { sq += ssq[c * 64 + lane]; sk += ssq[(16 + c) * 64 + lane]; }
                const float rq = 0.08838834764831845f / sqrtf(sq + EPS), rk = 1.0f / sqrtf(sk + EPS);
                const float blog = bf2f(braw), alog = bf2f(araw);
                if (ch + 1 < SEQ / 64) { const bf16_t* pr = proj + (rowbase + 64 + lane) * GIN_PAD + GCONV + GVDIM; braw = pr[hv]; araw = pr[GVH + hv]; }
                const float bet = sigmoid_f(blog);
                float g2 = -Aexp * softplus_f(alog + dtb) * 1.4426950408889634f;
#pragma unroll
                for (int o = 1; o < 64; o <<= 1) { const float t = __shfl_up(g2, o); if (lane >= o) g2 += t; }
                const float g2last = __shfl(g2, 63);
                const float eg = __builtin_amdgcn_exp2f(g2);
                sc[SC_BETA + lane] = bet; sc[SC_RK + lane] = rk; sc[SC_RQ + lane] = rq; sc[SC_G2 + lane] = g2;
                sc[SC_AK + lane] = rk * eg; sc[SC_BQ + lane] = rq * eg; sc[SC_EV + lane] = rk * __builtin_amdgcn_exp2f(g2last - g2);
                if (lane == 0) sc[SC_DL] = __builtin_amdgcn_exp2f(g2last);
            }
            __syncthreads();
            GDN_FRESH();
            if (w < 6) {
                const int i = 32 * bib + r32;
                const float g2i = sc[SC_G2 + i];
                const float fi = w < 3 ? sc[SC_BETA + i] * sc[SC_RK + i] : sc[SC_RQ + i];
                float val[16];
#pragma unroll
                for (int r = 0; r < 16; ++r) {
                    const int j = 32 * bjb + crow(r, hi);
                    const float dec = __builtin_amdgcn_exp2f(fminf(g2i - sc[SC_G2 + j], 0.f));
                    const bool keep = w < 3 ? (j < i) : (j <= i);
                    val[r] = keep ? fi * sc[SC_RK + j] * accB[r] * dec : 0.f;
                }
                if (w < 3) {
#pragma unroll
                    for (int g = 0; g < 4; ++g) *(LAS f32x4*)(L + L_LP + (i * 64 + 32 * bjb + 8 * g + 4 * hi) * 4) = (f32x4){val[4 * g], val[4 * g + 1], val[4 * g + 2], val[4 * g + 3]};
                } else {
#pragma unroll
                    for (int g = 0; g < 4; ++g) *(LAS u32x2*)(L + L_AQ + off64(i, 4 * bjb + g) + 8 * hi) = (u32x2){cvtpk(val[4 * g], val[4 * g + 1]), cvtpk(val[4 * g + 2], val[4 * g + 3])};
                }
            }
            { const u32x4* zp = (const u32x4*)(proj + (rowbase + (tid >> 3)) * GIN_PAD + GCONV + hv * HD + (tid & 7) * 16); zreg[0] = zp[0]; zreg[1] = zp[1]; }
            __syncthreads();
            GDN_FRESH();
            if (ch + 1 < SEQ / 64) GDN_LOADPRE(ch + 1);
            f32x16 ksacc = {}, qsacc = {};
#pragma unroll
            for (int s = 0; s < 8; ++s) {
                const bf16x8 ak = *(const LAS bf16x8*)(L + L_KU + off_b(32 * tb + r32, 2 * s + hi));
                const bf16x8 aq = *(const LAS bf16x8*)(L + L_QU + off_b(32 * tb + r32, 2 * s + hi));
                const bf16x8 bs = *(const LAS bf16x8*)(L + L_ST + off_b(32 * vb + r32, 2 * s + hi));
                ksacc = __builtin_amdgcn_mfma_f32_32x32x16_bf16(ak, bs, ksacc, 0, 0, 0);
                qsacc = __builtin_amdgcn_mfma_f32_32x32x16_bf16(aq, bs, qsacc, 0, 0, 0);
            }
            GDN_FRESH();
            {
                LAS float* TRm = (LAS float*)(L + L_TR); LAS float* TTm = (LAS float*)(L + L_TT);
                const LAS float* Lm = (const LAS float*)(L + L_LP);
                const int c16 = lane & 15, q4 = lane >> 4;
                if (w < 4) {
                    const int bb = w;
                    float Tc[16];
#pragma unroll
                    for (int rb = 0; rb < 4; ++rb) {
                        f32x4 lr[4][4];
#pragma unroll
                        for (int r = 0; r < 4; ++r)
#pragma unroll
                            for (int ch4 = 0; ch4 < 4; ++ch4) if (ch4 <= rb) lr[r][ch4] = *(const LAS f32x4*)(Lm + (16 * bb + 4 * rb + r) * 64 + 16 * bb + 4 * ch4);
#pragma unroll
                        for (int r = 0; r < 4; ++r) {
                            const int row = 4 * rb + r;
                            float s0 = 0.f, s1 = 0.f;
#pragma unroll
                            for (int rp = 0; rp < 16; ++rp) if (rp < row) { const float lv = lr[r][rp >> 2][rp & 3]; if (rp & 1) s1 += lv * Tc[rp]; else s0 += lv * Tc[rp]; }
                            Tc[row] = (c16 == row ? 1.f : 0.f) - (s0 + s1);
                        }
                    }
#pragma unroll
                    for (int e = 0; e < 4; ++e) {
                        const float tv = q4 == 0 ? Tc[e] : q4 == 1 ? Tc[4 + e] : q4 == 2 ? Tc[8 + e] : Tc[12 + e];
                        const int row = 4 * q4 + e;
                        TRm[(bb * 16 + row) * 16 + c16] = tv;
                        TTm[(bb * 16 + c16) * 16 + row] = tv;
                        const int gi = 16 * bb + row, gj = 16 * bb + c16;
                        *(LAS bf16_t*)(L + L_TM + off64(gi, gj >> 3) + (gj & 7) * 2) = (bf16_t)f2bf(tv);
                    }
                } else if (w == 4) {
                    const int blk = lane >> 5, row = (lane >> 1) & 15, chh = lane & 1;
                    *(LAS u32x4*)(L + L_TM + off64(32 * blk + row, 4 * blk + 2 + chh)) = (u32x4){0u, 0u, 0u, 0u};
                }
                __syncthreads();
                GDN_FRESH();
                if (w < 3) {
                    const int jb = w, c16b = lane & 15, q4b = lane >> 4;
                    f32x4 Tk[4];
                    Tk[jb] = *(const LAS f32x4*)(TTm + (jb * 16 + c16b) * 16 + 4 * q4b);
#pragma unroll
                    for (int ib = 1; ib < 4; ++ib) if (ib > jb) {
                        f32x4 S = {0.f, 0.f, 0.f, 0.f};
#pragma unroll
                        for (int kb2 = 0; kb2 < 3; ++kb2) if (kb2 >= jb && kb2 < ib) {
                            const f32x4 a4 = *(const LAS f32x4*)(Lm + (16 * ib + c16b) * 64 + 16 * kb2 + 4 * q4b);
#pragma unroll
                            for (int e = 0; e < 4; ++e) S = __builtin_amdgcn_mfma_f32_16x16x4f32(a4[e], Tk[kb2][e], S, 0, 0, 0);
                        }
                        const f32x4 t4 = *(const LAS f32x4*)(TRm + (ib * 16 + c16b) * 16 + 4 * q4b);
                        f32x4 Tn = {0.f, 0.f, 0.f, 0.f};
#pragma unroll
                        for (int e = 0; e < 4; ++e) Tn = __builtin_amdgcn_mfma_f32_16x16x4f32(t4[e], S[e], Tn, 0, 0, 0);
                        Tn = -Tn; Tk[ib] = Tn;
#pragma unroll
                        for (int e = 0; e < 4; ++e) { const int gi = 16 * ib + 4 * q4b + e, gj = 16 * jb + c16b;
                            *(LAS bf16_t*)(L + L_TM + off64(gi, gj >> 3) + (gj & 7) * 2) = (bf16_t)f2bf(Tn[e]); }
                    }
                }
            }
            __syncthreads();
            GDN_FRESH();
            f32x16 oacc;
            {
                const int dv = 32 * vb + r32;
                float val[16];
#pragma unroll
                for (int r = 0; r < 16; ++r) {
                    const int tok = 32 * tb + crow(r, hi);
                    const float vv = bf2f(*(const LAS bf16_t*)(L + L_VV + off_b(tok, dv >> 3) + (dv & 7) * 2));
                    val[r] = sc[SC_BETA + tok] * (vv - sc[SC_AK + tok] * ksacc[r]);
                    oacc[r] = sc[SC_BQ + tok] * qsacc[r];
                }
#pragma unroll
                for (int g = 0; g < 4; ++g) *(LAS u32x2*)(L + L_RT + off64(dv, 4 * tb + g) + 8 * hi) = (u32x2){cvtpk(val[4 * g], val[4 * g + 1]), cvtpk(val[4 * g + 2], val[4 * g + 3])};
            }
            __syncthreads();
            GDN_FRESH();
            {
                f32x16 vn = {};
#pragma unroll
                for (int s = 0; s < 4; ++s) if (s < 2 || tb) {
                    const bf16x8 a = *(const LAS bf16x8*)(L + L_TM + off64(32 * tb + r32, 2 * s + hi));
                    const bf16x8 bq = *(const LAS bf16x8*)(L + L_RT + off64(32 * vb + r32, 2 * s + hi));
                    vn = __builtin_amdgcn_mfma_f32_32x32x16_bf16(a, bq, vn, 0, 0, 0);
                }
                const int dv = 32 * vb + r32;
#pragma unroll
                for (int g = 0; g < 4; ++g) {
                    float e[4];
#pragma unroll
                    for (int c = 0; c < 4; ++c) e[c] = vn[4 * g + c] * sc[SC_EV + 32 * tb + crow(4 * g + c, hi)];
                    *(LAS u32x2*)(L + L_VNT + off64(dv, 4 * tb + g) + 8 * hi) = (u32x2){cvtpk(vn[4 * g], vn[4 * g + 1]), cvtpk(vn[4 * g + 2], vn[4 * g + 3])};
                    *(LAS u32x2*)(L + L_VNTE + off64(dv, 4 * tb + g) + 8 * hi) = (u32x2){cvtpk(e[0], e[1]), cvtpk(e[2], e[3])};
                }
            }
            __syncthreads();
            GDN_FRESH();
            {
#pragma unroll
                for (int s = 0; s < 4; ++s) if (s < 2 || tb) {
                    const bf16x8 a = *(const LAS bf16x8*)(L + L_AQ + off64(32 * tb + r32, 2 * s + hi));
                    const bf16x8 bq = *(const LAS bf16x8*)(L + L_VNT + off64(32 * vb + r32, 2 * s + hi));
                    oacc = __builtin_amdgcn_mfma_f32_32x32x16_bf16(a, bq, oacc, 0, 0, 0);
                }
                const int dv = 32 * vb + r32;
#pragma unroll
                for (int r = 0; r < 16; ++r) *(LAS bf16_t*)(L + L_OB + (32 * tb + crow(r, hi)) * 256 + dv * 2) = (bf16_t)f2bf(oacc[r]);
            }
            GDN_FRESH();
            {
                const float dl = sc[SC_DL];
                Sacc[0] *= dl; Sacc[1] *= dl;
                const unsigned blk = (lane >> 4) & 1, q = (lane & 15) >> 2, p = lane & 3;
#pragma unroll
                for (int ks = 0; ks < 4; ++ks) {
                    const s16x4 t0v = tr_read(lbase + L_KU + off_b(16 * ks + 8 * hi + q, 4 * kb + 2 * blk + (p >> 1)) + 8 * (p & 1));
                    const s16x4 t1v = tr_read(lbase + L_KU + off_b(16 * ks + 8 * hi + 4 + q, 4 * kb + 2 * blk + (p >> 1)) + 8 * (p & 1));
                    const bf16x8 b0 = *(const LAS bf16x8*)(L + L_VNTE + off64(32 * vbase + r32, 2 * ks + hi));
                    const bf16x8 b1 = *(const LAS bf16x8*)(L + L_VNTE + off64(32 * (vbase + 1) + r32, 2 * ks + hi));
                    asm volatile("s_waitcnt lgkmcnt(0)" ::: "memory"); __builtin_amdgcn_sched_barrier(0);
                    const bf16x8 a = (bf16x8){t0v[0], t0v[1], t0v[2], t0v[3], t1v[0], t1v[1], t1v[2], t1v[3]};
                    Sacc[0] = __builtin_amdgcn_mfma_f32_32x32x16_bf16(a, b0, Sacc[0], 0, 0, 0);
                    Sacc[1] = __builtin_amdgcn_mfma_f32_32x32x16_bf16(a, b1, Sacc[1], 0, 0, 0);
                }
#pragma unroll
                for (int v2 = 0; v2 < 2; ++v2)
#pragma unroll
                    for (int g = 0; g < 4; ++g)
                        *(LAS u32x2*)(L + L_ST + off_b(32 * (vbase + v2) + r32, 4 * kb + g) + 8 * hi) = (u32x2){cvtpk(Sacc[v2][4 * g], Sacc[v2][4 * g + 1]), cvtpk(Sacc[v2][4 * g + 2], Sacc[v2][4 * g + 3])};
            }
            __syncthreads();
            GDN_FRESH();
            {
                const int tok = tid >> 3, seg = tid & 7;
                const u32x4 oa = *(const LAS u32x4*)(L + L_OB + tok * 256 + seg * 32), ob2 = *(const LAS u32x4*)(L + L_OB + tok * 256 + seg * 32 + 16);
                float o[16], z[16];
                const unsigned ow[8] = {oa.x, oa.y, oa.z, oa.w, ob2.x, ob2.y, ob2.z, ob2.w};
                const unsigned zw[8] = {zreg[0].x, zreg[0].y, zreg[0].z, zreg[0].w, zreg[1].x, zreg[1].y, zreg[1].z, zreg[1].w};
                float ss = 0.f;
#pragma unroll
                for (int e = 0; e < 8; ++e) { o[2 * e] = bf2f(ow[e] & 0xffffu); o[2 * e + 1] = bf2f(ow[e] >> 16); z[2 * e] = bf2f(zw[e] & 0xffffu); z[2 * e + 1] = bf2f(zw[e] >> 16);
                    ss += o[2 * e] * o[2 * e] + o[2 * e + 1] * o[2 * e + 1]; }
                const float r = 1.0f / sqrtf(dpp_add8(ss) * (1.f / HD) + EPS);
                unsigned res[8];
#pragma unroll
                for (int e = 0; e < 8; ++e) { const f32x2 gg = *(const LAS f32x2*)(sc + SC_GAIN + seg * 16 + 2 * e);
                    res[e] = pk2(o[2 * e] * r * gg.x * silu_f(z[2 * e]), o[2 * e + 1] * r * gg.y * silu_f(z[2 * e + 1])); }
                u32x4* op = (u32x4*)(og + (rowbase + tok) * GVDIM + hv * HD + seg * 16);
                op[0] = (u32x4){res[0], res[1], res[2], res[3]}; op[1] = (u32x4){res[4], res[5], res[6], res[7]};
            }
        }
#undef GDN_LOADPRE
    }
}
#undef GDN_FRESH

struct MoeBufs { int* blk_cnt; int* pad_start; int* tok_e; float* tok_w; int* tok_slot; };
__device__ __forceinline__ void p_moe_route(const Ctx& F, const float* h, const float* gain, const float* WR, const float* b_rg, const float* b_re, bf16_t* XN, const MoeBufs& mb) {
    constexpr int YS = D + 4;
    LAS float* y = (LAS float*)F.lds;
    LAS float* part = y + 16 * YS;
    LAS float* lgt = part + 8 * 16 * WRN;
    LAS int* lcnt = (LAS int*)(lgt + 16 * 40);
    static_assert((16 * YS + 8 * 16 * WRN + 16 * 40 + 32) * 4 <= LDSCTL_OFF, "route lds");
    constexpr int TPB = 64;
    const int lane = F.lane, w = F.wave;
    for (int blk = F.bid; blk < T / TPB; blk += F.G) {
        if (F.tid < NE) lcnt[F.tid] = 0;
        __syncthreads();
        for (int rd = 0; rd < 4; ++rd) {
#pragma unroll
            for (int q = 0; q < 2; ++q) {
                const int tl = 2 * w + q, t = blk * TPB + rd * 16 + tl;
                const f32x4* xr = (const f32x4*)(h + (size_t)t * D) + 2 * lane;
                f32x4 v[8]; float s = 0.f;
#pragma unroll
                for (int j = 0; j < 8; ++j) { v[j] = xr[128 * (j >> 1) + (j & 1)]; s += (v[j].x * v[j].x + v[j].y * v[j].y) + (v[j].z * v[j].z + v[j].w * v[j].w); }
                const float r = 1.0f / sqrtf(wave_sum(s) * (1.f / D) + EPS);
                u32x4* o16 = (u32x4*)(XN + (size_t)t * D) + lane;
#pragma unroll
                for (int j = 0; j < 4; ++j) {
                    const f32x4 a = v[2 * j] * r * ((const f32x4*)gain)[128 * j + 2 * lane], b = v[2 * j + 1] * r * ((const f32x4*)gain)[128 * j + 2 * lane + 1];
                    o16[64 * j] = (u32x4){pk2(a.x, a.y), pk2(a.z, a.w), pk2(b.x, b.y), pk2(b.z, b.w)};
                    LAS f32x4* yp = (LAS f32x4*)(y + tl * YS + 8 * (64 * j + lane)); yp[0] = a; yp[1] = b; }
            }
            __syncthreads();
            {
                f32x4 acc0 = {0.f, 0.f, 0.f, 0.f}, acc1 = acc0, acc2 = acc0;
                const LAS float* ya = y + (lane & 15) * YS + 256 * w + 4 * (lane >> 4);
                const float* wb = WR + ((size_t)(64 * w + (lane >> 4)) * WRN + (lane & 15)) * 4;
#pragma unroll 4
                for (int j = 0; j < 16; ++j) {
                    const f32x4 a4 = *(const LAS f32x4*)(ya + 16 * j);
                    const f32x4 b0 = *(const f32x4*)(wb + (size_t)(4 * j) * WRN * 4), b1 = *(const f32x4*)(wb + (size_t)(4 * j) * WRN * 4 + 64), b2 = *(const f32x4*)(wb + (size_t)(4 * j) * WRN * 4 + 128);
#pragma unroll
                    for (int e = 0; e < 4; ++e) {
                        acc0 = __builtin_amdgcn_mfma_f32_16x16x4f32(a4[e], b0[e], acc0, 0, 0, 0);
                        acc1 = __builtin_amdgcn_mfma_f32_16x16x4f32(a4[e], b1[e], acc1, 0, 0, 0);
                        acc2 = __builtin_amdgcn_mfma_f32_16x16x4f32(a4[e], b2[e], acc2, 0, 0, 0);
                    }
                }
#pragma unroll
                for (int r = 0; r < 4; ++r) { LAS float* pp = part + (w * 16 + 4 * (lane >> 4) + r) * WRN + (lane & 15);
                    pp[0] = acc0[r]; pp[16] = acc1[r]; pp[32] = acc2[r]; }
            }
            __syncthreads();
            for (int idx = F.tid; idx < 16 * 36; idx += 512) {
                const int tok = idx / 36, n = idx % 36;
                float s = 0.f;
#pragma unroll
                for (int ww = 0; ww < 8; ++ww) s += part[(ww * 16 + tok) * WRN + n];
                lgt[tok * 40 + n] = s + (n < NGRP ? b_rg[n] : b_re[n - NGRP]);
            }
            __syncthreads();
#pragma unroll
            for (int q = 0; q < 2; ++q) {
                const int tl = 2 * w + q, t = blk * TPB + rd * 16 + tl;
                const LAS float* lg = lgt + tl * 40;
                int gi = 0; float gm = lg[0];
#pragma unroll
                for (int i = 1; i < NGRP; ++i) { const float v = lg[i]; if (v > gm) { gm = v; gi = i; } }
                float den = 0.f;
#pragma unroll
                for (int i = 0; i < NGRP; ++i) den += __expf(lg[i] - gm);
                const float gval = 1.0f / den;
                const LAS float* le = lg + NGRP + gi * EPG;
                int i1 = 0; float l1 = le[0];
#pragma unroll
                for (int i = 1; i < EPG; ++i) { const float v = le[i]; if (v > l1) { l1 = v; i1 = i; } }
                int i2 = -1; float l2 = -3.0e38f;
#pragma unroll
                for (int i = 0; i < EPG; ++i) { const float v = le[i]; if (i != i1 && v > l2) { l2 = v; i2 = i; } }
                const float ex = __expf(l2 - l1), w1 = 1.0f / (1.0f + ex), w2 = ex / (1.0f + ex);
                if (lane == 0) {
                    const int e1 = gi * EPG + i1, e2 = gi * EPG + i2;
                    const int p1 = atomicAdd((int*)&lcnt[e1], 1), p2 = atomicAdd((int*)&lcnt[e2], 1);
                    mb.tok_e[2 * t] = e1 | (p1 << 8); mb.tok_e[2 * t + 1] = e2 | (p2 << 8);
                    mb.tok_w[2 * t] = gval * w1; mb.tok_w[2 * t + 1] = gval * w2;
                }
            }
        }
        __syncthreads();
        if (F.tid < NE) mb.blk_cnt[blk * NE + F.tid] = lcnt[F.tid];
        __syncthreads();
    }
}
__device__ __forceinline__ void p_moe_scatter(const Ctx& F, const bf16_t* XN, bf16_t* XS, const MoeBufs& mb) {
    LAS int* tot = (LAS int*)F.lds;
    LAS int* base = tot + 32;
    LAS int* pst = base + 32;
    constexpr int TPB = 64, NBLK = T / TPB;
    for (int blk = F.bid; blk < NBLK; blk += F.G) {
        if (F.tid < NE) { int s = 0, bs = 0; for (int j = 0; j < NBLK; ++j) { const int c = mb.blk_cnt[j * NE + F.tid]; s += c; bs += (j < blk) ? c : 0; } tot[F.tid] = s; base[F.tid] = bs; }
        __syncthreads();
        if (F.tid == 0) { int s = 0; for (int e = 0; e < NE; ++e) { pst[e] = s; s += (tot[e] + 255) & ~255; } pst[NE] = s;
            if (blk == 0) for (int e = 0; e <= NE; ++e) mb.pad_start[e] = pst[e]; }
        __syncthreads();
        for (int a = F.wave; a < 2 * TPB; a += 8) {
            const int ai = blk * 2 * TPB + a, t = ai >> 1;
            const int ep = mb.tok_e[ai], e = ep & 0xff, lp = ep >> 8;
            const int slot = pst[e] + base[e] + lp;
            const u32x4* src = (const u32x4*)(XN + (size_t)t * D) + F.lane; u32x4* dst = (u32x4*)(XS + (size_t)slot * D) + F.lane;
#pragma unroll
            for (int j = 0; j < 4; ++j) dst[64 * j] = src[64 * j];
            if (F.lane == 0) mb.tok_slot[ai] = slot;
        }
        __syncthreads();
    }
}
__device__ __forceinline__ void moe_units(const Ctx& F, const MoeBufs& mb, int nN, pg8::ListOrder& S) {
    LAS int* pst = (LAS int*)(F.lds + LDSCTL_OFF + 256);
    if (F.tid <= NE) pst[F.tid] = mb.pad_start[F.tid];
    __syncthreads();
    const int nmt = pst[NE] / 256, n = nmt * nN;
    int d[8]; int cnt = 0;
#pragma unroll
    for (int i = 0; i < 8; ++i) {
        const int L = i * F.G + F.bid; d[i] = 0;
        if (L < n) {
            int wgid = L; { const int q = n / 8, r = n % 8, xcd = wgid % 8, off = wgid / 8; wgid = (xcd < r ? xcd * (q + 1) : r * (q + 1) + (xcd - r) * q) + off; }
            const int mt = wgid / nN, pn = wgid % nN;
            int e = 0; for (int j = 1; j <= NE - 1; ++j) e += (pst[j] <= mt * 256) ? 1 : 0;
            d[i] = __builtin_amdgcn_readfirstlane(mt | (pn << 12) | ((e * nN + pn) << 16)); cnt = i + 1;
        }
    }
    S.n = __builtin_amdgcn_readfirstlane(cnt); S.d0 = d[0]; S.d1 = d[1]; S.d2 = d[2]; S.d3 = d[3]; S.d4 = d[4]; S.d5 = d[5]; S.d6 = d[6]; S.d7 = d[7];
    __syncthreads();
}
__device__ __forceinline__ void moe_gather_prep(const Ctx& F, const MoeBufs& mb, int nN, pg8::ListOrder& S, LAS int* rowtok) {
    constexpr int TPB = 64, NBLK = T / TPB;
    LAS int* base = (LAS int*)F.lds;
    LAS int* segsum = base + NBLK * NE;
    LAS int* segoff = segsum + 16 * NE;
    LAS int* pst = segoff + 16 * NE;
    LAS int* umt = pst + 64;
    {   const int e = F.tid & 31, seg = F.tid >> 5; int s = 0;
        for (int j = seg * 16; j < seg * 16 + 16; ++j) { base[j * NE + e] = s; s += mb.blk_cnt[j * NE + e]; }
        segsum[seg * NE + e] = s; }
    __syncthreads();
    if (F.tid < NE) { int run = 0; for (int sg = 0; sg < 16; ++sg) { segoff[sg * NE + F.tid] = run; run += segsum[sg * NE + F.tid]; } segsum[F.tid] = run; }
    __syncthreads();
    if (F.tid == 0) { int s = 0; for (int e = 0; e < NE; ++e) { pst[e] = s; s += (segsum[e] + 255) & ~255; } pst[NE] = s;
        if (F.bid == 0) for (int e = 0; e <= NE; ++e) mb.pad_start[e] = pst[e]; }
    for (int i = F.tid; i < 8 * 256; i += 512) rowtok[i] = 0;
    __syncthreads();
    const int nmt = pst[NE] / 256, n = nmt * nN;
    int d[8]; int cnt = 0;
#pragma unroll
    for (int i = 0; i < 8; ++i) {
        const int Lq = i * F.G + F.bid; d[i] = 0;
        if (Lq < n) {
            int wgid = Lq; { const int q = n / 8, r = n % 8, xcd = wgid % 8, off = wgid / 8; wgid = (xcd < r ? xcd * (q + 1) : r * (q + 1) + (xcd - r) * q) + off; }
            const int mt = wgid / nN, pn = wgid % nN;
            int e = 0; for (int j = 1; j <= NE - 1; ++j) e += (pst[j] <= mt * 256) ? 1 : 0;
            d[i] = __builtin_amdgcn_readfirstlane(mt | (pn << 12) | ((e * nN + pn) << 16)); cnt = i + 1;
            if (F.tid == 0) umt[i] = mt;
        } else if (F.tid == 0) umt[i] = -1;
    }
    S.n = __builtin_amdgcn_readfirstlane(cnt); S.d0 = d[0]; S.d1 = d[1]; S.d2 = d[2]; S.d3 = d[3]; S.d4 = d[4]; S.d5 = d[5]; S.d6 = d[6]; S.d7 = d[7];
    __syncthreads();
    int um[8];
#pragma unroll
    for (int i = 0; i < 8; ++i) um[i] = umt[i];
    for (int a = F.tid; a < 2 * T; a += 512) {
        const int ep = mb.tok_e[a], e = ep & 0xff, lp = ep >> 8, blk = a >> 7;
        const int slot = pst[e] + segoff[(blk >> 4) * NE + e] + base[blk * NE + e] + lp;
        if (blk % F.G == F.bid) mb.tok_slot[a] = slot;
        const int mt = slot >> 8;
#pragma unroll
        for (int i = 0; i < 8; ++i) if (mt == um[i]) rowtok[i * 256 + (slot & 255)] = a >> 1;
    }
    __syncthreads();
}

__device__ __forceinline__ void p_moe_combine(const Ctx& F, float* h, const bf16_t* YS, const MoeBufs& mb, bf16_t* XN) {
    const int gw = F.bid * 8 + F.wave, NGW = F.G * 8;
    for (int t = gw; t < T; t += NGW) {
        const int s0 = mb.tok_slot[2 * t], s1 = mb.tok_slot[2 * t + 1]; const float w0 = mb.tok_w[2 * t], w1 = mb.tok_w[2 * t + 1];
        f32x4* hr = (f32x4*)(h + (size_t)t * D) + 2 * F.lane;
        const u32x4* y0 = (const u32x4*)(YS + (size_t)s0 * D) + F.lane; const u32x4* y1 = (const u32x4*)(YS + (size_t)s1 * D) + F.lane;
        f32x4 v[8]; float s = 0.f;
#pragma unroll
        for (int j = 0; j < 4; ++j) { const u32x4 a = y0[64 * j], b = y1[64 * j];
            f32x4 lo = hr[128 * j], hi4 = hr[128 * j + 1];
            lo.x += w0 * bf2f(a.x & 0xffffu) + w1 * bf2f(b.x & 0xffffu); lo.y += w0 * bf2f(a.x >> 16) + w1 * bf2f(b.x >> 16);
            lo.z += w0 * bf2f(a.y & 0xffffu) + w1 * bf2f(b.y & 0xffffu); lo.w += w0 * bf2f(a.y >> 16) + w1 * bf2f(b.y >> 16);
            hi4.x += w0 * bf2f(a.z & 0xffffu) + w1 * bf2f(b.z & 0xffffu); hi4.y += w0 * bf2f(a.z >> 16) + w1 * bf2f(b.z >> 16);
            hi4.z += w0 * bf2f(a.w & 0xffffu) + w1 * bf2f(b.w & 0xffffu); hi4.w += w0 * bf2f(a.w >> 16) + w1 * bf2f(b.w >> 16);
            hr[128 * j] = lo; hr[128 * j + 1] = hi4; v[2 * j] = lo; v[2 * j + 1] = hi4;
            s += (lo.x * lo.x + lo.y * lo.y) + (lo.z * lo.z + lo.w * lo.w) + (hi4.x * hi4.x + hi4.y * hi4.y) + (hi4.z * hi4.z + hi4.w * hi4.w); }
        if (XN) { const float r = 1.0f / sqrtf(wave_sum(s) * (1.f / D) + EPS); u32x4* o16 = (u32x4*)(XN + (size_t)t * D) + F.lane;
#pragma unroll
            for (int j = 0; j < 4; ++j) o16[64 * j] = (u32x4){pk2(v[2 * j].x * r, v[2 * j].y * r), pk2(v[2 * j].z * r, v[2 * j].w * r), pk2(v[2 * j + 1].x * r, v[2 * j + 1].y * r), pk2(v[2 * j + 1].z * r, v[2 * j + 1].w * r)}; }
    }
}
__device__ __forceinline__ void p_qk_norm(const Ctx& F, bf16_t* kvq, const float* k_gain, const float* q_gain) {
    const int gw = F.bid * 8 + F.wave, NGW = F.G * 8;
    for (int r = gw; r < T * 2 * SBH; r += NGW) {
        const int t = r / (2 * SBH), hh = r % (2 * SBH); const bool isq = hh >= SBH;
        unsigned* p = (unsigned*)(kvq + (size_t)t * KVQ + (isq ? 2 * SBDIM + (hh - SBH) * HD : hh * HD)) + F.lane;
        const unsigned u = *p; const float a = bf2f(u & 0xffffu), b = bf2f(u >> 16);
        const float rr = 1.0f / sqrtf(wave_sum(a * a + b * b) * (1.f / HD) + EPS);
        const float* g = isq ? q_gain : k_gain;
        const float qs = isq ? 0.12751743082459868f : 1.0f;
        *p = pk2(a * rr * g[2 * F.lane] * qs, b * rr * g[2 * F.lane + 1] * qs);
    }
}
__device__ __forceinline__ void p_sb_attn_ref(const Ctx& F, const bf16_t* kvq, bf16_t* ao) {
    LAS float* Kt = (LAS float*)F.lds;
    LAS float* Vt = Kt + 64 * HD;
    const int il = F.tid >> 1, half = F.tid & 1;
    for (int unit = F.bid; unit < BATCH * SBH * 4; unit += F.G) {
        const int p = unit & 3, bh = unit >> 2, b = bh / SBH, hh = bh % SBH;
        for (int side = 0; side < 2; ++side) {
            const int qb = side == 0 ? 7 - p : p;
            const int i = qb * 256 + il;
            float q[64], o[64];
            { const u32x4* qp = (const u32x4*)(kvq + (size_t)(b * SEQ + i) * KVQ + 2 * SBDIM + hh * HD + half * 64);
#pragma unroll
              for (int j = 0; j < 8; ++j) { const u32x4 u = qp[j];
                  q[8 * j + 0] = bf2f(u.x & 0xffffu); q[8 * j + 1] = bf2f(u.x >> 16); q[8 * j + 2] = bf2f(u.y & 0xffffu); q[8 * j + 3] = bf2f(u.y >> 16);
                  q[8 * j + 4] = bf2f(u.z & 0xffffu); q[8 * j + 5] = bf2f(u.z >> 16); q[8 * j + 6] = bf2f(u.w & 0xffffu); q[8 * j + 7] = bf2f(u.w >> 16); } }
#pragma unroll
            for (int d = 0; d < 64; ++d) { q[d] *= 0.08838834764831845f; o[d] = 0.f; }
            float csum = 0.f;
            for (int kt = qb * 4 + 3; kt >= 0; --kt) {
                __syncthreads();
                for (int idx = F.tid; idx < 64 * 16 * 2; idx += 512) {
                    const int which = idx / 1024, r = (idx / 16) % 64, c8 = idx % 16;
                    const u32x4 u = *(const u32x4*)(kvq + (size_t)(b * SEQ + kt * 64 + r) * KVQ + which * SBDIM + hh * HD + c8 * 8);
                    LAS float* dst = (which ? Vt : Kt) + r * HD + c8 * 8;
                    dst[0] = bf2f(u.x & 0xffffu); dst[1] = bf2f(u.x >> 16); dst[2] = bf2f(u.y & 0xffffu); dst[3] = bf2f(u.y >> 16);
                    dst[4] = bf2f(u.z & 0xffffu); dst[5] = bf2f(u.z >> 16); dst[6] = bf2f(u.w & 0xffffu); dst[7] = bf2f(u.w >> 16);
                }
                __syncthreads();
                for (int jl = 63; jl >= 0; --jl) {
                    const int j = kt * 64 + jl;
                    if (j < i) {
                        const LAS f32x4* kp = (const LAS f32x4*)(Kt + jl * HD + half * 64);
                        float z = 0.f;
#pragma unroll
                        for (int d = 0; d < 16; ++d) { const f32x4 kk = kp[d]; z += q[4 * d] * kk.x + q[4 * d + 1] * kk.y + q[4 * d + 2] * kk.z + q[4 * d + 3] * kk.w; }
                        z += __shfl_xor(z, 1);
                        csum -= softplus_f(z);
                        const float w = __expf(z + csum);
                        const LAS f32x4* vp = (const LAS f32x4*)(Vt + jl * HD + half * 64);
#pragma unroll
                        for (int d = 0; d < 16; ++d) { const f32x4 vv = vp[d]; o[4 * d] += w * vv.x; o[4 * d + 1] += w * vv.y; o[4 * d + 2] += w * vv.z; o[4 * d + 3] += w * vv.w; }
                    }
                }
            }
            u32x4* op = (u32x4*)(ao + (size_t)(b * SEQ + i) * SBDIM + hh * HD + half * 64);
#pragma unroll
            for (int j = 0; j < 8; ++j) { u32x4 w; w.x = pk2(o[8 * j], o[8 * j + 1]); w.y = pk2(o[8 * j + 2], o[8 * j + 3]); w.z = pk2(o[8 * j + 4], o[8 * j + 5]); w.w = pk2(o[8 * j + 6], o[8 * j + 7]); op[j] = w; }
        }
    }
}


namespace sba {
typedef float f32x16 __attribute__((ext_vector_type(16)));
typedef short s16x4 __attribute__((ext_vector_type(4)));
constexpr int SHM_V = 64 * HD * 2, SHM_K = 64 * HD * 2;
#define SBA_KSWZ(row, colB) ((row) * 256 + ((colB) ^ (((row) & 7) << 4)))
__device__ __forceinline__ int crow(int r, int hi) { return (r & 3) + 8 * (r >> 2) + 4 * hi; }
__device__ __forceinline__ unsigned cvtpk(float lo, float hi) { return pk2(lo, hi); }
__device__ __forceinline__ void qkt(f32x16& p0, f32x16& p1, const LAS char* Ks, const bf16x8* qr, int r32, int hi) {
    p0 = f32x16{}; p1 = f32x16{};
#pragma unroll
    for (int d0 = 0; d0 < 8; ++d0) { const int cb = (d0 * 16 + hi * 8) * 2;
        const bf16x8 b0 = *(const LAS bf16x8*)(Ks + SBA_KSWZ(r32, cb));
        const bf16x8 b1 = *(const LAS bf16x8*)(Ks + SBA_KSWZ(32 + r32, cb));
        p0 = __builtin_amdgcn_mfma_f32_32x32x16_bf16(b0, qr[d0], p0, 0, 0, 0);
        p1 = __builtin_amdgcn_mfma_f32_32x32x16_bf16(b1, qr[d0], p1, 0, 0, 0); }
}
__device__ __forceinline__ int v_st(int k, int c) { const int kk = (k & ~0xC) | ((k & 4) << 1) | ((k & 8) >> 1); return ((kk >> 3) * 4 + (c >> 5)) * 512 + ((kk & 7) * 32 + (c & 31)) * 2; }
__device__ __forceinline__ int v_rd_base(int lane) { return ((lane & 3) << 3) | (((lane >> 2) & 3) << 6) | (((lane >> 4) & 1) << 5) | (((lane >> 5) & 1) << 8); }
constexpr int v_rd_off(int d0, int ks, int half) { return d0 * 512 + ks * 4096 + half * 2048; }
template <int OFF> __device__ __forceinline__ s16x4 tr_read(int vb) { s16x4 r; asm volatile("ds_read_b64_tr_b16 %0, %1 offset:%2" : "=&v"(r) : "v"(vb), "i"(OFF) : "memory"); return r; }
template <int D0> __device__ __forceinline__ void pv_one(f32x16& od, int vb, bf16x8 pa0, bf16x8 pa1, bf16x8 pa2, bf16x8 pa3) {
    const s16x4 l0 = tr_read<v_rd_off(D0, 0, 0)>(vb), h0 = tr_read<v_rd_off(D0, 0, 1)>(vb), l1 = tr_read<v_rd_off(D0, 1, 0)>(vb), h1 = tr_read<v_rd_off(D0, 1, 1)>(vb);
    const s16x4 l2 = tr_read<v_rd_off(D0, 2, 0)>(vb), h2 = tr_read<v_rd_off(D0, 2, 1)>(vb), l3 = tr_read<v_rd_off(D0, 3, 0)>(vb), h3 = tr_read<v_rd_off(D0, 3, 1)>(vb);
    asm volatile("s_waitcnt lgkmcnt(0)" ::: "memory"); __builtin_amdgcn_sched_barrier(0);
#define SBA_PK(L, H) (bf16x8){L[0], L[1], L[2], L[3], H[0], H[1], H[2], H[3]}
    od = __builtin_amdgcn_mfma_f32_32x32x16_bf16(pa0, SBA_PK(l0, h0), od, 0, 0, 0);
    od = __builtin_amdgcn_mfma_f32_32x32x16_bf16(pa1, SBA_PK(l1, h1), od, 0, 0, 0);
    od = __builtin_amdgcn_mfma_f32_32x32x16_bf16(pa2, SBA_PK(l2, h2), od, 0, 0, 0);
    od = __builtin_amdgcn_mfma_f32_32x32x16_bf16(pa3, SBA_PK(l3, h3), od, 0, 0, 0);
#undef SBA_PK
}
__device__ __forceinline__ void sb_weights(f32x16& p0, f32x16& p1, float& carry, float hmask, bf16x8& pa0, bf16x8& pa1, bf16x8& pa2, bf16x8& pa3) {
    f32x16 l0, l1;
#pragma unroll
    for (int r = 0; r < 16; ++r) {
        const float t0 = __builtin_amdgcn_exp2f(fminf(p0[r], 64.f)), t1 = __builtin_amdgcn_exp2f(fminf(p1[r], 64.f));
        l0[r] = __builtin_amdgcn_rcpf(1.0f + t0); l1[r] = __builtin_amdgcn_rcpf(1.0f + t1);
        p0[r] = t0 * l0[r]; p1[r] = t1 * l1[r];
    }
#pragma unroll
    for (int m = 0; m < 4; ++m) {
        p0[4 * m + 2] *= l0[4 * m + 3]; l0[4 * m + 2] *= l0[4 * m + 3]; p0[4 * m + 1] *= l0[4 * m + 2]; l0[4 * m + 1] *= l0[4 * m + 2]; p0[4 * m] *= l0[4 * m + 1]; l0[4 * m] *= l0[4 * m + 1];
        p1[4 * m + 2] *= l1[4 * m + 3]; l1[4 * m + 2] *= l1[4 * m + 3]; p1[4 * m + 1] *= l1[4 * m + 2]; l1[4 * m + 1] *= l1[4 * m + 2]; p1[4 * m] *= l1[4 * m + 1]; l1[4 * m] *= l1[4 * m + 1];
    }
    float Pm[8], Om[8];
#pragma unroll
    for (int m = 0; m < 8; ++m) {
        const float tm = m < 4 ? l0[4 * m] : l1[4 * (m - 4)];
        auto rr = __builtin_amdgcn_permlane32_swap(__float_as_uint(tm), __float_as_uint(tm), false, false);
        const float e = __uint_as_float(rr[0]), o = __uint_as_float(rr[1]);
        Pm[m] = e * o; Om[m] = hmask * o + (1.0f - hmask);
    }
    float sp = carry;
#pragma unroll
    for (int m = 7; m >= 0; --m) {
        const float off = sp * Om[m];
        if (m < 4) {
#pragma unroll
            for (int j = 0; j < 4; ++j) p0[4 * m + j] *= off;
        } else {
#pragma unroll
            for (int j = 0; j < 4; ++j) p1[4 * (m - 4) + j] *= off;
        }
        sp *= Pm[m];
    }
    carry = sp;
#define SBA_PK4(P, BASE, OUT) do { unsigned a0 = cvtpk(P[BASE + 0], P[BASE + 1]), a1 = cvtpk(P[BASE + 2], P[BASE + 3]); \
    unsigned b0 = cvtpk(P[BASE + 4], P[BASE + 5]), b1 = cvtpk(P[BASE + 6], P[BASE + 7]); \
    auto r0 = __builtin_amdgcn_permlane32_swap(a0, b0, false, false); auto r1 = __builtin_amdgcn_permlane32_swap(a1, b1, false, false); \
    u32x4 w = {r0[0], r1[0], r0[1], r1[1]}; OUT = *reinterpret_cast<bf16x8*>(&w); } while (0)
    SBA_PK4(p0, 0, pa0); SBA_PK4(p0, 8, pa1); SBA_PK4(p1, 0, pa2); SBA_PK4(p1, 8, pa3);
#undef SBA_PK4
}
}

__device__ __forceinline__ void p_sb_attn(const Ctx& F, const bf16_t* kvq, bf16_t* ao) {
    using namespace sba;
    LAS char* V_lds = (LAS char*)F.lds; LAS char* K_lds = V_lds + 2 * SHM_V;
    const int tid = F.tid, wid = F.wave, lane = F.lane, r32 = lane & 31, hi = lane >> 5;
    const int sr = tid >> 4, sc = (tid & 15) * 8, vst0 = v_st(sr, sc), vst1 = v_st(32 + sr, sc);
    const int vb0 = (int)(unsigned)(size_t)V_lds + v_rd_base(lane);
    const float hmask = hi ? 0.f : 1.f;
    const int vcu = (F.G % 8 == 0) ? (F.bid % 8) * (F.G / 8) + F.bid / 8 : F.bid;
    for (int unit = vcu; unit < BATCH * SBH * 4; unit += F.G) {
        const int p = unit & 3, bh = unit >> 2, b = bh / SBH, hh = bh % SBH;
        const bf16_t* Kh = kvq + (size_t)(b * SEQ) * KVQ + hh * HD; const bf16_t* Vh = Kh + SBDIM; const bf16_t* Qh = Kh + 2 * SBDIM;
        for (int side = 0; side < 2; ++side) {
            const int qb = side == 0 ? 7 - p : p;
            const int i0 = qb * 256 + wid * 32;
            bf16x8 qr[8];
            { const bf16_t* Qw = Qh + (size_t)(i0 + r32) * KVQ + hi * 8;
#pragma unroll
              for (int d0 = 0; d0 < 8; ++d0) qr[d0] = *(const bf16x8*)(Qw + d0 * 16); }
            f32x16 o[4] = {};
            float carry = 1.f;
            const int NT = 4 * qb + 4;
            bf16x8 vs0, vs1, ks0, ks1;
#define SBA_SLOAD(k0) do { vs0 = *(const bf16x8*)(Vh + (size_t)((k0) + sr) * KVQ + sc); vs1 = *(const bf16x8*)(Vh + (size_t)((k0) + 32 + sr) * KVQ + sc); \
    ks0 = *(const bf16x8*)(Kh + (size_t)((k0) + sr) * KVQ + sc); ks1 = *(const bf16x8*)(Kh + (size_t)((k0) + 32 + sr) * KVQ + sc); } while (0)
#define SBA_SWRITE(bf) do { *(LAS bf16x8*)(V_lds + (bf) * SHM_V + vst0) = vs0; *(LAS bf16x8*)(V_lds + (bf) * SHM_V + vst1) = vs1; const int kc = sc * 2; \
    *(LAS bf16x8*)(K_lds + (bf) * SHM_K + SBA_KSWZ(sr, kc)) = ks0; *(LAS bf16x8*)(K_lds + (bf) * SHM_K + SBA_KSWZ(32 + sr, kc)) = ks1; } while (0)
            __syncthreads();
            SBA_SLOAD((NT - 1) * 64); SBA_SWRITE(0);
            if (NT > 1) SBA_SLOAD((NT - 2) * 64);
            __syncthreads();
            for (int n = 0; n < NT; ++n) {
                const int kt = NT - 1 - n, buf = n & 1;
                if (n + 1 < NT) { SBA_SWRITE(buf ^ 1); if (n + 2 < NT) SBA_SLOAD((kt - 2) * 64); }
                if (64 * kt < i0 + 31) {
                    f32x16 p0, p1;
                    qkt(p0, p1, K_lds + buf * SHM_K, qr, r32, hi);
                    if (64 * kt + 63 >= i0) {
                        const int irow = i0 + r32;
#pragma unroll
                        for (int r = 0; r < 16; ++r) { const int j = 64 * kt + crow(r, hi); p0[r] = (j < irow) ? p0[r] : -1.0e30f; p1[r] = (j + 32 < irow) ? p1[r] : -1.0e30f; }
                    }
                    bf16x8 pa0, pa1, pa2, pa3;
                    sb_weights(p0, p1, carry, hmask, pa0, pa1, pa2, pa3);
                    const int vb = vb0 + buf * SHM_V;
                    pv_one<0>(o[0], vb, pa0, pa1, pa2, pa3); pv_one<1>(o[1], vb, pa0, pa1, pa2, pa3); pv_one<2>(o[2], vb, pa0, pa1, pa2, pa3); pv_one<3>(o[3], vb, pa0, pa1, pa2, pa3);
                }
                __syncthreads();
            }
#undef SBA_SLOAD
#undef SBA_SWRITE
            bf16_t* Ow = ao + (size_t)(b * SEQ + i0) * SBDIM + hh * HD;
#pragma unroll
            for (int r = 0; r < 16; ++r) { const int orow = crow(r, hi);
#pragma unroll
                for (int d0 = 0; d0 < 4; ++d0) Ow[(size_t)orow * SBDIM + d0 * 32 + r32] = (bf16_t)f2bf(o[d0][r]); }
        }
    }
}

constexpr int NPH = 18;
struct Args { const float* in[23]; float* out; unsigned char* ws; int ph_lo, ph_hi; };
__global__ void __launch_bounds__(512, 2) yoco_fwd(Args args) {
    extern __shared__ __attribute__((aligned(16))) unsigned char lds_raw[];
    Ctx F;
    F.lds = (LAS unsigned char*)lds_raw;
    F.tid = threadIdx.x; F.lane = F.tid & 63; F.wave = __builtin_amdgcn_readfirstlane(F.tid >> 6);
    F.G = gridDim.x; F.bid = blockIdx.x;
    unsigned char* ws = args.ws;
    const float* x = args.in[0];
    float* h = args.out;
    bf16_t* Win_t = (bf16_t*)(ws + WS_WIN); bf16_t* Wouta_t = (bf16_t*)(ws + WS_WOUTA); bf16_t* Wkvq_t = (bf16_t*)(ws + WS_WKVQ); bf16_t* Woutb_t = (bf16_t*)(ws + WS_WOUTB);
    bf16_t* Wgu_t = (bf16_t*)(ws + WS_WGU); bf16_t* Wd_t = (bf16_t*)(ws + WS_WD);
    bf16_t* XN = (bf16_t*)(ws + WS_XN); bf16_t* OG = (bf16_t*)(ws + WS_OG); bf16_t* PROJ = (bf16_t*)(ws + WS_BIG);
    bf16_t* XS = (bf16_t*)(ws + WS_XS); bf16_t* HB = (bf16_t*)(ws + WS_HB); bf16_t* YS = (bf16_t*)(ws + WS_YS);
    bf16_t* KVQB = (bf16_t*)(ws + WS_KVQ); bf16_t* AO = (bf16_t*)(ws + WS_AO);
    MoeBufs mb; mb.blk_cnt = (int*)(ws + WS_MISC + MI_BLKCNT); mb.pad_start = (int*)(ws + WS_MISC + MI_PADSTART); mb.tok_e = (int*)(ws + WS_MISC + MI_TOKE);
    mb.tok_w = (float*)(ws + WS_MISC + MI_TOKW); mb.tok_slot = (int*)(ws + WS_MISC + MI_TOKSLOT);

    for (int u = F.tid; u < (LDS_BYTES - LDSCTL_OFF) / 4; u += 512) ((LAS unsigned*)(F.lds + LDSCTL_OFF))[u] = 0u;
    __syncthreads();
    const int lo = args.ph_lo, hi = args.ph_hi;
    const bool multi = (hi - lo) > 1;
    XcdBarrier bar; bar.bar = (unsigned*)(ws + WS_CTL) + CW_BAR; bar.x = 0; bar.st = nullptr;
    if (multi) bar = xcd_barrier_post((unsigned*)(ws + WS_CTL) + CW_BAR, (volatile LAS unsigned*)(F.lds + LDSCTL_OFF));
#define IN(k) (lo <= (k) && (k) < hi)
#define SEAM(k) do { if (IN(k) && IN((k) + 1)) xcd_barrier(bar); } while (0)

    P0Args pa; pa.x = x; pa.norm_a = args.in[1]; pa.w_in = args.in[2]; pa.w_out_a = args.in[7]; pa.norm_kv = args.in[8]; pa.w_kv = args.in[9]; pa.norm_b = args.in[11]; pa.w_q = args.in[12];
    pa.w_out_b = args.in[14]; pa.w_gate = args.in[20]; pa.w_up = args.in[21]; pa.w_down = args.in[22]; pa.w_rg = args.in[16]; pa.w_re = args.in[18]; pa.WR = (float*)(ws + WS_WR);
    pa.Win_t = Win_t; pa.Wouta_t = Wouta_t; pa.Wkvq_t = Wkvq_t; pa.Woutb_t = Woutb_t; pa.Wgu_t = Wgu_t; pa.Wd_t = Wd_t; pa.XN = XN;
    if (IN(0)) { for (int rep = 0; rep < (MK_REP_PHASE == 0 ? 2 : 1); ++rep) p0_prologue(F, pa); }
    SEAM(0);
    if (IN(1)) {
        const int GG = F.G >= 128 ? F.G - 60 : F.G;
        if (F.bid < GG) {
            pg8::Gemm g{XN, Win_t, D}; pg8::StaticOrder S; S.init(T, GIN_PAD, GG, F.bid);
            pg8::EpiBf16 E{PROJ, GIN_PAD};
            pg8::gemm_phase<pg8::EpiBf16, pg8::StaticOrder>(F.lds, g, S, E);
            if (MK_REP_PHASE == 1) { __syncthreads(); pg8::gemm_phase<pg8::EpiBf16, pg8::StaticOrder>(F.lds, g, S, E); }
        }
        __syncthreads();
        p0_queue(F, pa, (unsigned*)(ws + WS_CTL) + CW_TICKET);
    }
    SEAM(1);
    if (IN(2)) { for (int rep = 0; rep < (MK_REP_PHASE == 2 ? 2 : 1); ++rep) p2_gdn(F, PROJ, args.in[3], args.in[4], args.in[5], args.in[6], OG); }
    SEAM(2);
    if (IN(3)) {
        pg8::Gemm g{OG, Wouta_t, GVDIM}; pg8::StaticOrder S; S.init(T, D, F.G, F.bid);
        pg8::EpiResF32 E{x, h, D};
        pg8::gemm_phase<pg8::EpiResF32, pg8::StaticOrder>(F.lds, g, S, E);
        if (MK_REP_PHASE == 3) { __syncthreads(); pg8::gemm_phase<pg8::EpiResF32, pg8::StaticOrder>(F.lds, g, S, E); }
    }
    SEAM(3);
#define MOE_PHASES(layer, pb, XNOUT) \
    if (IN(pb)) for (int rep = 0; rep < ((MK_REP_PHASE == 4 && (layer) == 0) ? 2 : 1); ++rep) p_moe_route(F, h, args.in[15] + (layer) * D, (const float*)(ws + WS_WR) + (size_t)(layer) * D * WRN, args.in[17] + (layer) * NGRP, args.in[19] + (layer) * NE, XN, mb); \
    do { if (IN(pb) && IN((pb) + 2)) xcd_barrier(bar); } while (0); \
    if (IN((pb) + 2)) { pg8::ListOrder S; LAS int* rowtok = (LAS int*)(F.lds + RING_BYTES + 8192); moe_gather_prep(F, mb, 2 * HID / 256, S, rowtok); \
        pg8::Gemm g{XN, Wgu_t + (size_t)(layer) * NE * 2 * HID * D, D}; pg8::EpiSwiGLU E{HB, HID}; \
        pg8::gemm_phase_gather<pg8::EpiSwiGLU, pg8::ListOrder>(F.lds, g, S, E, rowtok); } \
    SEAM((pb) + 2); \
    if (IN((pb) + 3)) { pg8::ListOrder S; moe_units(F, mb, D / 256, S); \
        pg8::Gemm g{HB, Wd_t + (size_t)(layer) * NE * D * HID, HID}; pg8::EpiBf16 E{YS, D}; \
        pg8::gemm_phase<pg8::EpiBf16, pg8::ListOrder>(F.lds, g, S, E); \
        if (MK_REP_PHASE == 7 && (layer) == 0) { __syncthreads(); pg8::gemm_phase<pg8::EpiBf16, pg8::ListOrder>(F.lds, g, S, E); } } \
    SEAM((pb) + 3); \
    if (IN((pb) + 4)) p_moe_combine(F, h, YS, mb, XNOUT);

    MOE_PHASES(0, 4, XN)
    SEAM(8);
    if (IN(9)) {
        pg8::Gemm g{XN, Wkvq_t, D}; pg8::StaticOrder S; S.init(T, KVQ, F.G, F.bid);
        pg8::EpiKvqNorm E{KVQB, args.in[10], args.in[13], (LAS float*)(F.lds + RING_BYTES)};
        pg8::gemm_phase<pg8::EpiKvqNorm, pg8::StaticOrder>(F.lds, g, S, E);
        if (MK_REP_PHASE == 9) { __syncthreads(); pg8::gemm_phase<pg8::EpiKvqNorm, pg8::StaticOrder>(F.lds, g, S, E); }
    }
    do { if (IN(9) && IN(11)) xcd_barrier(bar); } while (0);
    if (IN(11)) { for (int rep = 0; rep < (MK_REP_PHASE == 11 ? 2 : 1); ++rep) p_sb_attn(F, KVQB, AO); }
    SEAM(11);
    if (IN(12)) {
        pg8::Gemm g{AO, Woutb_t, SBDIM}; pg8::StaticOrder S; S.init(T, D, F.G, F.bid);
        pg8::EpiResF32 E{h, h, D};
        pg8::gemm_phase<pg8::EpiResF32, pg8::StaticOrder>(F.lds, g, S, E);
    }
    SEAM(12);
    MOE_PHASES(1, 13, (bf16_t*)nullptr)
#undef MOE_PHASES
#undef IN
#undef SEAM
}

extern "C" void kernel_launch(void* const* d_in, const int* in_sizes, int n_in, void* d_out, int out_size, void* d_ws, size_t ws_size, hipStream_t stream) {
    static int grid = 0;
    if (grid == 0) {
        if (n_in != 23 || out_size != T * D || ws_size < WS_END) { fprintf(stderr, "kernel_launch: unexpected shapes (n_in %d, out %d, ws %zu)\n", n_in, out_size, ws_size); grid = -1; return; }
        int dev = 0, cus = 0, per_cu = 0;
        if (hipGetDevice(&dev) != hipSuccess || hipDeviceGetAttribute(&cus, hipDeviceAttributeMultiprocessorCount, dev) != hipSuccess) { grid = -1; return; }
        if (hipFuncSetAttribute((const void*)yoco_fwd, hipFuncAttributeMaxDynamicSharedMemorySize, LDS_BYTES) != hipSuccess) { fprintf(stderr, "kernel_launch: hipFuncSetAttribute failed\n"); grid = -1; return; }
        if (hipOccupancyMaxActiveBlocksPerMultiprocessor(&per_cu, (const void*)yoco_fwd, 512, LDS_BYTES) != hipSuccess || per_cu < 1) fprintf(stderr, "kernel_launch: occupancy query reports %d\n", per_cu);
        (void)hipGetLastError();
        grid = cus;
        if (grid > 256) grid = 256;
    }
    if (grid < 0) return;
    (void)hipMemsetAsync((char*)d_ws + WS_CTL, 0, CTL_ZERO_BYTES, stream);
    Args a{};
    for (int i = 0; i < 23; ++i) a.in[i] = (const float*)d_in[i];
    a.out = (float*)d_out; a.ws = (unsigned char*)d_ws;
#if MK_ONE_LAUNCH
    a.ph_lo = 0; a.ph_hi = MK_LAST_PHASE;
    hipLaunchKernelGGL(yoco_fwd, dim3(grid), dim3(512), LDS_BYTES, stream, a);
#else
    for (int p = 0; p < MK_LAST_PHASE; ++p) { if (p == 10 || p == 5 || p == 14) continue; a.ph_lo = p; a.ph_hi = p + 1; hipLaunchKernelGGL(yoco_fwd, dim3(grid), dim3(512), LDS_BYTES, stream, a); }
#endif
}
```

```cpp
#include <hip/hip_runtime.h>
#include <cstdio>

#ifndef MK_ONE_LAUNCH
#define MK_ONE_LAUNCH 1
#endif
#ifndef MK_REP_PHASE
#define MK_REP_PHASE -1
#endif
#ifndef MK_LAST_PHASE
#define MK_LAST_PHASE 18
#endif

#define GAS __attribute__((address_space(1)))
#define LAS __attribute__((address_space(3)))
typedef unsigned short bf16_t;
typedef short bf16x8 __attribute__((ext_vector_type(8)));
typedef float f32x4 __attribute__((ext_vector_type(4)));
typedef float f32x2 __attribute__((ext_vector_type(2)));
typedef unsigned u32x4 __attribute__((ext_vector_type(4)));
typedef unsigned u32x2 __attribute__((ext_vector_type(2)));

constexpr int D = 2048, BATCH = 8, SEQ = 2048, T = BATCH * SEQ;
constexpr int HD = 128;
constexpr int GKH = 16, GVH = 32, GKDIM = 2048, GVDIM = 4096, GCONV = 8192, GIN = 12352, GIN_PAD = 12544;
constexpr int SBH = 16, SBDIM = 2048, KVQ = 6144;
constexpr int NGRP = 4, EPG = 8, NE = 32, HID = 768;
constexpr float EPS = 1e-6f;
constexpr int MAXSLOTS = T * 2 + NE * 256;

constexpr size_t MiB = 1u << 20;
constexpr size_t WS_CTL = 0, CTL_ZERO_BYTES = 1 * MiB;
constexpr size_t WS_MISC = 1 * MiB;
constexpr size_t WS_WIN = 2 * MiB, WS_WOUTA = 51 * MiB, WS_WKVQ = 67 * MiB, WS_WOUTB = 91 * MiB, WS_WGU = 99 * MiB, WS_WD = 483 * MiB;
constexpr size_t WS_XN = 675 * MiB, WS_OG = 739 * MiB, WS_BIG = 867 * MiB, WS_WR = 1259 * MiB, WS_END = 1260 * MiB;
constexpr int WRN = 48;
constexpr size_t WS_XS = WS_BIG, WS_HB = WS_BIG + 160 * MiB, WS_YS = WS_BIG + 220 * MiB;
constexpr size_t WS_KVQ = WS_BIG, WS_AO = WS_BIG + 192 * MiB;
static_assert((size_t)GIN_PAD * D * 2 <= 49 * MiB && (size_t)T * GIN_PAD * 2 <= 392 * MiB, "map");
static_assert((size_t)MAXSLOTS * D * 2 <= 160 * MiB && (size_t)MAXSLOTS * HID * 2 <= 60 * MiB, "map");
constexpr size_t MI_BLKCNT = 0, MI_PADSTART = 32768, MI_TOKE = 65536, MI_TOKW = 65536 + 131072, MI_TOKSLOT = 65536 + 262144;
constexpr int CW_BAR = 4096, CW_TICKET = 64;

constexpr int RING_BYTES = 131072;
constexpr int LDS_BYTES = 163840;
constexpr int LDSCTL_OFF = LDS_BYTES - 1024;

#define LDS_WAIT() asm volatile("s_waitcnt lgkmcnt(0)" ::: "memory")
#define VM_WAIT() asm volatile("s_waitcnt vmcnt(0)" ::: "memory")
__device__ __forceinline__ float bf2f(unsigned b) { return __uint_as_float(b << 16); }
__device__ __forceinline__ unsigned f2bf(float f) { unsigned u = __float_as_uint(f); return (u + 0x7fffu + ((u >> 16) & 1u)) >> 16; }
typedef __bf16 bf16v2_t __attribute__((ext_vector_type(2)));
__device__ __forceinline__ unsigned pk2(float lo, float hi) { bf16v2_t v = __builtin_convertvector((f32x2){lo, hi}, bf16v2_t); return __builtin_bit_cast(unsigned, v); }
__device__ __forceinline__ float wave_sum(float v) {
#pragma unroll
    for (int o = 1; o < 64; o <<= 1) v += __shfl_xor(v, o);
    return v;
}
__device__ __forceinline__ float silu_f(float x) { return x * __builtin_amdgcn_rcpf(1.0f + __builtin_amdgcn_exp2f(-1.4426950408889634f * x)); }
__device__ __forceinline__ float sigmoid_f(float x) { return __builtin_amdgcn_rcpf(1.0f + __builtin_amdgcn_exp2f(-1.4426950408889634f * x)); }
__device__ __forceinline__ float softplus_f(float x) { return fmaxf(x, 0.f) + __logf(1.0f + __expf(-fabsf(x))); }

#define XB_TMO      128
#define XB_XCNT(j)  (256  + 64 * (j))
#define XB_XSUB(j)  (1280 + 64 * (j))
#define XB_XGEN(j)  (2304 + 64 * (j))
#define XB_TOP      3328
#define XB_TOPGEN   3392
#define XCD_BAR_WORDS 3456
#define XB_SPIN_CAP (1u << 20)
__device__ __forceinline__ unsigned xb_ld(unsigned* p)              { return __hip_atomic_load(p, __ATOMIC_RELAXED, __HIP_MEMORY_SCOPE_AGENT); }
__device__ __forceinline__ unsigned xb_add(unsigned* p, unsigned v) { return __hip_atomic_fetch_add(p, v, __ATOMIC_RELAXED, __HIP_MEMORY_SCOPE_AGENT); }
__device__ __forceinline__ unsigned xb_xcc_id() { return (unsigned)__builtin_amdgcn_s_getreg((3 << 11) | 20) & 0xFu; }
#define XB_SPIN(cond, bar) do { unsigned _sp = 0; while (cond) { __builtin_amdgcn_s_sleep(1); \
    if ((++_sp & 255u) == 0u) { if (xb_ld(&(bar)[XB_TMO])) break; if (_sp > XB_SPIN_CAP) { atomicAdd(&(bar)[XB_TMO], 1u); break; } } } } while (0)
struct XcdBarrier { unsigned* bar; unsigned x; volatile LAS unsigned* st; };
__device__ __forceinline__ XcdBarrier xcd_barrier_post(unsigned* bar, volatile LAS unsigned* st) {
    XcdBarrier b; b.bar = bar; b.x = xb_xcc_id(); b.st = st;
    if (threadIdx.x == 0) (void)xb_add(&bar[XB_XCNT(b.x)], 1u);
    return b;
}
__device__ __forceinline__ void xcd_barrier_complete(unsigned* bar, unsigned x, unsigned& nloc, unsigned& nx) {
    const unsigned G = gridDim.x * gridDim.y * gridDim.z;
    unsigned sum, cnt, mine, sp = 0u;
    for (;;) {
        sum = 0u; cnt = 0u; mine = 0u;
#pragma unroll
        for (unsigned j = 0; j < 16; ++j) { const unsigned c = xb_ld(&bar[XB_XCNT(j)]); sum += c; cnt += (c > 0u) ? 1u : 0u; mine = (j == x) ? c : mine; }
        if (sum == G) break;
        __builtin_amdgcn_s_sleep(1);
        if ((++sp & 255u) == 0u) { if (xb_ld(&bar[XB_TMO])) break; if (sp > XB_SPIN_CAP) { atomicAdd(&bar[XB_TMO], 1u); break; } }
    }
    nloc = mine > 0u ? mine : 1u; nx = cnt > 0u ? cnt : 1u;
}
__device__ __forceinline__ void xcd_barrier(const XcdBarrier& b) {
    asm volatile("s_waitcnt vmcnt(0)" ::: "memory");
    __syncthreads();
    if (threadIdx.x == 0) {
        unsigned* bar = b.bar;
        __builtin_amdgcn_s_waitcnt(0);
        unsigned nloc = b.st[0], nx = b.st[1];
        if (nloc == 0u) { xcd_barrier_complete(bar, b.x, nloc, nx); b.st[0] = nloc; b.st[1] = nx; }
        const unsigned old = xb_add(&bar[XB_XSUB(b.x)], 1u);
        const unsigned gen = old / nloc;
        if (old + 1u == (gen + 1u) * nloc) {
            __builtin_amdgcn_fence(__ATOMIC_RELEASE, "agent");
            asm volatile("s_waitcnt vmcnt(0)" ::: "memory");
            const unsigned og = xb_add(&bar[XB_TOP], 1u);
            const unsigned tg = og / nx;
            if (og + 1u == (tg + 1u) * nx) xb_add(&bar[XB_TOPGEN], 1u);
            else XB_SPIN(xb_ld(&bar[XB_TOPGEN]) == tg, bar);
            __builtin_amdgcn_fence(__ATOMIC_ACQUIRE, "agent");
            xb_add(&bar[XB_XGEN(b.x)], 1u);
            asm volatile("s_waitcnt vmcnt(0)" ::: "memory");
        } else {
            XB_SPIN(xb_ld(&bar[XB_XGEN(b.x)]) == gen, bar);
            __builtin_amdgcn_fence(__ATOMIC_ACQUIRE, "agent");
            asm volatile("s_waitcnt vmcnt(0)" ::: "memory");
        }
    }
    __syncthreads();
}

namespace pg8 {
constexpr int BM = 256, BK = 64, HALF = 128, HTB = HALF * BK * 2, STAGE_BYTES = 8 * HTB, NXCD = 8, WGM = 8;
__host__ __device__ __forceinline__ int lds_byte(int r, int c) { const int st = (r >> 4) * 2 + (c >> 5), rr = r & 15, cc = c & 31, ob = rr * 64 + cc * 2; return st * 1024 + (ob ^ (((ob >> 9) & 1) << 5)); }
__host__ __device__ __forceinline__ void stage_rc(int b, int& R, int& C) { const int st = b / 1024, sb = b % 1024, swz = sb ^ (((sb >> 9) & 1) << 5); R = (st >> 1) * 16 + swz / 64; C = (st & 1) * 32 + (swz % 64) / 2; }
__host__ __device__ __forceinline__ int perm32(int rho) { const int n = rho >> 4, i = rho & 15; return 8 * (i >> 2) + 4 * n + (i & 3); }

struct Unit { int pm, pn, pb; };
struct Gemm { const bf16_t* A; const bf16_t* Bt; int K; };

struct StaticOrder {
    int nM, nN, nwg, G, c;
    __device__ void init(int M, int N, int G_, int c_) { nM = M / BM; nN = N / BM; nwg = nM * nN; G = G_; c = c_; }
    __device__ bool next(int i, Unit& u) const {
        const long L = (long)i * G + c; if (L >= nwg) return false;
        int wgid = (int)L; { const int q = nwg / NXCD, r = nwg % NXCD, xcd = wgid % NXCD, off = wgid / NXCD; wgid = (xcd < r ? xcd * (q + 1) : r * (q + 1) + (xcd - r) * q) + off; }
        const int nig = WGM * nN, gid = wgid / nig, fm = gid * WGM, gsz = (nM - fm) < WGM ? (nM - fm) : WGM;
        u.pm = fm + ((wgid % nig) % gsz); u.pn = (wgid % nig) / gsz; u.pb = u.pn; return true;
    }
};
struct ListOrder {
    int n, d0, d1, d2, d3, d4, d5, d6, d7;
    __device__ bool next(int i, Unit& u) const {
        if (i >= n) return false;
        const int d = i == 0 ? d0 : i == 1 ? d1 : i == 2 ? d2 : i == 3 ? d3 : i == 4 ? d4 : i == 5 ? d5 : i == 6 ? d6 : d7;
        u.pm = d & 0xfff; u.pn = (d >> 12) & 0xf; u.pb = d >> 16; return true;
    }
};

__device__ __forceinline__ unsigned cvt_pk_bf16(float lo, float hi) { return pk2(lo, hi); }

struct EpiBf16 {
    static constexpr bool PERM = true;
    bf16_t* O; int ldc;
    __device__ __forceinline__ void operator()(const f32x4 (&acc)[2][2][4][2], const Unit& u, int wr, int wc, int fr, int fq) const {
        const int row0 = u.pm * BM + wr * 64 + fr, col0 = u.pn * BM + wc * 32 + 8 * fq;
#pragma unroll
        for (int ai = 0; ai < 2; ++ai)
#pragma unroll
            for (int m = 0; m < 4; ++m) { bf16_t* rowp = O + (size_t)(row0 + ai * HALF + m * 16) * ldc + col0;
#pragma unroll
                for (int bj = 0; bj < 2; ++bj) { const f32x4 v0 = acc[ai][bj][m][0], v1 = acc[ai][bj][m][1];
                    u32x4 w; w.x = cvt_pk_bf16(v0[0], v0[1]); w.y = cvt_pk_bf16(v0[2], v0[3]); w.z = cvt_pk_bf16(v1[0], v1[1]); w.w = cvt_pk_bf16(v1[2], v1[3]);
                    *(u32x4*)(rowp + bj * HALF) = w; } }
    }
};
struct EpiKvqNorm {
    static constexpr bool PERM = true;
    bf16_t* O; const float* k_gain; const float* q_gain; LAS float* xch;
    __device__ __forceinline__ void operator()(const f32x4 (&acc)[2][2][4][2], const Unit& u, int wr, int wc, int fr, int fq) const {
        const int row0 = u.pm * BM + wr * 64 + fr, col0 = u.pn * BM + wc * 32 + 8 * fq;
        const bool isk = u.pn < 8, isq = u.pn >= 16;
        float rs[2][4][2];
        if (isk || isq) {
#pragma unroll
            for (int ai = 0; ai < 2; ++ai)
#pragma unroll
                for (int m = 0; m < 4; ++m)
#pragma unroll
                    for (int bj = 0; bj < 2; ++bj) { const f32x4 a = acc[ai][bj][m][0], b = acc[ai][bj][m][1];
                        float s = (a[0] * a[0] + a[1] * a[1]) + (a[2] * a[2] + a[3] * a[3]) + (b[0] * b[0] + b[1] * b[1]) + (b[2] * b[2] + b[3] * b[3]);
                        s += __shfl_xor(s, 16); s += __shfl_xor(s, 32);
                        if (fq == 0) xch[((ai * HALF + wr * 64 + m * 16 + fr) * 2 + bj) * 4 + wc] = s; }
            asm volatile("s_waitcnt lgkmcnt(0)" ::: "memory"); __builtin_amdgcn_s_barrier(); asm volatile("" ::: "memory");
            const float* g = isk ? k_gain : q_gain; const float qs = isq ? 0.12751743082459868f : 1.0f;
#pragma unroll
            for (int ai = 0; ai < 2; ++ai)
#pragma unroll
                for (int m = 0; m < 4; ++m)
#pragma unroll
                    for (int bj = 0; bj < 2; ++bj) { const f32x4 p = *(const LAS f32x4*)(xch + ((ai * HALF + wr * 64 + m * 16 + fr) * 2 + bj) * 4);
                        rs[ai][m][bj] = qs / sqrtf(((p[0] + p[1]) + (p[2] + p[3])) * (1.f / HD) + EPS); }
        }
        f32x4 g0 = {1.f, 1.f, 1.f, 1.f}, g1 = g0;
        if (isk || isq) { const float* g = isk ? k_gain : q_gain; g0 = *(const f32x4*)(g + wc * 32 + 8 * fq); g1 = *(const f32x4*)(g + wc * 32 + 8 * fq + 4); }
#pragma unroll
        for (int ai = 0; ai < 2; ++ai)
#pragma unroll
            for (int m = 0; m < 4; ++m) { bf16_t* rowp = O + (size_t)(row0 + ai * HALF + m * 16) * KVQ + col0;
#pragma unroll
                for (int bj = 0; bj < 2; ++bj) { f32x4 v0 = acc[ai][bj][m][0], v1 = acc[ai][bj][m][1];
                    if (isk || isq) { const float r = rs[ai][m][bj]; v0 = v0 * r * g0; v1 = v1 * r * g1; }
                    u32x4 w; w.x = cvt_pk_bf16(v0[0], v0[1]); w.y = cvt_pk_bf16(v0[2], v0[3]); w.z = cvt_pk_bf16(v1[0], v1[1]); w.w = cvt_pk_bf16(v1[2], v1[3]);
                    *(u32x4*)(rowp + bj * HALF) = w; } }
    }
};
struct EpiResF32 {
    static constexpr bool PERM = false;
    const float* base; float* out; int ldc;
    __device__ __forceinline__ void operator()(const f32x4 (&acc)[2][2][4][2], const Unit& u, int wr, int wc, int fr, int fq) const {
        const int row0 = u.pm * BM + wr * 64 + fr, col0 = u.pn * BM + wc * 32 + 4 * fq;
        const float* __restrict__ bp = base; float* __restrict__ op = out;
#pragma unroll
        for (int ai = 0; ai < 2; ++ai)
#pragma unroll
            for (int mp = 0; mp < 2; ++mp) {
                f32x4 b[2][2][2];
#pragma unroll
                for (int mm = 0; mm < 2; ++mm) { const size_t ro = (size_t)(row0 + ai * HALF + (2 * mp + mm) * 16) * ldc + col0;
#pragma unroll
                    for (int bj = 0; bj < 2; ++bj)
#pragma unroll
                        for (int n = 0; n < 2; ++n) b[mm][bj][n] = *(const f32x4*)(bp + ro + bj * HALF + n * 16); }
#pragma unroll
                for (int mm = 0; mm < 2; ++mm) { const size_t ro = (size_t)(row0 + ai * HALF + (2 * mp + mm) * 16) * ldc + col0;
#pragma unroll
                    for (int bj = 0; bj < 2; ++bj)
#pragma unroll
                        for (int n = 0; n < 2; ++n) *(f32x4*)(op + ro + bj * HALF + n * 16) = acc[ai][bj][2 * mp + mm][n] + b[mm][bj][n]; }
            }
    }
};
struct EpiSwiGLU {
    static constexpr bool PERM = true;
    bf16_t* O; int ldc;
    __device__ __forceinline__ void operator()(const f32x4 (&acc)[2][2][4][2], const Unit& u, int wr, int wc, int fr, int fq) const {
        const int row0 = u.pm * BM + wr * 64 + fr, col0 = u.pn * HALF + wc * 32 + 8 * fq;
#pragma unroll
        for (int ai = 0; ai < 2; ++ai)
#pragma unroll
            for (int m = 0; m < 4; ++m) { bf16_t* rowp = O + (size_t)(row0 + ai * HALF + m * 16) * ldc + col0;
                float h[8];
#pragma unroll
                for (int n = 0; n < 2; ++n)
#pragma unroll
                    for (int j = 0; j < 4; ++j) { const float g = acc[ai][0][m][n][j], up = acc[ai][1][m][n][j]; h[n * 4 + j] = g * __builtin_amdgcn_rcpf(1.0f + __expf(-g)) * up; }
                u32x4 w; w.x = cvt_pk_bf16(h[0], h[1]); w.y = cvt_pk_bf16(h[2], h[3]); w.z = cvt_pk_bf16(h[4], h[5]); w.w = cvt_pk_bf16(h[6], h[7]);
                *(u32x4*)rowp = w; }
    }
};

template <class Epi, class Sched>
__device__ __forceinline__ void gemm_phase(LAS unsigned char* lds, const Gemm g, const Sched& S, const Epi& E) {
    const int tid = threadIdx.x, wid = __builtin_amdgcn_readfirstlane(tid >> 6), lane = tid & 63, wr = wid >> 2, wc = wid & 3, fr = lane & 15, fq = lane >> 4;
    const int K = g.K, nt = K / BK;
    unsigned voffA[2], voffB[2];
#pragma unroll
    for (int i = 0; i < 2; ++i) { int R, C; stage_rc(tid * 16 + i * 8192, R, C); const int Rb = Epi::PERM ? ((R & ~31) + perm32(R & 31)) : R;
        voffA[i] = (unsigned)(R * K + C) * 2u; voffB[i] = (unsigned)(Rb * K + C) * 2u; }
    const size_t kstep = (size_t)(BK * 2);
    const size_t hstep = (size_t)HALF * K * 2;
    const size_t tstep = 2 * hstep;
    const unsigned ldsw = (unsigned)wid * 1024u;
    const int aoff = lds_byte(wr * 64 + fr, fq * 8), boff = lds_byte(wc * 32 + fr, fq * 8);
#define PG8_SA(b, h) (((b) * 2 + (h)) * HTB)
#define PG8_SB(b, h) ((4 + (b) * 2 + (h)) * HTB)
#define PG8_STAGE(bufoff, gbase, voff) do { _Pragma("unroll") for (int _i = 0; _i < 2; ++_i) \
        __builtin_amdgcn_global_load_lds((const unsigned*)((const char*)(gbase) + (voff)[_i]), (LAS unsigned*)(lds + (bufoff) + ldsw + _i * 8192), 16, 0, 0); } while (0)
#define PG8_LDA(dst, b, h) do { _Pragma("unroll") for (int m = 0; m < 4; ++m) _Pragma("unroll") for (int k = 0; k < 2; ++k) dst[m][k] = *(const LAS bf16x8*)(lds + PG8_SA(b, h) + aoff + m * 2048 + k * 1024); } while (0)
#define PG8_LDB(dst, b, h) do { _Pragma("unroll") for (int n = 0; n < 2; ++n) _Pragma("unroll") for (int k = 0; k < 2; ++k) dst[n][k] = *(const LAS bf16x8*)(lds + PG8_SB(b, h) + boff + n * 2048 + k * 1024); } while (0)
#define PG8_MMA(ai, bj, At, Bt) do { __builtin_amdgcn_s_setprio(1); _Pragma("unroll") for (int m = 0; m < 4; ++m) _Pragma("unroll") for (int n = 0; n < 2; ++n) _Pragma("unroll") for (int k = 0; k < 2; ++k) \
        acc[ai][bj][m][n] = __builtin_amdgcn_mfma_f32_16x16x32_bf16(Bt[n][k], At[m][k], acc[ai][bj][m][n], 0, 0, 0); __builtin_amdgcn_s_setprio(0); } while (0)
#define PG8_WAIT_V(n) asm volatile("s_waitcnt vmcnt(" #n ")" ::: "memory")
#define PG8_WAIT_L(n) asm volatile("s_waitcnt lgkmcnt(" #n ")" ::: "memory")
#define PG8_BAR __builtin_amdgcn_s_barrier()
#define PG8_SCHED __builtin_amdgcn_sched_barrier(0)
    Unit cur, nxt; int ui = 0;
    if (!S.next(0, cur)) return;
    f32x4 acc[2][2][4][2];
#pragma unroll
    for (int a = 0; a < 2; ++a)
#pragma unroll
        for (int b = 0; b < 2; ++b)
#pragma unroll
            for (int m = 0; m < 4; ++m)
#pragma unroll
                for (int n = 0; n < 2; ++n) acc[a][b][m][n] = (f32x4){0.f, 0.f, 0.f, 0.f};
    bf16x8 At[4][2], B0[2][2], B1[2][2];
    const char* cA = (const char*)g.A + (size_t)cur.pm * tstep; const char* cB = (const char*)g.Bt + (size_t)cur.pb * tstep;
    PG8_STAGE(PG8_SB(0, 0), cB, voffB); PG8_STAGE(PG8_SA(0, 0), cA, voffA); PG8_STAGE(PG8_SB(0, 1), cB + hstep, voffB); PG8_STAGE(PG8_SA(0, 1), cA + hstep, voffA);
    if (wr == 1) PG8_BAR;
    PG8_WAIT_V(4); PG8_BAR;
    PG8_STAGE(PG8_SB(1, 0), cB + kstep, voffB); PG8_STAGE(PG8_SA(1, 0), cA + kstep, voffA); PG8_STAGE(PG8_SB(1, 1), cB + hstep + kstep, voffB);
    PG8_WAIT_V(6); PG8_BAR;
    for (;;) {
        const bool has_next = S.next(ui + 1, nxt);
        const char* nA = has_next ? (const char*)g.A + (size_t)nxt.pm * tstep : cA; const char* nB = has_next ? (const char*)g.Bt + (size_t)nxt.pb * tstep : cB;
        for (int t = 0; t < nt; t += 2) {
            const bool last = (t == nt - 2);
            const char* a1 = cA + (size_t)(t + 1) * kstep;
            const char* a2 = last ? nA : cA + (size_t)(t + 2) * kstep; const char* b2 = last ? nB : cB + (size_t)(t + 2) * kstep;
            const char* a3 = a2 + kstep; const char* b3 = b2 + kstep;
            PG8_LDB(B0, 0, 0); PG8_SCHED; PG8_LDA(At, 0, 0); PG8_STAGE(PG8_SA(1, 1), a1 + hstep, voffA);
            PG8_WAIT_L(8); PG8_BAR; PG8_WAIT_L(0); PG8_MMA(0, 0, At, B0); PG8_BAR; PG8_SCHED;
            PG8_LDB(B1, 0, 1); PG8_STAGE(PG8_SB(0, 0), b2, voffB);
            PG8_BAR; PG8_WAIT_L(0); PG8_MMA(0, 1, At, B1); PG8_BAR;
            PG8_LDA(At, 0, 1); PG8_STAGE(PG8_SA(0, 0), a2, voffA);
            PG8_BAR; PG8_WAIT_L(0); PG8_MMA(1, 0, At, B0); PG8_BAR; PG8_SCHED;
            PG8_STAGE(PG8_SB(0, 1), b2 + hstep, voffB);
            PG8_WAIT_V(6); PG8_BAR; PG8_MMA(1, 1, At, B1); PG8_BAR;
            PG8_LDB(B0, 1, 0); PG8_SCHED; PG8_LDA(At, 1, 0); PG8_STAGE(PG8_SA(0, 1), a2 + hstep, voffA);
            PG8_WAIT_L(8); PG8_BAR; PG8_WAIT_L(0); PG8_MMA(0, 0, At, B0); PG8_BAR; PG8_SCHED;
            PG8_LDB(B1, 1, 1); PG8_STAGE(PG8_SB(1, 0), b3, voffB);
            PG8_BAR; PG8_WAIT_L(0); PG8_MMA(0, 1, At, B1); PG8_BAR;
            PG8_LDA(At, 1, 1); PG8_STAGE(PG8_SA(1, 0), a3, voffA);
            PG8_BAR; PG8_WAIT_L(0); PG8_MMA(1, 0, At, B0); PG8_BAR; PG8_SCHED;
            PG8_STAGE(PG8_SB(1, 1), b3 + hstep, voffB);
            PG8_WAIT_V(6); PG8_BAR; PG8_MMA(1, 1, At, B1); PG8_BAR;
        }
        E(acc, cur, wr, wc, fr, fq);
        if (!has_next) break;
#pragma unroll
        for (int a = 0; a < 2; ++a)
#pragma unroll
            for (int b = 0; b < 2; ++b)
#pragma unroll
                for (int m = 0; m < 4; ++m)
#pragma unroll
                    for (int n = 0; n < 2; ++n) acc[a][b][m][n] = (f32x4){0.f, 0.f, 0.f, 0.f};
        cur = nxt; cA = nA; cB = nB; ++ui;
    }
    PG8_WAIT_V(0);
    if (wr == 0) PG8_BAR;
    PG8_BAR;
#undef PG8_SA
#undef PG8_SB
#undef PG8_STAGE
#undef PG8_LDA
#undef PG8_LDB
#undef PG8_MMA
#undef PG8_WAIT_V
#undef PG8_WAIT_L
#undef PG8_BAR
#undef PG8_SCHED
}
template <class Epi, class Sched>
__device__ __forceinline__ void gemm_phase_gather(LAS unsigned char* lds, const Gemm g, const Sched& S, const Epi& E, const LAS int* rowtok) {
    const int tid = threadIdx.x, wid = __builtin_amdgcn_readfirstlane(tid >> 6), lane = tid & 63, wr = wid >> 2, wc = wid & 3, fr = lane & 15, fq = lane >> 4;
    const int K = g.K, nt = K / BK;
    unsigned voffB[2]; unsigned cofA[2]; int rofA[2];
#pragma unroll
    for (int i = 0; i < 2; ++i) { int R, C; stage_rc(tid * 16 + i * 8192, R, C); const int Rb = Epi::PERM ? ((R & ~31) + perm32(R & 31)) : R;
        cofA[i] = (unsigned)C * 2u; rofA[i] = R; voffB[i] = (unsigned)(Rb * K + C) * 2u; }
    unsigned ga[2][2], gn[2][2];
#define PG8_ROWS(dst, u_) do { _Pragma("unroll") for (int h_ = 0; h_ < 2; ++h_) _Pragma("unroll") for (int i_ = 0; i_ < 2; ++i_) \
        dst[h_][i_] = (unsigned)rowtok[(u_) * 256 + h_ * HALF + rofA[i_]] * (unsigned)(K * 2) + cofA[i_]; } while (0)
    const size_t kstep = (size_t)(BK * 2);
    const size_t hstep = (size_t)HALF * K * 2;
    const size_t tstep = 2 * hstep;
    const unsigned ldsw = (unsigned)wid * 1024u;
    const int aoff = lds_byte(wr * 64 + fr, fq * 8), boff = lds_byte(wc * 32 + fr, fq * 8);
#define PG8_SA(b, h) (((b) * 2 + (h)) * HTB)
#define PG8_SB(b, h) ((4 + (b) * 2 + (h)) * HTB)
#define PG8_STAGE(bufoff, gbase, voff) do { _Pragma("unroll") for (int _i = 0; _i < 2; ++_i) \
        __builtin_amdgcn_global_load_lds((const unsigned*)((const char*)(gbase) + (voff)[_i]), (LAS unsigned*)(lds + (bufoff) + ldsw + _i * 8192), 16, 0, 0); } while (0)
#define PG8_LDA(dst, b, h) do { _Pragma("unroll") for (int m = 0; m < 4; ++m) _Pragma("unroll") for (int k = 0; k < 2; ++k) dst[m][k] = *(const LAS bf16x8*)(lds + PG8_SA(b, h) + aoff + m * 2048 + k * 1024); } while (0)
#define PG8_LDB(dst, b, h) do { _Pragma("unroll") for (int n = 0; n < 2; ++n) _Pragma("unroll") for (int k = 0; k < 2; ++k) dst[n][k] = *(const LAS bf16x8*)(lds + PG8_SB(b, h) + boff + n * 2048 + k * 1024); } while (0)
#define PG8_MMA(ai, bj, At, Bt) do { __builtin_amdgcn_s_setprio(1); _Pragma("unroll") for (int m = 0; m < 4; ++m) _Pragma("unroll") for (int n = 0; n < 2; ++n) _Pragma("unroll") for (int k = 0; k < 2; ++k) \
        acc[ai][bj][m][n] = __builtin_amdgcn_mfma_f32_16x16x32_bf16(Bt[n][k], At[m][k], acc[ai][bj][m][n], 0, 0, 0); __builtin_amdgcn_s_setprio(0); } while (0)
#define PG8_WAIT_V(n) asm volatile("s_waitcnt vmcnt(" #n ")" ::: "memory")
#define PG8_WAIT_L(n) asm volatile("s_waitcnt lgkmcnt(" #n ")" ::: "memory")
#define PG8_BAR __builtin_amdgcn_s_barrier()
#define PG8_SCHED __builtin_amdgcn_sched_barrier(0)
    Unit cur, nxt; int ui = 0;
    if (!S.next(0, cur)) return;
    f32x4 acc[2][2][4][2];
#pragma unroll
    for (int a = 0; a < 2; ++a)
#pragma unroll
        for (int b = 0; b < 2; ++b)
#pragma unroll
            for (int m = 0; m < 4; ++m)
#pragma unroll
                for (int n = 0; n < 2; ++n) acc[a][b][m][n] = (f32x4){0.f, 0.f, 0.f, 0.f};
    bf16x8 At[4][2], B0[2][2], B1[2][2];
    const char* cA = (const char*)g.A; const char* cB = (const char*)g.Bt + (size_t)cur.pb * tstep;
    PG8_ROWS(ga, 0);
    PG8_STAGE(PG8_SB(0, 0), cB, voffB); PG8_STAGE(PG8_SA(0, 0), cA, ga[0]); PG8_STAGE(PG8_SB(0, 1), cB + hstep, voffB); PG8_STAGE(PG8_SA(0, 1), cA, ga[1]);
    if (wr == 1) PG8_BAR;
    PG8_WAIT_V(4); PG8_BAR;
    PG8_STAGE(PG8_SB(1, 0), cB + kstep, voffB); PG8_STAGE(PG8_SA(1, 0), cA + kstep, ga[0]); PG8_STAGE(PG8_SB(1, 1), cB + hstep + kstep, voffB);
    PG8_WAIT_V(6); PG8_BAR;
    for (;;) {
        const bool has_next = S.next(ui + 1, nxt);
        const char* nB = has_next ? (const char*)g.Bt + (size_t)nxt.pb * tstep : cB;
        if (has_next) PG8_ROWS(gn, ui + 1); else { gn[0][0] = ga[0][0]; gn[0][1] = ga[0][1]; gn[1][0] = ga[1][0]; gn[1][1] = ga[1][1]; }
        for (int t = 0; t < nt; t += 2) {
            const bool last = (t == nt - 2);
            const char* a1 = cA + (size_t)(t + 1) * kstep;
            const char* a2 = last ? cA : cA + (size_t)(t + 2) * kstep; const char* b2 = last ? nB : cB + (size_t)(t + 2) * kstep;
            unsigned o2[2][2];
            _Pragma("unroll") for (int h_ = 0; h_ < 2; ++h_) _Pragma("unroll") for (int i_ = 0; i_ < 2; ++i_) o2[h_][i_] = last ? gn[h_][i_] : ga[h_][i_];
            const char* a3 = a2 + kstep; const char* b3 = b2 + kstep;
            PG8_LDB(B0, 0, 0); PG8_SCHED; PG8_LDA(At, 0, 0); PG8_STAGE(PG8_SA(1, 1), a1, ga[1]);
            PG8_WAIT_L(8); PG8_BAR; PG8_WAIT_L(0); PG8_MMA(0, 0, At, B0); PG8_BAR; PG8_SCHED;
            PG8_LDB(B1, 0, 1); PG8_STAGE(PG8_SB(0, 0), b2, voffB);
            PG8_BAR; PG8_WAIT_L(0); PG8_MMA(0, 1, At, B1); PG8_BAR;
            PG8_LDA(At, 0, 1); PG8_STAGE(PG8_SA(0, 0), a2, o2[0]);
            PG8_BAR; PG8_WAIT_L(0); PG8_MMA(1, 0, At, B0); PG8_BAR; PG8_SCHED;
            PG8_STAGE(PG8_SB(0, 1), b2 + hstep, voffB);
            PG8_WAIT_V(6); PG8_BAR; PG8_MMA(1, 1, At, B1); PG8_BAR;
            PG8_LDB(B0, 1, 0); PG8_SCHED; PG8_LDA(At, 1, 0); PG8_STAGE(PG8_SA(0, 1), a2, o2[1]);
            PG8_WAIT_L(8); PG8_BAR; PG8_WAIT_L(0); PG8_MMA(0, 0, At, B0); PG8_BAR; PG8_SCHED;
            PG8_LDB(B1, 1, 1); PG8_STAGE(PG8_SB(1, 0), b3, voffB);
            PG8_BAR; PG8_WAIT_L(0); PG8_MMA(0, 1, At, B1); PG8_BAR;
            PG8_LDA(At, 1, 1); PG8_STAGE(PG8_SA(1, 0), a3, o2[0]);
            PG8_BAR; PG8_WAIT_L(0); PG8_MMA(1, 0, At, B0); PG8_BAR; PG8_SCHED;
            PG8_STAGE(PG8_SB(1, 1), b3 + hstep, voffB);
            PG8_WAIT_V(6); PG8_BAR; PG8_MMA(1, 1, At, B1); PG8_BAR;
        }
        E(acc, cur, wr, wc, fr, fq);
        if (!has_next) break;
#pragma unroll
        for (int a = 0; a < 2; ++a)
#pragma unroll
            for (int b = 0; b < 2; ++b)
#pragma unroll
                for (int m = 0; m < 4; ++m)
#pragma unroll
                    for (int n = 0; n < 2; ++n) acc[a][b][m][n] = (f32x4){0.f, 0.f, 0.f, 0.f};
        cur = nxt; cB = nB; ++ui; ga[0][0] = gn[0][0]; ga[0][1] = gn[0][1]; ga[1][0] = gn[1][0]; ga[1][1] = gn[1][1];
    }
    PG8_WAIT_V(0);
    if (wr == 0) PG8_BAR;
    PG8_BAR;
#undef PG8_SA
#undef PG8_SB
#undef PG8_STAGE
#undef PG8_ROWS
#undef PG8_LDA
#undef PG8_LDB
#undef PG8_MMA
#undef PG8_WAIT_V
#undef PG8_WAIT_L
#undef PG8_BAR
#undef PG8_SCHED
}
}

struct Ctx {
    LAS unsigned char* lds;
    int tid, lane, wave, G, bid;
};

struct TrItem { const float* W; int N, k0, n0; bf16_t* WT; int ldk, drow0; const float* gain; };
template <bool NT>
__device__ __forceinline__ void tr_load(const TrItem& d, f32x4 (&v)[8], int lane) {
#pragma unroll
    for (int i = 0; i < 8; ++i) { const int kk = 8 * i + (lane >> 3); const f32x4* p = (const f32x4*)&d.W[(size_t)(d.k0 + kk) * d.N + d.n0 + 4 * (lane & 7)]; v[i] = NT ? __builtin_nontemporal_load(p) : *p; }
}
template <bool NT>
__device__ __forceinline__ void tr_finish(const TrItem& d, f32x4 (&v)[8], LAS float* scr, int lane) {
    if (d.gain) {
#pragma unroll
        for (int i = 0; i < 8; ++i) v[i] *= d.gain[d.k0 + 8 * i + (lane >> 3)];
    }
#pragma unroll
    for (int i = 0; i < 8; ++i) { LAS float* s = scr + (8 * i + (lane >> 3)) * 33 + 4 * (lane & 7); s[0] = v[i].x; s[1] = v[i].y; s[2] = v[i].z; s[3] = v[i].w; }
    LDS_WAIT(); asm volatile("" ::: "memory");
    const int c = lane & 7;
#pragma unroll
    for (int j = 0; j < 4; ++j) { const int n = (lane >> 3) + 8 * j; const LAS float* s = scr + (8 * c) * 33 + n;
        u32x4 o; o.x = pk2(s[0 * 33], s[1 * 33]); o.y = pk2(s[2 * 33], s[3 * 33]); o.z = pk2(s[4 * 33], s[5 * 33]); o.w = pk2(s[6 * 33], s[7 * 33]);
        u32x4* dp = (u32x4*)(d.WT + (size_t)(d.drow0 + n) * d.ldk + d.k0 + 8 * c); if (NT) __builtin_nontemporal_store(o, dp); else *dp = o; }
    LDS_WAIT(); asm volatile("" ::: "memory");
}
__device__ __forceinline__ void rms_row_to_bf16(const float* xrow, const float* gain, bf16_t* orow, int lane) {
    const f32x4* xr = (const f32x4*)xrow + 2 * lane;
    f32x4 v[8]; float s = 0.f;
#pragma unroll
    for (int j = 0; j < 8; ++j) { v[j] = xr[128 * (j >> 1) + (j & 1)]; s += (v[j].x * v[j].x + v[j].y * v[j].y) + (v[j].z * v[j].z + v[j].w * v[j].w); }
    const float r = 1.0f / sqrtf(wave_sum(s) * (1.f / D) + EPS);
    u32x4* o16 = (u32x4*)orow + lane;
#pragma unroll
    for (int j = 0; j < 4; ++j) {
        const f32x4 g0 = gain ? ((const f32x4*)gain)[128 * j + 2 * lane] : (f32x4){1.f, 1.f, 1.f, 1.f}, g1 = gain ? ((const f32x4*)gain)[128 * j + 2 * lane + 1] : (f32x4){1.f, 1.f, 1.f, 1.f};
        const f32x4 a = v[2 * j] * r * g0, b = v[2 * j + 1] * r * g1;
        o16[64 * j] = (u32x4){pk2(a.x, a.y), pk2(a.z, a.w), pk2(b.x, b.y), pk2(b.z, b.w)}; }
}

struct P0Args { const float *x, *norm_a, *w_in, *w_out_a, *norm_kv, *w_kv, *norm_b, *w_q, *w_out_b, *w_gate, *w_up, *w_down, *w_rg, *w_re; float* WR;
                bf16_t *Win_t, *Wouta_t, *Wkvq_t, *Woutb_t, *Wgu_t, *Wd_t, *XN; };
constexpr int I_IN = 32 * (GIN / 32), I_OA = 64 * 64, I_KV = 32 * 128, I_Q = 32 * 64, I_OB = 32 * 64, I_G1 = 32 * 24, I_D1 = 12 * 64;
constexpr int I_G = 64 * I_G1, I_DN = 64 * I_D1;
constexpr int NITEMS = I_IN + I_OA + I_KV + I_Q + I_OB + 2 * I_G + I_DN;
__device__ __forceinline__ TrItem p0_desc(const P0Args& a, int it) {
    int r = it;
    if (r < I_IN) { const int nnb = GIN / 32, kb = r / nnb, nb = r % nnb; return TrItem{a.w_in, GIN, 64 * kb, 32 * nb, a.Win_t, D, 32 * nb, nullptr}; } r -= I_IN;
    if (r < I_OA) { const int kb = r / 64, nb = r % 64; return TrItem{a.w_out_a, D, 64 * kb, 32 * nb, a.Wouta_t, GVDIM, 32 * nb, nullptr}; } r -= I_OA;
    if (r < I_KV) { const int kb = r / 128, nb = r % 128; return TrItem{a.w_kv, 2 * SBDIM, 64 * kb, 32 * nb, a.Wkvq_t, D, 32 * nb, a.norm_kv}; } r -= I_KV;
    if (r < I_Q) { const int kb = r / 64, nb = r % 64; return TrItem{a.w_q, SBDIM, 64 * kb, 32 * nb, a.Wkvq_t, D, 2 * SBDIM + 32 * nb, a.norm_b}; } r -= I_Q;
    if (r < I_OB) { const int kb = r / 64, nb = r % 64; return TrItem{a.w_out_b, D, 64 * kb, 32 * nb, a.Woutb_t, SBDIM, 32 * nb, nullptr}; } r -= I_OB;
    if (r < I_G) { const int mi = r / I_G1, q = r % I_G1, kb = q / 24, nb = q % 24, n0 = 32 * nb;
        return TrItem{a.w_gate + (size_t)mi * D * HID, HID, 64 * kb, n0, a.Wgu_t + (size_t)mi * 2 * HID * D, D, 256 * (n0 / 128) + (n0 % 128), nullptr}; } r -= I_G;
    if (r < I_G) { const int mi = r / I_G1, q = r % I_G1, kb = q / 24, nb = q % 24, n0 = 32 * nb;
        return TrItem{a.w_up + (size_t)mi * D * HID, HID, 64 * kb, n0, a.Wgu_t + (size_t)mi * 2 * HID * D, D, 256 * (n0 / 128) + 128 + (n0 % 128), nullptr}; } r -= I_G;
    { const int mi = r / I_D1, q = r % I_D1, kb = q / 64, nb = q % 64;
        return TrItem{a.w_down + (size_t)mi * HID * D, D, 64 * kb, 32 * nb, a.Wd_t + (size_t)mi * D * HID, HID, 32 * nb, nullptr}; }
}
__device__ __forceinline__ void p0_prologue(const Ctx& F, const P0Args& a) {
    LAS float* scr = (LAS float*)(F.lds + F.wave * 16384);
    const int gw = F.bid * 8 + F.wave, NGW = F.G * 8;
    for (int it = gw; it < I_IN; it += NGW) { const TrItem d = p0_desc(a, it); f32x4 v[8]; tr_load<false>(d, v, F.lane); tr_finish<false>(d, v, scr, F.lane); }
    for (int m = gw; m < T; m += NGW) rms_row_to_bf16(a.x + (size_t)m * D, a.norm_a, a.XN + (size_t)m * D, F.lane);
    for (int i = F.bid * 512 + F.tid; i < 2 * D * WRN; i += F.G * 512) { const int l = i / (D * WRN), q = i % (D * WRN), k = 4 * (q / (4 * WRN)) + (q & 3), n = (q / 4) % WRN;
        a.WR[i] = n < NGRP ? a.w_rg[(size_t)(l * D + k) * NGRP + n] : n < NGRP + NE ? a.w_re[(size_t)(l * D + k) * NE + (n - NGRP)] : 0.f; }
}
constexpr int P0_TK = 32;
__device__ __forceinline__ void p0_queue(const Ctx& F, const P0Args& a, unsigned* ticket) {
    LAS float* scr = (LAS float*)(F.lds + F.wave * 16384);
    constexpr int NREST = NITEMS - I_IN;
    for (;;) {
        unsigned t = 0;
        if (F.lane == 0) t = __hip_atomic_fetch_add(ticket, 1u, __ATOMIC_RELAXED, __HIP_MEMORY_SCOPE_AGENT);
        t = __builtin_amdgcn_readfirstlane(t);
        if ((long)t * P0_TK >= NREST) break;
        const int i0 = (int)t * P0_TK, i1 = i0 + P0_TK < NREST ? i0 + P0_TK : NREST;
        f32x4 va[8], vb[8];
        tr_load<true>(p0_desc(a, I_IN + i0), va, F.lane);
        for (int it = i0; it < i1; it += 2) {
            if (it + 1 < i1) tr_load<true>(p0_desc(a, I_IN + it + 1), vb, F.lane);
            { const TrItem d = p0_desc(a, I_IN + it); tr_finish<true>(d, va, scr, F.lane); }
            if (it + 2 < i1) tr_load<true>(p0_desc(a, I_IN + it + 2), va, F.lane);
            if (it + 1 < i1) { const TrItem d = p0_desc(a, I_IN + it + 1); tr_finish<true>(d, vb, scr, F.lane); }
        }
    }
}

constexpr int GCH = 32;
__device__ __forceinline__ void p2_gdn_ref(const Ctx& F, const bf16_t* proj, const float* conv_w, const float* a_log, const float* dt_bias, const float* out_gain, bf16_t* og) {
    LAS float* qs = (LAS float*)F.lds;
    LAS float* ks = qs + GCH * HD;
    LAS float* vs = ks + GCH * HD;
    LAS float* ob = vs + GCH * HD;
    LAS float* bet = ob + GCH * HD;
    LAS float* egs = bet + GCH;
    const int cl = F.lane & 15, qd = F.lane >> 4, c = F.wave * 16 + cl;
    for (int unit = F.bid; unit < BATCH * GVH; unit += F.G) {
        const int b = unit / GVH, hv = unit % GVH, hk = hv / 2;
        const float A = __expf(a_log[hv]), dtb = dt_bias[hv];
        float S[32];
#pragma unroll
        for (int i = 0; i < 32; ++i) S[i] = 0.f;
        for (int ch = 0; ch < SEQ / GCH; ++ch) {
            const int t0 = ch * GCH;
            for (int idx = F.tid; idx < 3 * GCH * HD; idx += 512) {
                const int which = idx / (GCH * HD), tl = (idx / HD) % GCH, cc = idx % HD;
                const int col = which == 0 ? hk * HD + cc : which == 1 ? GKDIM + hk * HD + cc : 2 * GKDIM + hv * HD + cc;
                float acc = 0.f;
#pragma unroll
                for (int j = 0; j < 4; ++j) { const int tt = t0 + tl - 3 + j; if (tt >= 0) acc += conv_w[j * GCONV + col] * bf2f(proj[(size_t)(b * SEQ + tt) * GIN_PAD + col]); }
                qs[which * GCH * HD + tl * HD + cc] = silu_f(acc);
            }
            if (F.tid < GCH) { const size_t row = (size_t)(b * SEQ + t0 + F.tid) * GIN_PAD;
                bet[F.tid] = sigmoid_f(bf2f(proj[row + GCONV + GVDIM + hv]));
                const float av = bf2f(proj[row + GCONV + GVDIM + GVH + hv]);
                egs[F.tid] = __expf(-A * softplus_f(av + dtb)); }
            __syncthreads();
            for (int tl = F.wave; tl < GCH; tl += 8) {
                const float q0 = qs[tl * HD + 2 * F.lane], q1 = qs[tl * HD + 2 * F.lane + 1], k0 = ks[tl * HD + 2 * F.lane], k1 = ks[tl * HD + 2 * F.lane + 1];
                const float rq = 1.0f / sqrtf(wave_sum(q0 * q0 + q1 * q1) + EPS) * 0.08838834764831845f, rk = 1.0f / sqrtf(wave_sum(k0 * k0 + k1 * k1) + EPS);
                qs[tl * HD + 2 * F.lane] = q0 * rq; qs[tl * HD + 2 * F.lane + 1] = q1 * rq; ks[tl * HD + 2 * F.lane] = k0 * rk; ks[tl * HD + 2 * F.lane + 1] = k1 * rk;
            }
            __syncthreads();
            for (int tl = 0; tl < GCH; ++tl) {
                const float e = egs[tl], bt = bet[tl];
                float dk = 0.f, dq = 0.f, kq = 0.f;
                const LAS f32x4* kp = (const LAS f32x4*)(ks + tl * HD + 32 * qd); const LAS f32x4* qp = (const LAS f32x4*)(qs + tl * HD + 32 * qd);
                f32x4 kv[8];
#pragma unroll
                for (int i = 0; i < 8; ++i) { kv[i] = kp[i]; const f32x4 qv = qp[i];
#pragma unroll
                    for (int j = 0; j < 4; ++j) { S[4 * i + j] *= e; dk += kv[i][j] * S[4 * i + j]; dq += qv[j] * S[4 * i + j]; kq += kv[i][j] * qv[j]; } }
                dk += __shfl_xor(dk, 16); dk += __shfl_xor(dk, 32);
                dq += __shfl_xor(dq, 16); dq += __shfl_xor(dq, 32);
                kq += __shfl_xor(kq, 16); kq += __shfl_xor(kq, 32);
                const float vn = bt * (vs[tl * HD + c] - dk);
#pragma unroll
                for (int i = 0; i < 8; ++i)
#pragma unroll
                    for (int j = 0; j < 4; ++j) S[4 * i + j] += kv[i][j] * vn;
                if (qd == 0) ob[tl * HD + c] = dq + kq * vn;
            }
            __syncthreads();
            for (int tl = F.wave; tl < GCH; tl += 8) {
                const float o0 = ob[tl * HD + 2 * F.lane], o1 = ob[tl * HD + 2 * F.lane + 1];
                const float r = 1.0f / sqrtf(wave_sum(o0 * o0 + o1 * o1) * (1.f / HD) + EPS);
                const size_t row = (size_t)(b * SEQ + t0 + tl);
                const unsigned zz = *(const unsigned*)(proj + row * GIN_PAD + GCONV + hv * HD + 2 * F.lane);
                const float z0 = bf2f(zz & 0xffffu), z1 = bf2f(zz >> 16);
                *(unsigned*)(og + row * GVDIM + hv * HD + 2 * F.lane) = pk2(o0 * r * out_gain[2 * F.lane] * silu_f(z0), o1 * r * out_gain[2 * F.lane + 1] * silu_f(z1));
            }
            __syncthreads();
        }
    }
}


namespace gdn {
typedef float f32x16 __attribute__((ext_vector_type(16)));
typedef short s16x4 __attribute__((ext_vector_type(4)));
__device__ __forceinline__ unsigned off_b(unsigned row, unsigned ch) { return 256u * row + 16u * (ch ^ (((row & 3) << 2) | ((row >> 2) & 3))); }
__device__ __forceinline__ unsigned off64(unsigned row, unsigned ch) { return 128u * row + 16u * (ch ^ (row & 7)); }
constexpr int L_KU = 0, L_QU = 16384, L_VNT = 16384, L_VV = 32768, L_ST = 49152, L_LP = 81920, L_RT = 81920, L_OB = 81920, L_TM = 98304, L_SSQ = 98304, L_AQ = 106496, L_VNTE = 114688;
constexpr int L_CW = RING_BYTES, L_SC = L_CW + 6144;
constexpr int L_TR = L_SC + 2560, L_TT = L_TR + 4096;
constexpr int SC_BETA = 0, SC_RK = 64, SC_RQ = 128, SC_G2 = 192, SC_AK = 256, SC_BQ = 320, SC_EV = 384, SC_DL = 448, SC_GAIN = 512;
static_assert(L_TT + 4096 <= LDSCTL_OFF, "gdn lds");
__device__ __forceinline__ int crow(int r, int hi) { return (r & 3) + 8 * (r >> 2) + 4 * hi; }
__device__ __forceinline__ unsigned cvtpk(float lo, float hi) { return pk2(lo, hi); }
__device__ __forceinline__ float dpp_add8(float v) {
    v += __int_as_float(__builtin_amdgcn_mov_dpp(__float_as_int(v), 0xB1, 0xF, 0xF, true));
    v += __int_as_float(__builtin_amdgcn_mov_dpp(__float_as_int(v), 0x4E, 0xF, 0xF, true));
    v += __int_as_float(__builtin_amdgcn_mov_dpp(__float_as_int(v), 0x141, 0xF, 0xF, true));
    return v;
}
__device__ __forceinline__ s16x4 tr_read(unsigned addr) { s16x4 r; asm volatile("ds_read_b64_tr_b16 %0, %1" : "=&v"(r) : "v"(addr) : "memory"); return r; }
}

__device__ __forceinline__ void p2_gdn(const Ctx& F, const bf16_t* proj, const float* conv_w, const float* a_log, const float* dt_bias, const float* out_gain, bf16_t* og) {
    using namespace gdn;
    LAS unsigned char* L = F.lds;
    const unsigned lbase = (unsigned)(size_t)L;
    LAS float* cw = (LAS float*)(L + L_CW);
    LAS float* sc = (LAS float*)(L + L_SC);
    LAS float* ssq = (LAS float*)(L + L_SSQ);
    int tid = F.tid, lane = F.lane, r32 = lane & 31, hi = lane >> 5;
    const int w = F.wave;
#define GDN_FRESH() do { asm volatile("" : "+v"(tid)); lane = tid & 63; r32 = lane & 31; hi = lane >> 5; } while (0)
    const int tb = w >> 2, vb = w & 3;
    const int kb = w >> 1, vbase = 2 * (w & 1);
    for (int unit = F.bid; unit < BATCH * GVH; unit += F.G) {
        const int b = unit / GVH, hv = unit % GVH, hk = hv / 2;
        const float Aexp = __expf(a_log[hv]), dtb = dt_bias[hv];
        __syncthreads();
        for (int idx = tid; idx < 4 * 384; idx += 512) { const int j = idx / 384, cl = idx % 384;
            const int col = cl < 128 ? hk * HD + cl : cl < 256 ? GKDIM + hk * HD + (cl - 128) : 2 * GKDIM + hv * HD + (cl - 256);
            cw[idx] = conv_w[j * GCONV + col]; }
        for (int idx = tid; idx < 32768 / 16; idx += 512) *(LAS u32x4*)(L + L_ST + idx * 16) = (u32x4){0u, 0u, 0u, 0u};
        f32x16 Sacc[2] = {};
        u32x4 pre[3][5];
#define GDN_LOADPRE(CH) do { _Pragma("unroll") for (int k_ = 0; k_ < 3; ++k_) { const int item_ = tid + 512 * k_, cc_ = item_ % 48, tok0_ = 2 * (item_ / 48); \
        const int col_ = cc_ < 16 ? hk * HD + cc_ * 8 : cc_ < 32 ? GKDIM + hk * HD + (cc_ - 16) * 8 : 2 * GKDIM + hv * HD + (cc_ - 32) * 8; \
        _Pragma("unroll") for (int rr_ = 0; rr_ < 5; ++rr_) { int tt_ = (CH) * 64 + tok0_ - 3 + rr_; tt_ = tt_ < 0 ? 0 : tt_; \
            pre[k_][rr_] = *(const u32x4*)(proj + (size_t)(b * SEQ + tt_) * GIN_PAD + col_); } } } while (0)
        GDN_LOADPRE(0);
        unsigned short braw = 0, araw = 0;
        if (w == 6) { const bf16_t* pr = proj + ((size_t)(b * SEQ) + lane) * GIN_PAD + GCONV + GVDIM; braw = pr[hv]; araw = pr[GVH + hv]; }
        for (int idx = tid; idx < HD; idx += 512) sc[SC_GAIN + idx] = out_gain[idx];
        __syncthreads();
        for (int ch = 0; ch < SEQ / 64; ++ch) {
            const int t0 = ch * 64;
            const size_t rowbase = (size_t)(b * SEQ + t0);
            GDN_FRESH();
            u32x4 zreg[2];
#pragma unroll
            for (int k = 0; k < 3; ++k) {
                const int item = tid + 512 * k, cc = item % 48, tok0 = 2 * (item / 48);
                float x[5][8];
#pragma unroll
                for (int rr = 0; rr < 5; ++rr) {
                    u32x4 u = pre[k][rr];
                    if (ch == 0 && rr < 3 && tok0 - 3 + rr < 0) u = (u32x4){0u, 0u, 0u, 0u};
                    x[rr][0] = bf2f(u.x & 0xffffu); x[rr][1] = bf2f(u.x >> 16); x[rr][2] = bf2f(u.y & 0xffffu); x[rr][3] = bf2f(u.y >> 16);
                    x[rr][4] = bf2f(u.z & 0xffffu); x[rr][5] = bf2f(u.z >> 16); x[rr][6] = bf2f(u.w & 0xffffu); x[rr][7] = bf2f(u.w >> 16);
                }
                float y[2][8];
#pragma unroll
                for (int e = 0; e < 8; ++e) { y[0][e] = 0.f; y[1][e] = 0.f; }
#pragma unroll
                for (int j = 0; j < 4; ++j) {
                    const f32x4 w0 = *(const LAS f32x4*)(cw + j * 384 + cc * 8), w1 = *(const LAS f32x4*)(cw + j * 384 + cc * 8 + 4);
#pragma unroll
                    for (int d = 0; d < 2; ++d) {
                        y[d][0] += w0.x * x[d + j][0]; y[d][1] += w0.y * x[d + j][1]; y[d][2] += w0.z * x[d + j][2]; y[d][3] += w0.w * x[d + j][3];
                        y[d][4] += w1.x * x[d + j][4]; y[d][5] += w1.y * x[d + j][5]; y[d][6] += w1.z * x[d + j][6]; y[d][7] += w1.w * x[d + j][7];
                    }
                }
                float s2[2];
#pragma unroll
                for (int d = 0; d < 2; ++d) {
                    s2[d] = 0.f;
#pragma unroll
                    for (int e = 0; e < 8; ++e) { y[d][e] = silu_f(y[d][e]); s2[d] += y[d][e] * y[d][e]; }
                    u32x4 o; o.x = cvtpk(y[d][0], y[d][1]); o.y = cvtpk(y[d][2], y[d][3]); o.z = cvtpk(y[d][4], y[d][5]); o.w = cvtpk(y[d][6], y[d][7]);
                    const int tile = cc < 16 ? L_QU : cc < 32 ? L_KU : L_VV;
                    *(LAS u32x4*)(L + tile + off_b(tok0 + d, cc & 15)) = o;
                }
                if (cc < 32) *(LAS f32x2*)(ssq + cc * 64 + tok0) = (f32x2){s2[0], s2[1]};
            }
            __syncthreads();
            GDN_FRESH();
            f32x16 accB = {};
            const int bblk = w % 3, bib = bblk == 0 ? 0 : 1, bjb = bblk == 2 ? 1 : 0;
            if (w < 6) {
                const int btile = w >= 3 ? L_QU : L_KU;
#pragma unroll
                for (int s = 0; s < 8; ++s) {
                    const bf16x8 a = *(const LAS bf16x8*)(L + L_KU + off_b(32 * bjb + r32, 2 * s + hi));
                    const bf16x8 bq = *(const LAS bf16x8*)(L + btile + off_b(32 * bib + r32, 2 * s + hi));
                    accB = __builtin_amdgcn_mfma_f32_32x32x16_bf16(a, bq, accB, 0, 0, 0);
                }
            } else if (w == 6) {
                float sq = 0.f, sk = 0.f;
#pragma unroll
                for (int c = 0; c < 16; ++c) { sq += ssq[c * 64 + lane]; sk += ssq[(16 + c) * 64 + lane]; }
                const float rq = 0.08838834764831845f / sqrtf(sq + EPS), rk = 1.0f / sqrtf(sk + EPS);
                const float blog = bf2f(braw), alog = bf2f(araw);
                if (ch + 1 < SEQ / 64) { const bf16_t* pr = proj + (rowbase + 64 + lane) * GIN_PAD + GCONV + GVDIM; braw = pr[hv]; araw = pr[GVH + hv]; }
                const float bet = sigmoid_f(blog);
                float g2 = -Aexp * softplus_f(alog + dtb) * 1.4426950408889634f;
#pragma unroll
                for (int o = 1; o < 64; o <<= 1) { const float t = __shfl_up(g2, o); if (lane >= o) g2 += t; }
                const float g2last = __shfl(g2, 63);
                const float eg = __builtin_amdgcn_exp2f(g2);
                sc[SC_BETA + lane] = bet; sc[SC_RK + lane] = rk; sc[SC_RQ + lane] = rq; sc[SC_G2 + lane] = g2;
                sc[SC_AK + lane] = rk * eg; sc[SC_BQ + lane] = rq * eg; sc[SC_EV + lane] = rk * __builtin_amdgcn_exp2f(g2last - g2);
                if (lane == 0) sc[SC_DL] = __builtin_amdgcn_exp2f(g2last);
            }
            __syncthreads();
            GDN_FRESH();
            if (w < 6) {
                const int i = 32 * bib + r32;
                const float g2i = sc[SC_G2 + i];
                const float fi = w < 3 ? sc[SC_BETA + i] * sc[SC_RK + i] : sc[SC_RQ + i];
                float val[16];
#pragma unroll
                for (int r = 0; r < 16; ++r) {
                    const int j = 32 * bjb + crow(r, hi);
                    const float dec = __builtin_amdgcn_exp2f(fminf(g2i - sc[SC_G2 + j], 0.f));
                    const bool keep = w < 3 ? (j < i) : (j <= i);
                    val[r] = keep ? fi * sc[SC_RK + j] * accB[r] * dec : 0.f;
                }
                if (w < 3) {
#pragma unroll
                    for (int g = 0; g < 4; ++g) *(LAS f32x4*)(L + L_LP + (i * 64 + 32 * bjb + 8 * g + 4 * hi) * 4) = (f32x4){val[4 * g], val[4 * g + 1], val[4 * g + 2], val[4 * g + 3]};
                } else {
#pragma unroll
                    for (int g = 0; g < 4; ++g) *(LAS u32x2*)(L + L_AQ + off64(i, 4 * bjb + g) + 8 * hi) = (u32x2){cvtpk(val[4 * g], val[4 * g + 1]), cvtpk(val[4 * g + 2], val[4 * g + 3])};
                }
            }
            { const u32x4* zp = (const u32x4*)(proj + (rowbase + (tid >> 3)) * GIN_PAD + GCONV + hv * HD + (tid & 7) * 16); zreg[0] = zp[0]; zreg[1] = zp[1]; }
            __syncthreads();
            GDN_FRESH();
            if (ch + 1 < SEQ / 64) GDN_LOADPRE(ch + 1);
            f32x16 ksacc = {}, qsacc = {};
#pragma unroll
            for (int s = 0; s < 8; ++s) {
                const bf16x8 ak = *(const LAS bf16x8*)(L + L_KU + off_b(32 * tb + r32, 2 * s + hi));
                const bf16x8 aq = *(const LAS bf16x8*)(L + L_QU + off_b(32 * tb + r32, 2 * s + hi));
                const bf16x8 bs = *(const LAS bf16x8*)(L + L_ST + off_b(32 * vb + r32, 2 * s + hi));
                ksacc = __builtin_amdgcn_mfma_f32_32x32x16_bf16(ak, bs, ksacc, 0, 0, 0);
                qsacc = __builtin_amdgcn_mfma_f32_32x32x16_bf16(aq, bs, qsacc, 0, 0, 0);
            }
            GDN_FRESH();
            {
                LAS float* TRm = (LAS float*)(L + L_TR); LAS float* TTm = (LAS float*)(L + L_TT);
                const LAS float* Lm = (const LAS float*)(L + L_LP);
                const int c16 = lane & 15, q4 = lane >> 4;
                if (w < 4) {
                    const int bb = w;
                    float Tc[16];
#pragma unroll
                    for (int rb = 0; rb < 4; ++rb) {
                        f32x4 lr[4][4];
#pragma unroll
                        for (int r = 0; r < 4; ++r)
#pragma unroll
                            for (int ch4 = 0; ch4 < 4; ++ch4) if (ch4 <= rb) lr[r][ch4] = *(const LAS f32x4*)(Lm + (16 * bb + 4 * rb + r) * 64 + 16 * bb + 4 * ch4);
#pragma unroll
                        for (int r = 0; r < 4; ++r) {
                            const int row = 4 * rb + r;
                            float s0 = 0.f, s1 = 0.f;
#pragma unroll
                            for (int rp = 0; rp < 16; ++rp) if (rp < row) { const float lv = lr[r][rp >> 2][rp & 3]; if (rp & 1) s1 += lv * Tc[rp]; else s0 += lv * Tc[rp]; }
                            Tc[row] = (c16 == row ? 1.f : 0.f) - (s0 + s1);
                        }
                    }
#pragma unroll
                    for (int e = 0; e < 4; ++e) {
                        const float tv = q4 == 0 ? Tc[e] : q4 == 1 ? Tc[4 + e] : q4 == 2 ? Tc[8 + e] : Tc[12 + e];
                        const int row = 4 * q4 + e;
                        TRm[(bb * 16 + row) * 16 + c16] = tv;
                        TTm[(bb * 16 + c16) * 16 + row] = tv;
                        const int gi = 16 * bb + row, gj = 16 * bb + c16;
                        *(LAS bf16_t*)(L + L_TM + off64(gi, gj >> 3) + (gj & 7) * 2) = (bf16_t)f2bf(tv);
                    }
                } else if (w == 4) {
                    const int blk = lane >> 5, row = (lane >> 1) & 15, chh = lane & 1;
                    *(LAS u32x4*)(L + L_TM + off64(32 * blk + row, 4 * blk + 2 + chh)) = (u32x4){0u, 0u, 0u, 0u};
                }
                __syncthreads();
                GDN_FRESH();
                if (w < 3) {
                    const int jb = w, c16b = lane & 15, q4b = lane >> 4;
                    f32x4 Tk[4];
                    Tk[jb] = *(const LAS f32x4*)(TTm + (jb * 16 + c16b) * 16 + 4 * q4b);
#pragma unroll
                    for (int ib = 1; ib < 4; ++ib) if (ib > jb) {
                        f32x4 S = {0.f, 0.f, 0.f, 0.f};
#pragma unroll
                        for (int kb2 = 0; kb2 < 3; ++kb2) if (kb2 >= jb && kb2 < ib) {
                            const f32x4 a4 = *(const LAS f32x4*)(Lm + (16 * ib + c16b) * 64 + 16 * kb2 + 4 * q4b);
#pragma unroll
                            for (int e = 0; e < 4; ++e) S = __builtin_amdgcn_mfma_f32_16x16x4f32(a4[e], Tk[kb2][e], S, 0, 0, 0);
                        }
                        const f32x4 t4 = *(const LAS f32x4*)(TRm + (ib * 16 + c16b) * 16 + 4 * q4b);
                        f32x4 Tn = {0.f, 0.f, 0.f, 0.f};
#pragma unroll
                        for (int e = 0; e < 4; ++e) Tn = __builtin_amdgcn_mfma_f32_16x16x4f32(t4[e], S[e], Tn, 0, 0, 0);
                        Tn = -Tn; Tk[ib] = Tn;
#pragma unroll
                        for (int e = 0; e < 4; ++e) { const int gi = 16 * ib + 4 * q4b + e, gj = 16 * jb + c16b;
                            *(LAS bf16_t*)(L + L_TM + off64(gi, gj >> 3) + (gj & 7) * 2) = (bf16_t)f2bf(Tn[e]); }
                    }
                }
            }
            __syncthreads();
            GDN_FRESH();
            f32x16 oacc;
            {
                const int dv = 32 * vb + r32;
                float val[16];
#pragma unroll
                for (int r = 0; r < 16; ++r) {
                    const int tok = 32 * tb + crow(r, hi);
                    const float vv = bf2f(*(const LAS bf16_t*)(L + L_VV + off_b(tok, dv >> 3) + (dv & 7) * 2));
                    val[r] = sc[SC_BETA + tok] * (vv - sc[SC_AK + tok] * ksacc[r]);
                    oacc[r] = sc[SC_BQ + tok] * qsacc[r];
                }
#pragma unroll
                for (int g = 0; g < 4; ++g) *(LAS u32x2*)(L + L_RT + off64(dv, 4 * tb + g) + 8 * hi) = (u32x2){cvtpk(val[4 * g], val[4 * g + 1]), cvtpk(val[4 * g + 2], val[4 * g + 3])};
            }
            __syncthreads();
            GDN_FRESH();
            {
                f32x16 vn = {};
#pragma unroll
                for (int s = 0; s < 4; ++s) if (s < 2 || tb) {
                    const bf16x8 a = *(const LAS bf16x8*)(L + L_TM + off64(32 * tb + r32, 2 * s + hi));
                    const bf16x8 bq = *(const LAS bf16x8*)(L + L_RT + off64(32 * vb + r32, 2 * s + hi));
                    vn = __builtin_amdgcn_mfma_f32_32x32x16_bf16(a, bq, vn, 0, 0, 0);
                }
                const int dv = 32 * vb + r32;
#pragma unroll
                for (int g = 0; g < 4; ++g) {
                    float e[4];
#pragma unroll
                    for (int c = 0; c < 4; ++c) e[c] = vn[4 * g + c] * sc[SC_EV + 32 * tb + crow(4 * g + c, hi)];
                    *(LAS u32x2*)(L + L_VNT + off64(dv, 4 * tb + g) + 8 * hi) = (u32x2){cvtpk(vn[4 * g], vn[4 * g + 1]), cvtpk(vn[4 * g + 2], vn[4 * g + 3])};
                    *(LAS u32x2*)(L + L_VNTE + off64(dv, 4 * tb + g) + 8 * hi) = (u32x2){cvtpk(e[0], e[1]), cvtpk(e[2], e[3])};
                }
            }
            __syncthreads();
            GDN_FRESH();
            {
#pragma unroll
                for (int s = 0; s < 4; ++s) if (s < 2 || tb) {
                    const bf16x8 a = *(const LAS bf16x8*)(L + L_AQ + off64(32 * tb + r32, 2 * s + hi));
                    const bf16x8 bq = *(const LAS bf16x8*)(L + L_VNT + off64(32 * vb + r32, 2 * s + hi));
                    oacc = __builtin_amdgcn_mfma_f32_32x32x16_bf16(a, bq, oacc, 0, 0, 0);
                }
                const int dv = 32 * vb + r32;
#pragma unroll
                for (int r = 0; r < 16; ++r) *(LAS bf16_t*)(L + L_OB + (32 * tb + crow(r, hi)) * 256 + dv * 2) = (bf16_t)f2bf(oacc[r]);
            }
            GDN_FRESH();
            {
                const float dl = sc[SC_DL];
                Sacc[0] *= dl; Sacc[1] *= dl;
                const unsigned blk = (lane >> 4) & 1, q = (lane & 15) >> 2, p = lane & 3;
#pragma unroll
                for (int ks = 0; ks < 4; ++ks) {
                    const s16x4 t0v = tr_read(lbase + L_KU + off_b(16 * ks + 8 * hi + q, 4 * kb + 2 * blk + (p >> 1)) + 8 * (p & 1));
                    const s16x4 t1v = tr_read(lbase + L_KU + off_b(16 * ks + 8 * hi + 4 + q, 4 * kb + 2 * blk + (p >> 1)) + 8 * (p & 1));
                    const bf16x8 b0 = *(const LAS bf16x8*)(L + L_VNTE + off64(32 * vbase + r32, 2 * ks + hi));
                    const bf16x8 b1 = *(const LAS bf16x8*)(L + L_VNTE + off64(32 * (vbase + 1) + r32, 2 * ks + hi));
                    asm volatile("s_waitcnt lgkmcnt(0)" ::: "memory"); __builtin_amdgcn_sched_barrier(0);
                    const bf16x8 a = (bf16x8){t0v[0], t0v[1], t0v[2], t0v[3], t1v[0], t1v[1], t1v[2], t1v[3]};
                    Sacc[0] = __builtin_amdgcn_mfma_f32_32x32x16_bf16(a, b0, Sacc[0], 0, 0, 0);
                    Sacc[1] = __builtin_amdgcn_mfma_f32_32x32x16_bf16(a, b1, Sacc[1], 0, 0, 0);
                }
#pragma unroll
                for (int v2 = 0; v2 < 2; ++v2)
#pragma unroll
                    for (int g = 0; g < 4; ++g)
                        *(LAS u32x2*)(L + L_ST + off_b(32 * (vbase + v2) + r32, 4 * kb + g) + 8 * hi) = (u32x2){cvtpk(Sacc[v2][4 * g], Sacc[v2][4 * g + 1]), cvtpk(Sacc[v2][4 * g + 2], Sacc[v2][4 * g + 3])};
            }
            __syncthreads();
            GDN_FRESH();
            {
                const int tok = tid >> 3, seg = tid & 7;
                const u32x4 oa = *(const LAS u32x4*)(L + L_OB + tok * 256 + seg * 32), ob2 = *(const LAS u32x4*)(L + L_OB + tok * 256 + seg * 32 + 16);
                float o[16], z[16];
                const unsigned ow[8] = {oa.x, oa.y, oa.z, oa.w, ob2.x, ob2.y, ob2.z, ob2.w};
                const unsigned zw[8] = {zreg[0].x, zreg[0].y, zreg[0].z, zreg[0].w, zreg[1].x, zreg[1].y, zreg[1].z, zreg[1].w};
                float ss = 0.f;
#pragma unroll
                for (int e = 0; e < 8; ++e) { o[2 * e] = bf2f(ow[e] & 0xffffu); o[2 * e + 1] = bf2f(ow[e] >> 16); z[2 * e] = bf2f(zw[e] & 0xffffu); z[2 * e + 1] = bf2f(zw[e] >> 16);
                    ss += o[2 * e] * o[2 * e] + o[2 * e + 1] * o[2 * e + 1]; }
                const float r = 1.0f / sqrtf(dpp_add8(ss) * (1.f / HD) + EPS);
                unsigned res[8];
#pragma unroll
                for (int e = 0; e < 8; ++e) { const f32x2 gg = *(const LAS f32x2*)(sc + SC_GAIN + seg * 16 + 2 * e);
                    res[e] = pk2(o[2 * e] * r * gg.x * silu_f(z[2 * e]), o[2 * e + 1] * r * gg.y * silu_f(z[2 * e + 1])); }
                u32x4* op = (u32x4*)(og + (rowbase + tok) * GVDIM + hv * HD + seg * 16);
                op[0] = (u32x4){res[0], res[1], res[2], res[3]}; op[1] = (u32x4){res[4], res[5], res[6], res[7]};
            }
        }
#undef GDN_LOADPRE
    }
}
#undef GDN_FRESH

struct MoeBufs { int* blk_cnt; int* pad_start; int* tok_e; float* tok_w; int* tok_slot; };
__device__ __forceinline__ void p_moe_route(const Ctx& F, const float* h, const float* gain, const float* WR, const float* b_rg, const float* b_re, bf16_t* XN, const MoeBufs& mb) {
    constexpr int YS = D + 4;
    LAS float* y = (LAS float*)F.lds;
    LAS float* part = y + 16 * YS;
    LAS float* lgt = part + 8 * 16 * WRN;
    LAS int* lcnt = (LAS int*)(lgt + 16 * 40);
    static_assert((16 * YS + 8 * 16 * WRN + 16 * 40 + 32) * 4 <= LDSCTL_OFF, "route lds");
    constexpr int TPB = 64;
    const int lane = F.lane, w = F.wave;
    for (int blk = F.bid; blk < T / TPB; blk += F.G) {
        if (F.tid < NE) lcnt[F.tid] = 0;
        __syncthreads();
        for (int rd = 0; rd < 4; ++rd) {
#pragma unroll
            for (int q = 0; q < 2; ++q) {
                const int tl = 2 * w + q, t = blk * TPB + rd * 16 + tl;
                const f32x4* xr = (const f32x4*)(h + (size_t)t * D) + 2 * lane;
                f32x4 v[8]; float s = 0.f;
#pragma unroll
                for (int j = 0; j < 8; ++j) { v[j] = xr[128 * (j >> 1) + (j & 1)]; s += (v[j].x * v[j].x + v[j].y * v[j].y) + (v[j].z * v[j].z + v[j].w * v[j].w); }
                const float r = 1.0f / sqrtf(wave_sum(s) * (1.f / D) + EPS);
                u32x4* o16 = (u32x4*)(XN + (size_t)t * D) + lane;
#pragma unroll
                for (int j = 0; j < 4; ++j) {
                    const f32x4 a = v[2 * j] * r * ((const f32x4*)gain)[128 * j + 2 * lane], b = v[2 * j + 1] * r * ((const f32x4*)gain)[128 * j + 2 * lane + 1];
                    o16[64 * j] = (u32x4){pk2(a.x, a.y), pk2(a.z, a.w), pk2(b.x, b.y), pk2(b.z, b.w)};
                    LAS f32x4* yp = (LAS f32x4*)(y + tl * YS + 8 * (64 * j + lane)); yp[0] = a; yp[1] = b; }
            }
            __syncthreads();
            {
                f32x4 acc0 = {0.f, 0.f, 0.f, 0.f}, acc1 = acc0, acc2 = acc0;
                const LAS float* ya = y + (lane & 15) * YS + 256 * w + 4 * (lane >> 4);
                const float* wb = WR + ((size_t)(64 * w + (lane >> 4)) * WRN + (lane & 15)) * 4;
#pragma unroll 4
                for (int j = 0; j < 16; ++j) {
                    const f32x4 a4 = *(const LAS f32x4*)(ya + 16 * j);
                    const f32x4 b0 = *(const f32x4*)(wb + (size_t)(4 * j) * WRN * 4), b1 = *(const f32x4*)(wb + (size_t)(4 * j) * WRN * 4 + 64), b2 = *(const f32x4*)(wb + (size_t)(4 * j) * WRN * 4 + 128);
#pragma unroll
                    for (int e = 0; e < 4; ++e) {
                        acc0 = __builtin_amdgcn_mfma_f32_16x16x4f32(a4[e], b0[e], acc0, 0, 0, 0);
                        acc1 = __builtin_amdgcn_mfma_f32_16x16x4f32(a4[e], b1[e], acc1, 0, 0, 0);
                        acc2 = __builtin_amdgcn_mfma_f32_16x16x4f32(a4[e], b2[e], acc2, 0, 0, 0);
                    }
                }
#pragma unroll
                for (int r = 0; r < 4; ++r) { LAS float* pp = part + (w * 16 + 4 * (lane >> 4) + r) * WRN + (lane & 15);
                    pp[0] = acc0[r]; pp[16] = acc1[r]; pp[32] = acc2[r]; }
            }
            __syncthreads();
            for (int idx = F.tid; idx < 16 * 36; idx += 512) {
                const int tok = idx / 36, n = idx % 36;
                float s = 0.f;
#pragma unroll
                for (int ww = 0; ww < 8; ++ww) s += part[(ww * 16 + tok) * WRN + n];
                lgt[tok * 40 + n] = s + (n < NGRP ? b_rg[n] : b_re[n - NGRP]);
            }
            __syncthreads();
#pragma unroll
            for (int q = 0; q < 2; ++q) {
                const int tl = 2 * w + q, t = blk * TPB + rd * 16 + tl;
                const LAS float* lg = lgt + tl * 40;
                int gi = 0; float gm = lg[0];
#pragma unroll
                for (int i = 1; i < NGRP; ++i) { const float v = lg[i]; if (v > gm) { gm = v; gi = i; } }
                float den = 0.f;
#pragma unroll
                for (int i = 0; i < NGRP; ++i) den += __expf(lg[i] - gm);
                const float gval = 1.0f / den;
                const LAS float* le = lg + NGRP + gi * EPG;
                int i1 = 0; float l1 = le[0];
#pragma unroll
                for (int i = 1; i < EPG; ++i) { const float v = le[i]; if (v > l1) { l1 = v; i1 = i; } }
                int i2 = -1; float l2 = -3.0e38f;
#pragma unroll
                for (int i = 0; i < EPG; ++i) { const float v = le[i]; if (i != i1 && v > l2) { l2 = v; i2 = i; } }
                const float ex = __expf(l2 - l1), w1 = 1.0f / (1.0f + ex), w2 = ex / (1.0f + ex);
                if (lane == 0) {
                    const int e1 = gi * EPG + i1, e2 = gi * EPG + i2;
                    const int p1 = atomicAdd((int*)&lcnt[e1], 1), p2 = atomicAdd((int*)&lcnt[e2], 1);
                    mb.tok_e[2 * t] = e1 | (p1 << 8); mb.tok_e[2 * t + 1] = e2 | (p2 << 8);
                    mb.tok_w[2 * t] = gval * w1; mb.tok_w[2 * t + 1] = gval * w2;
                }
            }
        }
        __syncthreads();
        if (F.tid < NE) mb.blk_cnt[blk * NE + F.tid] = lcnt[F.tid];
        __syncthreads();
    }
}
__device__ __forceinline__ void p_moe_scatter(const Ctx& F, const bf16_t* XN, bf16_t* XS, const MoeBufs& mb) {
    LAS int* tot = (LAS int*)F.lds;
    LAS int* base = tot + 32;
    LAS int* pst = base + 32;
    constexpr int TPB = 64, NBLK = T / TPB;
    for (int blk = F.bid; blk < NBLK; blk += F.G) {
        if (F.tid < NE) { int s = 0, bs = 0; for (int j = 0; j < NBLK; ++j) { const int c = mb.blk_cnt[j * NE + F.tid]; s += c; bs += (j < blk) ? c : 0; } tot[F.tid] = s; base[F.tid] = bs; }
        __syncthreads();
        if (F.tid == 0) { int s = 0; for (int e = 0; e < NE; ++e) { pst[e] = s; s += (tot[e] + 255) & ~255; } pst[NE] = s;
            if (blk == 0) for (int e = 0; e <= NE; ++e) mb.pad_start[e] = pst[e]; }
        __syncthreads();
        for (int a = F.wave; a < 2 * TPB; a += 8) {
            const int ai = blk * 2 * TPB + a, t = ai >> 1;
            const int ep = mb.tok_e[ai], e = ep & 0xff, lp = ep >> 8;
            const int slot = pst[e] + base[e] + lp;
            const u32x4* src = (const u32x4*)(XN + (size_t)t * D) + F.lane; u32x4* dst = (u32x4*)(XS + (size_t)slot * D) + F.lane;
#pragma unroll
            for (int j = 0; j < 4; ++j) dst[64 * j] = src[64 * j];
            if (F.lane == 0) mb.tok_slot[ai] = slot;
        }
        __syncthreads();
    }
}
__device__ __forceinline__ void moe_units(const Ctx& F, const MoeBufs& mb, int nN, pg8::ListOrder& S) {
    LAS int* pst = (LAS int*)(F.lds + LDSCTL_OFF + 256);
    if (F.tid <= NE) pst[F.tid] = mb.pad_start[F.tid];
    __syncthreads();
    const int nmt = pst[NE] / 256, n = nmt * nN;
    int d[8]; int cnt = 0;
#pragma unroll
    for (int i = 0; i < 8; ++i) {
        const int L = i * F.G + F.bid; d[i] = 0;
        if (L < n) {
            int wgid = L; { const int q = n / 8, r = n % 8, xcd = wgid % 8, off = wgid / 8; wgid = (xcd < r ? xcd * (q + 1) : r * (q + 1) + (xcd - r) * q) + off; }
            const int mt = wgid / nN, pn = wgid % nN;
            int e = 0; for (int j = 1; j <= NE - 1; ++j) e += (pst[j] <= mt * 256) ? 1 : 0;
            d[i] = __builtin_amdgcn_readfirstlane(mt | (pn << 12) | ((e * nN + pn) << 16)); cnt = i + 1;
        }
    }
    S.n = __builtin_amdgcn_readfirstlane(cnt); S.d0 = d[0]; S.d1 = d[1]; S.d2 = d[2]; S.d3 = d[3]; S.d4 = d[4]; S.d5 = d[5]; S.d6 = d[6]; S.d7 = d[7];
    __syncthreads();
}
__device__ __forceinline__ void moe_gather_prep(const Ctx& F, const MoeBufs& mb, int nN, pg8::ListOrder& S, LAS int* rowtok) {
    constexpr int TPB = 64, NBLK = T / TPB;
    LAS int* base = (LAS int*)F.lds;
    LAS int* segsum = base + NBLK * NE;
    LAS int* segoff = segsum + 16 * NE;
    LAS int* pst = segoff + 16 * NE;
    LAS int* umt = pst + 64;
    {   const int e = F.tid & 31, seg = F.tid >> 5; int s = 0;
        for (int j = seg * 16; j < seg * 16 + 16; ++j) { base[j * NE + e] = s; s += mb.blk_cnt[j * NE + e]; }
        segsum[seg * NE + e] = s; }
    __syncthreads();
    if (F.tid < NE) { int run = 0; for (int sg = 0; sg < 16; ++sg) { segoff[sg * NE + F.tid] = run; run += segsum[sg * NE + F.tid]; } segsum[F.tid] = run; }
    __syncthreads();
    if (F.tid == 0) { int s = 0; for (int e = 0; e < NE; ++e) { pst[e] = s; s += (segsum[e] + 255) & ~255; } pst[NE] = s;
        if (F.bid == 0) for (int e = 0; e <= NE; ++e) mb.pad_start[e] = pst[e]; }
    for (int i = F.tid; i < 8 * 256; i += 512) rowtok[i] = 0;
    __syncthreads();
    const int nmt = pst[NE] / 256, n = nmt * nN;
    int d[8]; int cnt = 0;
#pragma unroll
    for (int i = 0; i < 8; ++i) {
        const int Lq = i * F.G + F.bid; d[i] = 0;
        if (Lq < n) {
            int wgid = Lq; { const int q = n / 8, r = n % 8, xcd = wgid % 8, off = wgid / 8; wgid = (xcd < r ? xcd * (q + 1) : r * (q + 1) + (xcd - r) * q) + off; }
            const int mt = wgid / nN, pn = wgid % nN;
            int e = 0; for (int j = 1; j <= NE - 1; ++j) e += (pst[j] <= mt * 256) ? 1 : 0;
            d[i] = __builtin_amdgcn_readfirstlane(mt | (pn << 12) | ((e * nN + pn) << 16)); cnt = i + 1;
            if (F.tid == 0) umt[i] = mt;
        } else if (F.tid == 0) umt[i] = -1;
    }
    S.n = __builtin_amdgcn_readfirstlane(cnt); S.d0 = d[0]; S.d1 = d[1]; S.d2 = d[2]; S.d3 = d[3]; S.d4 = d[4]; S.d5 = d[5]; S.d6 = d[6]; S.d7 = d[7];
    __syncthreads();
    int um[8];
#pragma unroll
    for (int i = 0; i < 8; ++i) um[i] = umt[i];
    for (int a = F.tid; a < 2 * T; a += 512) {
        const int ep = mb.tok_e[a], e = ep & 0xff, lp = ep >> 8, blk = a >> 7;
        const int slot = pst[e] + segoff[(blk >> 4) * NE + e] + base[blk * NE + e] + lp;
        if (blk % F.G == F.bid) mb.tok_slot[a] = slot;
        const int mt = slot >> 8;
#pragma unroll
        for (int i = 0; i < 8; ++i) if (mt == um[i]) rowtok[i * 256 + (slot & 255)] = a >> 1;
    }
    __syncthreads();
}

__device__ __forceinline__ void p_moe_combine(const Ctx& F, float* h, const bf16_t* YS, const MoeBufs& mb, bf16_t* XN) {
    const int gw = F.bid * 8 + F.wave, NGW = F.G * 8;
    for (int t = gw; t < T; t += NGW) {
        const int s0 = mb.tok_slot[2 * t], s1 = mb.tok_slot[2 * t + 1]; const float w0 = mb.tok_w[2 * t], w1 = mb.tok_w[2 * t + 1];
        f32x4* hr = (f32x4*)(h + (size_t)t * D) + 2 * F.lane;
        const u32x4* y0 = (const u32x4*)(YS + (size_t)s0 * D) + F.lane; const u32x4* y1 = (const u32x4*)(YS + (size_t)s1 * D) + F.lane;
        f32x4 v[8]; float s = 0.f;
#pragma unroll
        for (int j = 0; j < 4; ++j) { const u32x4 a = y0[64 * j], b = y1[64 * j];
            f32x4 lo = hr[128 * j], hi4 = hr[128 * j + 1];
            lo.x += w0 * bf2f(a.x & 0xffffu) + w1 * bf2f(b.x & 0xffffu); lo.y += w0 * bf2f(a.x >> 16) + w1 * bf2f(b.x >> 16);
            lo.z += w0 * bf2f(a.y & 0xffffu) + w1 * bf2f(b.y & 0xffffu); lo.w += w0 * bf2f(a.y >> 16) + w1 * bf2f(b.y >> 16);
            hi4.x += w0 * bf2f(a.z & 0xffffu) + w1 * bf2f(b.z & 0xffffu); hi4.y += w0 * bf2f(a.z >> 16) + w1 * bf2f(b.z >> 16);
            hi4.z += w0 * bf2f(a.w & 0xffffu) + w1 * bf2f(b.w & 0xffffu); hi4.w += w0 * bf2f(a.w >> 16) + w1 * bf2f(b.w >> 16);
            hr[128 * j] = lo; hr[128 * j + 1] = hi4; v[2 * j] = lo; v[2 * j + 1] = hi4;
            s += (lo.x * lo.x + lo.y * lo.y) + (lo.z * lo.z + lo.w * lo.w) + (hi4.x * hi4.x + hi4.y * hi4.y) + (hi4.z * hi4.z + hi4.w * hi4.w); }
        if (XN) { const float r = 1.0f / sqrtf(wave_sum(s) * (1.f / D) + EPS); u32x4* o16 = (u32x4*)(XN + (size_t)t * D) + F.lane;
#pragma unroll
            for (int j = 0; j < 4; ++j) o16[64 * j] = (u32x4){pk2(v[2 * j].x * r, v[2 * j].y * r), pk2(v[2 * j].z * r, v[2 * j].w * r), pk2(v[2 * j + 1].x * r, v[2 * j + 1].y * r), pk2(v[2 * j + 1].z * r, v[2 * j + 1].w * r)}; }
    }
}
__device__ __forceinline__ void p_qk_norm(const Ctx& F, bf16_t* kvq, const float* k_gain, const float* q_gain) {
    const int gw = F.bid * 8 + F.wave, NGW = F.G * 8;
    for (int r = gw; r < T * 2 * SBH; r += NGW) {
        const int t = r / (2 * SBH), hh = r % (2 * SBH); const bool isq = hh >= SBH;
        unsigned* p = (unsigned*)(kvq + (size_t)t * KVQ + (isq ? 2 * SBDIM + (hh - SBH) * HD : hh * HD)) + F.lane;
        const unsigned u = *p; const float a = bf2f(u & 0xffffu), b = bf2f(u >> 16);
        const float rr = 1.0f / sqrtf(wave_sum(a * a + b * b) * (1.f / HD) + EPS);
        const float* g = isq ? q_gain : k_gain;
        const float qs = isq ? 0.12751743082459868f : 1.0f;
        *p = pk2(a * rr * g[2 * F.lane] * qs, b * rr * g[2 * F.lane + 1] * qs);
    }
}
__device__ __forceinline__ void p_sb_attn_ref(const Ctx& F, const bf16_t* kvq, bf16_t* ao) {
    LAS float* Kt = (LAS float*)F.lds;
    LAS float* Vt = Kt + 64 * HD;
    const int il = F.tid >> 1, half = F.tid & 1;
    for (int unit = F.bid; unit < BATCH * SBH * 4; unit += F.G) {
        const int p = unit & 3, bh = unit >> 2, b = bh / SBH, hh = bh % SBH;
        for (int side = 0; side < 2; ++side) {
            const int qb = side == 0 ? 7 - p : p;
            const int i = qb * 256 + il;
            float q[64], o[64];
            { const u32x4* qp = (const u32x4*)(kvq + (size_t)(b * SEQ + i) * KVQ + 2 * SBDIM + hh * HD + half * 64);
#pragma unroll
              for (int j = 0; j < 8; ++j) { const u32x4 u = qp[j];
                  q[8 * j + 0] = bf2f(u.x & 0xffffu); q[8 * j + 1] = bf2f(u.x >> 16); q[8 * j + 2] = bf2f(u.y & 0xffffu); q[8 * j + 3] = bf2f(u.y >> 16);
                  q[8 * j + 4] = bf2f(u.z & 0xffffu); q[8 * j + 5] = bf2f(u.z >> 16); q[8 * j + 6] = bf2f(u.w & 0xffffu); q[8 * j + 7] = bf2f(u.w >> 16); } }
#pragma unroll
            for (int d = 0; d < 64; ++d) { q[d] *= 0.08838834764831845f; o[d] = 0.f; }
            float csum = 0.f;
            for (int kt = qb * 4 + 3; kt >= 0; --kt) {
                __syncthreads();
                for (int idx = F.tid; idx < 64 * 16 * 2; idx += 512) {
                    const int which = idx / 1024, r = (idx / 16) % 64, c8 = idx % 16;
                    const u32x4 u = *(const u32x4*)(kvq + (size_t)(b * SEQ + kt * 64 + r) * KVQ + which * SBDIM + hh * HD + c8 * 8);
                    LAS float* dst = (which ? Vt : Kt) + r * HD + c8 * 8;
                    dst[0] = bf2f(u.x & 0xffffu); dst[1] = bf2f(u.x >> 16); dst[2] = bf2f(u.y & 0xffffu); dst[3] = bf2f(u.y >> 16);
                    dst[4] = bf2f(u.z & 0xffffu); dst[5] = bf2f(u.z >> 16); dst[6] = bf2f(u.w & 0xffffu); dst[7] = bf2f(u.w >> 16);
                }
                __syncthreads();
                for (int jl = 63; jl >= 0; --jl) {
                    const int j = kt * 64 + jl;
                    if (j < i) {
                        const LAS f32x4* kp = (const LAS f32x4*)(Kt + jl * HD + half * 64);
                        float z = 0.f;
#pragma unroll
                        for (int d = 0; d < 16; ++d) { const f32x4 kk = kp[d]; z += q[4 * d] * kk.x + q[4 * d + 1] * kk.y + q[4 * d + 2] * kk.z + q[4 * d + 3] * kk.w; }
                        z += __shfl_xor(z, 1);
                        csum -= softplus_f(z);
                        const float w = __expf(z + csum);
                        const LAS f32x4* vp = (const LAS f32x4*)(Vt + jl * HD + half * 64);
#pragma unroll
                        for (int d = 0; d < 16; ++d) { const f32x4 vv = vp[d]; o[4 * d] += w * vv.x; o[4 * d + 1] += w * vv.y; o[4 * d + 2] += w * vv.z; o[4 * d + 3] += w * vv.w; }
                    }
                }
            }
            u32x4* op = (u32x4*)(ao + (size_t)(b * SEQ + i) * SBDIM + hh * HD + half * 64);
#pragma unroll
            for (int j = 0; j < 8; ++j) { u32x4 w; w.x = pk2(o[8 * j], o[8 * j + 1]); w.y = pk2(o[8 * j + 2], o[8 * j + 3]); w.z = pk2(o[8 * j + 4], o[8 * j + 5]); w.w = pk2(o[8 * j + 6], o[8 * j + 7]); op[j] = w; }
        }
    }
}


namespace sba {
typedef float f32x16 __attribute__((ext_vector_type(16)));
typedef short s16x4 __attribute__((ext_vector_type(4)));
constexpr int SHM_V = 64 * HD * 2, SHM_K = 64 * HD * 2;
#define SBA_KSWZ(row, colB) ((row) * 256 + ((colB) ^ (((row) & 7) << 4)))
__device__ __forceinline__ int crow(int r, int hi) { return (r & 3) + 8 * (r >> 2) + 4 * hi; }
__device__ __forceinline__ unsigned cvtpk(float lo, float hi) { return pk2(lo, hi); }
__device__ __forceinline__ void qkt(f32x16& p0, f32x16& p1, const LAS char* Ks, const bf16x8* qr, int r32, int hi) {
    p0 = f32x16{}; p1 = f32x16{};
#pragma unroll
    for (int d0 = 0; d0 < 8; ++d0) { const int cb = (d0 * 16 + hi * 8) * 2;
        const bf16x8 b0 = *(const LAS bf16x8*)(Ks + SBA_KSWZ(r32, cb));
        const bf16x8 b1 = *(const LAS bf16x8*)(Ks + SBA_KSWZ(32 + r32, cb));
        p0 = __builtin_amdgcn_mfma_f32_32x32x16_bf16(b0, qr[d0], p0, 0, 0, 0);
        p1 = __builtin_amdgcn_mfma_f32_32x32x16_bf16(b1, qr[d0], p1, 0, 0, 0); }
}
__device__ __forceinline__ int v_st(int k, int c) { const int kk = (k & ~0xC) | ((k & 4) << 1) | ((k & 8) >> 1); return ((kk >> 3) * 4 + (c >> 5)) * 512 + ((kk & 7) * 32 + (c & 31)) * 2; }
__device__ __forceinline__ int v_rd_base(int lane) { return ((lane & 3) << 3) | (((lane >> 2) & 3) << 6) | (((lane >> 4) & 1) << 5) | (((lane >> 5) & 1) << 8); }
constexpr int v_rd_off(int d0, int ks, int half) { return d0 * 512 + ks * 4096 + half * 2048; }
template <int OFF> __device__ __forceinline__ s16x4 tr_read(int vb) { s16x4 r; asm volatile("ds_read_b64_tr_b16 %0, %1 offset:%2" : "=&v"(r) : "v"(vb), "i"(OFF) : "memory"); return r; }
template <int D0> __device__ __forceinline__ void pv_one(f32x16& od, int vb, bf16x8 pa0, bf16x8 pa1, bf16x8 pa2, bf16x8 pa3) {
    const s16x4 l0 = tr_read<v_rd_off(D0, 0, 0)>(vb), h0 = tr_read<v_rd_off(D0, 0, 1)>(vb), l1 = tr_read<v_rd_off(D0, 1, 0)>(vb), h1 = tr_read<v_rd_off(D0, 1, 1)>(vb);
    const s16x4 l2 = tr_read<v_rd_off(D0, 2, 0)>(vb), h2 = tr_read<v_rd_off(D0, 2, 1)>(vb), l3 = tr_read<v_rd_off(D0, 3, 0)>(vb), h3 = tr_read<v_rd_off(D0, 3, 1)>(vb);
    asm volatile("s_waitcnt lgkmcnt(0)" ::: "memory"); __builtin_amdgcn_sched_barrier(0);
#define SBA_PK(L, H) (bf16x8){L[0], L[1], L[2], L[3], H[0], H[1], H[2], H[3]}
    od = __builtin_amdgcn_mfma_f32_32x32x16_bf16(pa0, SBA_PK(l0, h0), od, 0, 0, 0);
    od = __builtin_amdgcn_mfma_f32_32x32x16_bf16(pa1, SBA_PK(l1, h1), od, 0, 0, 0);
    od = __builtin_amdgcn_mfma_f32_32x32x16_bf16(pa2, SBA_PK(l2, h2), od, 0, 0, 0);
    od = __builtin_amdgcn_mfma_f32_32x32x16_bf16(pa3, SBA_PK(l3, h3), od, 0, 0, 0);
#undef SBA_PK
}
__device__ __forceinline__ void sb_weights(f32x16& p0, f32x16& p1, float& carry, float hmask, bf16x8& pa0, bf16x8& pa1, bf16x8& pa2, bf16x8& pa3) {
    f32x16 l0, l1;
#pragma unroll
    for (int r = 0; r < 16; ++r) {
        const float t0 = __builtin_amdgcn_exp2f(fminf(p0[r], 64.f)), t1 = __builtin_amdgcn_exp2f(fminf(p1[r], 64.f));
        l0[r] = __builtin_amdgcn_rcpf(1.0f + t0); l1[r] = __builtin_amdgcn_rcpf(1.0f + t1);
        p0[r] = t0 * l0[r]; p1[r] = t1 * l1[r];
    }
#pragma unroll
    for (int m = 0; m < 4; ++m) {
        p0[4 * m + 2] *= l0[4 * m + 3]; l0[4 * m + 2] *= l0[4 * m + 3]; p0[4 * m + 1] *= l0[4 * m + 2]; l0[4 * m + 1] *= l0[4 * m + 2]; p0[4 * m] *= l0[4 * m + 1]; l0[4 * m] *= l0[4 * m + 1];
        p1[4 * m + 2] *= l1[4 * m + 3]; l1[4 * m + 2] *= l1[4 * m + 3]; p1[4 * m + 1] *= l1[4 * m + 2]; l1[4 * m + 1] *= l1[4 * m + 2]; p1[4 * m] *= l1[4 * m + 1]; l1[4 * m] *= l1[4 * m + 1];
    }
    float Pm[8], Om[8];
#pragma unroll
    for (int m = 0; m < 8; ++m) {
        const float tm = m < 4 ? l0[4 * m] : l1[4 * (m - 4)];
        auto rr = __builtin_amdgcn_permlane32_swap(__float_as_uint(tm), __float_as_uint(tm), false, false);
        const float e = __uint_as_float(rr[0]), o = __uint_as_float(rr[1]);
        Pm[m] = e * o; Om[m] = hmask * o + (1.0f - hmask);
    }
    float sp = carry;
#pragma unroll
    for (int m = 7; m >= 0; --m) {
        const float off = sp * Om[m];
        if (m < 4) {
#pragma unroll
            for (int j = 0; j < 4; ++j) p0[4 * m + j] *= off;
        } else {
#pragma unroll
            for (int j = 0; j < 4; ++j) p1[4 * (m - 4) + j] *= off;
        }
        sp *= Pm[m];
    }
    carry = sp;
#define SBA_PK4(P, BASE, OUT) do { unsigned a0 = cvtpk(P[BASE + 0], P[BASE + 1]), a1 = cvtpk(P[BASE + 2], P[BASE + 3]); \
    unsigned b0 = cvtpk(P[BASE + 4], P[BASE + 5]), b1 = cvtpk(P[BASE + 6], P[BASE + 7]); \
    auto r0 = __builtin_amdgcn_permlane32_swap(a0, b0, false, false); auto r1 = __builtin_amdgcn_permlane32_swap(a1, b1, false, false); \
    u32x4 w = {r0[0], r1[0], r0[1], r1[1]}; OUT = *reinterpret_cast<bf16x8*>(&w); } while (0)
    SBA_PK4(p0, 0, pa0); SBA_PK4(p0, 8, pa1); SBA_PK4(p1, 0, pa2); SBA_PK4(p1, 8, pa3);
#undef SBA_PK4
}
}

__device__ __forceinline__ void p_sb_attn(const Ctx& F, const bf16_t* kvq, bf16_t* ao) {
    using namespace sba;
    LAS char* V_lds = (LAS char*)F.lds; LAS char* K_lds = V_lds + 2 * SHM_V;
    const int tid = F.tid, wid = F.wave, lane = F.lane, r32 = lane & 31, hi = lane >> 5;
    const int sr = tid >> 4, sc = (tid & 15) * 8, vst0 = v_st(sr, sc), vst1 = v_st(32 + sr, sc);
    const int vb0 = (int)(unsigned)(size_t)V_lds + v_rd_base(lane);
    const float hmask = hi ? 0.f : 1.f;
    const int vcu = (F.G % 8 == 0) ? (F.bid % 8) * (F.G / 8) + F.bid / 8 : F.bid;
    for (int unit = vcu; unit < BATCH * SBH * 4; unit += F.G) {
        const int p = unit & 3, bh = unit >> 2, b = bh / SBH, hh = bh % SBH;
        const bf16_t* Kh = kvq + (size_t)(b * SEQ) * KVQ + hh * HD; const bf16_t* Vh = Kh + SBDIM; const bf16_t* Qh = Kh + 2 * SBDIM;
        for (int side = 0; side < 2; ++side) {
            const int qb = side == 0 ? 7 - p : p;
            const int i0 = qb * 256 + wid * 32;
            bf16x8 qr[8];
            { const bf16_t* Qw = Qh + (size_t)(i0 + r32) * KVQ + hi * 8;
#pragma unroll
              for (int d0 = 0; d0 < 8; ++d0) qr[d0] = *(const bf16x8*)(Qw + d0 * 16); }
            f32x16 o[4] = {};
            float carry = 1.f;
            const int NT = 4 * qb + 4;
            bf16x8 vs0, vs1, ks0, ks1;
#define SBA_SLOAD(k0) do { vs0 = *(const bf16x8*)(Vh + (size_t)((k0) + sr) * KVQ + sc); vs1 = *(const bf16x8*)(Vh + (size_t)((k0) + 32 + sr) * KVQ + sc); \
    ks0 = *(const bf16x8*)(Kh + (size_t)((k0) + sr) * KVQ + sc); ks1 = *(const bf16x8*)(Kh + (size_t)((k0) + 32 + sr) * KVQ + sc); } while (0)
#define SBA_SWRITE(bf) do { *(LAS bf16x8*)(V_lds + (bf) * SHM_V + vst0) = vs0; *(LAS bf16x8*)(V_lds + (bf) * SHM_V + vst1) = vs1; const int kc = sc * 2; \
    *(LAS bf16x8*)(K_lds + (bf) * SHM_K + SBA_KSWZ(sr, kc)) = ks0; *(LAS bf16x8*)(K_lds + (bf) * SHM_K + SBA_KSWZ(32 + sr, kc)) = ks1; } while (0)
            __syncthreads();
            SBA_SLOAD((NT - 1) * 64); SBA_SWRITE(0);
            if (NT > 1) SBA_SLOAD((NT - 2) * 64);
            __syncthreads();
            for (int n = 0; n < NT; ++n) {
                const int kt = NT - 1 - n, buf = n & 1;
                if (n + 1 < NT) { SBA_SWRITE(buf ^ 1); if (n + 2 < NT) SBA_SLOAD((kt - 2) * 64); }
                if (64 * kt < i0 + 31) {
                    f32x16 p0, p1;
                    qkt(p0, p1, K_lds + buf * SHM_K, qr, r32, hi);
                    if (64 * kt + 63 >= i0) {
                        const int irow = i0 + r32;
#pragma unroll
                        for (int r = 0; r < 16; ++r) { const int j = 64 * kt + crow(r, hi); p0[r] = (j < irow) ? p0[r] : -1.0e30f; p1[r] = (j + 32 < irow) ? p1[r] : -1.0e30f; }
                    }
                    bf16x8 pa0, pa1, pa2, pa3;
                    sb_weights(p0, p1, carry, hmask, pa0, pa1, pa2, pa3);
                    const int vb = vb0 + buf * SHM_V;
                    pv_one<0>(o[0], vb, pa0, pa1, pa2, pa3); pv_one<1>(o[1], vb, pa0, pa1, pa2, pa3); pv_one<2>(o[2], vb, pa0, pa1, pa2, pa3); pv_one<3>(o[3], vb, pa0, pa1, pa2, pa3);
                }
                __syncthreads();
            }
#undef SBA_SLOAD
#undef SBA_SWRITE
            bf16_t* Ow = ao + (size_t)(b * SEQ + i0) * SBDIM + hh * HD;
#pragma unroll
            for (int r = 0; r < 16; ++r) { const int orow = crow(r, hi);
#pragma unroll
                for (int d0 = 0; d0 < 4; ++d0) Ow[(size_t)orow * SBDIM + d0 * 32 + r32] = (bf16_t)f2bf(o[d0][r]); }
        }
    }
}

constexpr int NPH = 18;
struct Args { const float* in[23]; float* out; unsigned char* ws; int ph_lo, ph_hi; };
__global__ void __launch_bounds__(512, 2) yoco_fwd(Args args) {
    extern __shared__ __attribute__((aligned(16))) unsigned char lds_raw[];
    Ctx F;
    F.lds = (LAS unsigned char*)lds_raw;
    F.tid = threadIdx.x; F.lane = F.tid & 63; F.wave = __builtin_amdgcn_readfirstlane(F.tid >> 6);
    F.G = gridDim.x; F.bid = blockIdx.x;
    unsigned char* ws = args.ws;
    const float* x = args.in[0];
    float* h = args.out;
    bf16_t* Win_t = (bf16_t*)(ws + WS_WIN); bf16_t* Wouta_t = (bf16_t*)(ws + WS_WOUTA); bf16_t* Wkvq_t = (bf16_t*)(ws + WS_WKVQ); bf16_t* Woutb_t = (bf16_t*)(ws + WS_WOUTB);
    bf16_t* Wgu_t = (bf16_t*)(ws + WS_WGU); bf16_t* Wd_t = (bf16_t*)(ws + WS_WD);
    bf16_t* XN = (bf16_t*)(ws + WS_XN); bf16_t* OG = (bf16_t*)(ws + WS_OG); bf16_t* PROJ = (bf16_t*)(ws + WS_BIG);
    bf16_t* XS = (bf16_t*)(ws + WS_XS); bf16_t* HB = (bf16_t*)(ws + WS_HB); bf16_t* YS = (bf16_t*)(ws + WS_YS);
    bf16_t* KVQB = (bf16_t*)(ws + WS_KVQ); bf16_t* AO = (bf16_t*)(ws + WS_AO);
    MoeBufs mb; mb.blk_cnt = (int*)(ws + WS_MISC + MI_BLKCNT); mb.pad_start = (int*)(ws + WS_MISC + MI_PADSTART); mb.tok_e = (int*)(ws + WS_MISC + MI_TOKE);
    mb.tok_w = (float*)(ws + WS_MISC + MI_TOKW); mb.tok_slot = (int*)(ws + WS_MISC + MI_TOKSLOT);

    for (int u = F.tid; u < (LDS_BYTES - LDSCTL_OFF) / 4; u += 512) ((LAS unsigned*)(F.lds + LDSCTL_OFF))[u] = 0u;
    __syncthreads();
    const int lo = args.ph_lo, hi = args.ph_hi;
    const bool multi = (hi - lo) > 1;
    XcdBarrier bar; bar.bar = (unsigned*)(ws + WS_CTL) + CW_BAR; bar.x = 0; bar.st = nullptr;
    if (multi) bar = xcd_barrier_post((unsigned*)(ws + WS_CTL) + CW_BAR, (volatile LAS unsigned*)(F.lds + LDSCTL_OFF));
#define IN(k) (lo <= (k) && (k) < hi)
#define SEAM(k) do { if (IN(k) && IN((k) + 1)) xcd_barrier(bar); } while (0)

    P0Args pa; pa.x = x; pa.norm_a = args.in[1]; pa.w_in = args.in[2]; pa.w_out_a = args.in[7]; pa.norm_kv = args.in[8]; pa.w_kv = args.in[9]; pa.norm_b = args.in[11]; pa.w_q = args.in[12];
    pa.w_out_b = args.in[14]; pa.w_gate = args.in[20]; pa.w_up = args.in[21]; pa.w_down = args.in[22]; pa.w_rg = args.in[16]; pa.w_re = args.in[18]; pa.WR = (float*)(ws + WS_WR);
    pa.Win_t = Win_t; pa.Wouta_t = Wouta_t; pa.Wkvq_t = Wkvq_t; pa.Woutb_t = Woutb_t; pa.Wgu_t = Wgu_t; pa.Wd_t = Wd_t; pa.XN = XN;
    if (IN(0)) { for (int rep = 0; rep < (MK_REP_PHASE == 0 ? 2 : 1); ++rep) p0_prologue(F, pa); }
    SEAM(0);
    if (IN(1)) {
        const int GG = F.G >= 128 ? F.G - 60 : F.G;
        if (F.bid < GG) {
            pg8::Gemm g{XN, Win_t, D}; pg8::StaticOrder S; S.init(T, GIN_PAD, GG, F.bid);
            pg8::EpiBf16 E{PROJ, GIN_PAD};
            pg8::gemm_phase<pg8::EpiBf16, pg8::StaticOrder>(F.lds, g, S, E);
            if (MK_REP_PHASE == 1) { __syncthreads(); pg8::gemm_phase<pg8::EpiBf16, pg8::StaticOrder>(F.lds, g, S, E); }
        }
        __syncthreads();
        p0_queue(F, pa, (unsigned*)(ws + WS_CTL) + CW_TICKET);
    }
    SEAM(1);
    if (IN(2)) { for (int rep = 0; rep < (MK_REP_PHASE == 2 ? 2 : 1); ++rep) p2_gdn(F, PROJ, args.in[3], args.in[4], args.in[5], args.in[6], OG); }
    SEAM(2);
    if (IN(3)) {
        pg8::Gemm g{OG, Wouta_t, GVDIM}; pg8::StaticOrder S; S.init(T, D, F.G, F.bid);
        pg8::EpiResF32 E{x, h, D};
        pg8::gemm_phase<pg8::EpiResF32, pg8::StaticOrder>(F.lds, g, S, E);
        if (MK_REP_PHASE == 3) { __syncthreads(); pg8::gemm_phase<pg8::EpiResF32, pg8::StaticOrder>(F.lds, g, S, E); }
    }
    SEAM(3);
#define MOE_PHASES(layer, pb, XNOUT) \
    if (IN(pb)) for (int rep = 0; rep < ((MK_REP_PHASE == 4 && (layer) == 0) ? 2 : 1); ++rep) p_moe_route(F, h, args.in[15] + (layer) * D, (const float*)(ws + WS_WR) + (size_t)(layer) * D * WRN, args.in[17] + (layer) * NGRP, args.in[19] + (layer) * NE, XN, mb); \
    do { if (IN(pb) && IN((pb) + 2)) xcd_barrier(bar); } while (0); \
    if (IN((pb) + 2)) { pg8::ListOrder S; LAS int* rowtok = (LAS int*)(F.lds + RING_BYTES + 8192); moe_gather_prep(F, mb, 2 * HID / 256, S, rowtok); \
        pg8::Gemm g{XN, Wgu_t + (size_t)(layer) * NE * 2 * HID * D, D}; pg8::EpiSwiGLU E{HB, HID}; \
        pg8::gemm_phase_gather<pg8::EpiSwiGLU, pg8::ListOrder>(F.lds, g, S, E, rowtok); } \
    SEAM((pb) + 2); \
    if (IN((pb) + 3)) { pg8::ListOrder S; moe_units(F, mb, D / 256, S); \
        pg8::Gemm g{HB, Wd_t + (size_t)(layer) * NE * D * HID, HID}; pg8::EpiBf16 E{YS, D}; \
        pg8::gemm_phase<pg8::EpiBf16, pg8::ListOrder>(F.lds, g, S, E); \
        if (MK_REP_PHASE == 7 && (layer) == 0) { __syncthreads(); pg8::gemm_phase<pg8::EpiBf16, pg8::ListOrder>(F.lds, g, S, E); } } \
    SEAM((pb) + 3); \
    if (IN((pb) + 4)) p_moe_combine(F, h, YS, mb, XNOUT);

    MOE_PHASES(0, 4, XN)
    SEAM(8);
    if (IN(9)) {
        pg8::Gemm g{XN, Wkvq_t, D}; pg8::StaticOrder S; S.init(T, KVQ, F.G, F.bid);
        pg8::EpiKvqNorm E{KVQB, args.in[10], args.in[13], (LAS float*)(F.lds + RING_BYTES)};
        pg8::gemm_phase<pg8::EpiKvqNorm, pg8::StaticOrder>(F.lds, g, S, E);
        if (MK_REP_PHASE == 9) { __syncthreads(); pg8::gemm_phase<pg8::EpiKvqNorm, pg8::StaticOrder>(F.lds, g, S, E); }
    }
    do { if (IN(9) && IN(11)) xcd_barrier(bar); } while (0);
    if (IN(11)) { for (int rep = 0; rep < (MK_REP_PHASE == 11 ? 2 : 1); ++rep) p_sb_attn(F, KVQB, AO); }
    SEAM(11);
    if (IN(12)) {
        pg8::Gemm g{AO, Woutb_t, SBDIM}; pg8::StaticOrder S; S.init(T, D, F.G, F.bid);
        pg8::EpiResF32 E{h, h, D};
        pg8::gemm_phase<pg8::EpiResF32, pg8::StaticOrder>(F.lds, g, S, E);
    }
    SEAM(12);
    MOE_PHASES(1, 13, (bf16_t*)nullptr)
#undef MOE_PHASES
#undef IN
#undef SEAM
}

extern "C" void kernel_launch(void* const* d_in, const int* in_sizes, int n_in, void* d_out, int out_size, void* d_ws, size_t ws_size, hipStream_t stream) {
    static int grid = 0;
    if (grid == 0) {
        if (n_in != 23 || out_size != T * D || ws_size < WS_END) { fprintf(stderr, "kernel_launch: unexpected shapes (n_in %d, out %d, ws %zu)\n", n_in, out_size, ws_size); grid = -1; return; }
        int dev = 0, cus = 0, per_cu = 0;
        if (hipGetDevice(&dev) != hipSuccess || hipDeviceGetAttribute(&cus, hipDeviceAttributeMultiprocessorCount, dev) != hipSuccess) { grid = -1; return; }
        if (hipFuncSetAttribute((const void*)yoco_fwd, hipFuncAttributeMaxDynamicSharedMemorySize, LDS_BYTES) != hipSuccess) { fprintf(stderr, "kernel_launch: hipFuncSetAttribute failed\n"); grid = -1; return; }
        if (hipOccupancyMaxActiveBlocksPerMultiprocessor(&per_cu, (const void*)yoco_fwd, 512, LDS_BYTES) != hipSuccess || per_cu < 1) fprintf(stderr, "kernel_launch: occupancy query reports %d\n", per_cu);
        (void)hipGetLastError();
        grid = cus;
        if (grid > 256) grid = 256;
    }
    if (grid < 0) return;
    (void)hipMemsetAsync((char*)d_ws + WS_CTL, 0, CTL_ZERO_BYTES, stream);
    Args a{};
    for (int i = 0; i < 23; ++i) a.in[i] = (const float*)d_in[i];
    a.out = (float*)d_out; a.ws = (unsigned char*)d_ws;
#if MK_ONE_LAUNCH
    a.ph_lo = 0; a.ph_hi = MK_LAST_PHASE;
    hipLaunchKernelGGL(yoco_fwd, dim3(grid), dim3(512), LDS_BYTES, stream, a);
#else
    for (int p = 0; p < MK_LAST_PHASE; ++p) { if (p == 10 || p == 5 || p == 14) continue; a.ph_lo = p; a.ph_hi = p + 1; hipLaunchKernelGGL(yoco_fwd, dim3(grid), dim3(512), LDS_BYTES, stream, a); }
#endif
}
```

```cpp
#include <hip/hip_runtime.h>
#include <cstdio>

#ifndef MK_ONE_LAUNCH
#define MK_ONE_LAUNCH 1
#endif
#ifndef MK_REP_PHASE
#define MK_REP_PHASE -1
#endif
#ifndef MK_LAST_PHASE
#define MK_LAST_PHASE 18
#endif

#define GAS __attribute__((address_space(1)))
#define LAS __attribute__((address_space(3)))
typedef unsigned short bf16_t;
typedef short bf16x8 __attribute__((ext_vector_type(8)));
typedef float f32x4 __attribute__((ext_vector_type(4)));
typedef float f32x2 __attribute__((ext_vector_type(2)));
typedef unsigned u32x4 __attribute__((ext_vector_type(4)));
typedef unsigned u32x2 __attribute__((ext_vector_type(2)));

constexpr int D = 2048, BATCH = 8, SEQ = 2048, T = BATCH * SEQ;
constexpr int HD = 128;
constexpr int GKH = 16, GVH = 32, GKDIM = 2048, GVDIM = 4096, GCONV = 8192, GIN = 12352, GIN_PAD = 12544;
constexpr int SBH = 16, SBDIM = 2048, KVQ = 6144;
constexpr int NGRP = 4, EPG = 8, NE = 32, HID = 768;
constexpr float EPS = 1e-6f;
constexpr int MAXSLOTS = T * 2 + NE * 256;

constexpr size_t MiB = 1u << 20;
constexpr size_t WS_CTL = 0, CTL_ZERO_BYTES = 1 * MiB;
constexpr size_t WS_MISC = 1 * MiB;
constexpr size_t WS_WIN = 2 * MiB, WS_WOUTA = 51 * MiB, WS_WKVQ = 67 * MiB, WS_WOUTB = 91 * MiB, WS_WGU = 99 * MiB, WS_WD = 483 * MiB;
constexpr size_t WS_XN = 675 * MiB, WS_OG = 739 * MiB, WS_BIG = 867 * MiB, WS_WR = 1259 * MiB, WS_END = 1260 * MiB;
constexpr int WRN = 48;
constexpr size_t WS_XS = WS_BIG, WS_HB = WS_BIG + 160 * MiB, WS_YS = WS_BIG + 220 * MiB;
constexpr size_t WS_KVQ = WS_BIG, WS_AO = WS_BIG + 192 * MiB;
static_assert((size_t)GIN_PAD * D * 2 <= 49 * MiB && (size_t)T * GIN_PAD * 2 <= 392 * MiB, "map");
static_assert((size_t)MAXSLOTS * D * 2 <= 160 * MiB && (size_t)MAXSLOTS * HID * 2 <= 60 * MiB, "map");
constexpr size_t MI_BLKCNT = 0, MI_PADSTART = 32768, MI_TOKE = 65536, MI_TOKW = 65536 + 131072, MI_TOKSLOT = 65536 + 262144;
constexpr int CW_BAR = 4096, CW_TICKET = 64;

constexpr int RING_BYTES = 131072;
constexpr int LDS_BYTES = 163840;
constexpr int LDSCTL_OFF = LDS_BYTES - 1024;

#define LDS_WAIT() asm volatile("s_waitcnt lgkmcnt(0)" ::: "memory")
#define VM_WAIT() asm volatile("s_waitcnt vmcnt(0)" ::: "memory")
__device__ __forceinline__ float bf2f(unsigned b) { return __uint_as_float(b << 16); }
__device__ __forceinline__ unsigned f2bf(float f) { unsigned u = __float_as_uint(f); return (u + 0x7fffu + ((u >> 16) & 1u)) >> 16; }
typedef __bf16 bf16v2_t __attribute__((ext_vector_type(2)));
__device__ __forceinline__ unsigned pk2(float lo, float hi) { bf16v2_t v = __builtin_convertvector((f32x2){lo, hi}, bf16v2_t); return __builtin_bit_cast(unsigned, v); }
__device__ __forceinline__ float wave_sum(float v) {
#pragma unroll
    for (int o = 1; o < 64; o <<= 1) v += __shfl_xor(v, o);
    return v;
}
__device__ __forceinline__ float silu_f(float x) { return x * __builtin_amdgcn_rcpf(1.0f + __builtin_amdgcn_exp2f(-1.4426950408889634f * x)); }
__device__ __forceinline__ float sigmoid_f(float x) { return __builtin_amdgcn_rcpf(1.0f + __builtin_amdgcn_exp2f(-1.4426950408889634f * x)); }
__device__ __forceinline__ float softplus_f(float x) { return fmaxf(x, 0.f) + __logf(1.0f + __expf(-fabsf(x))); }

#define XB_TMO      128
#define XB_XCNT(j)  (256  + 64 * (j))
#define XB_XSUB(j)  (1280 + 64 * (j))
#define XB_XGEN(j)  (2304 + 64 * (j))
#define XB_TOP      3328
#define XB_TOPGEN   3392
#define XCD_BAR_WORDS 3456
#define XB_SPIN_CAP (1u << 20)
__device__ __forceinline__ unsigned xb_ld(unsigned* p)              { return __hip_atomic_load(p, __ATOMIC_RELAXED, __HIP_MEMORY_SCOPE_AGENT); }
__device__ __forceinline__ unsigned xb_add(unsigned* p, unsigned v) { return __hip_atomic_fetch_add(p, v, __ATOMIC_RELAXED, __HIP_MEMORY_SCOPE_AGENT); }
__device__ __forceinline__ unsigned xb_xcc_id() { return (unsigned)__builtin_amdgcn_s_getreg((3 << 11) | 20) & 0xFu; }
#define XB_SPIN(cond, bar) do { unsigned _sp = 0; while (cond) { __builtin_amdgcn_s_sleep(1); \
    if ((++_sp & 255u) == 0u) { if (xb_ld(&(bar)[XB_TMO])) break; if (_sp > XB_SPIN_CAP) { atomicAdd(&(bar)[XB_TMO], 1u); break; } } } } while (0)
struct XcdBarrier { unsigned* bar; unsigned x; volatile LAS unsigned* st; };
__device__ __forceinline__ XcdBarrier xcd_barrier_post(unsigned* bar, volatile LAS unsigned* st) {
    XcdBarrier b; b.bar = bar; b.x = xb_xcc_id(); b.st = st;
    if (threadIdx.x == 0) (void)xb_add(&bar[XB_XCNT(b.x)], 1u);
    return b;
}
__device__ __forceinline__ void xcd_barrier_complete(unsigned* bar, unsigned x, unsigned& nloc, unsigned& nx) {
    const unsigned G = gridDim.x * gridDim.y * gridDim.z;
    unsigned sum, cnt, mine, sp = 0u;
    for (;;) {
        sum = 0u; cnt = 0u; mine = 0u;
#pragma unroll
        for (unsigned j = 0; j < 16; ++j) { const unsigned c = xb_ld(&bar[XB_XCNT(j)]); sum += c; cnt += (c > 0u) ? 1u : 0u; mine = (j == x) ? c : mine; }
        if (sum == G) break;
        __builtin_amdgcn_s_sleep(1);
        if ((++sp & 255u) == 0u) { if (xb_ld(&bar[XB_TMO])) break; if (sp > XB_SPIN_CAP) { atomicAdd(&bar[XB_TMO], 1u); break; } }
    }
    nloc = mine > 0u ? mine : 1u; nx = cnt > 0u ? cnt : 1u;
}
__device__ __forceinline__ void xcd_barrier(const XcdBarrier& b) {
    asm volatile("s_waitcnt vmcnt(0)" ::: "memory");
    __syncthreads();
    if (threadIdx.x == 0) {
        unsigned* bar = b.bar;
        __builtin_amdgcn_s_waitcnt(0);
        unsigned nloc = b.st[0], nx = b.st[1];
        if (nloc == 0u) { xcd_barrier_complete(bar, b.x, nloc, nx); b.st[0] = nloc; b.st[1] = nx; }
        const unsigned old = xb_add(&bar[XB_XSUB(b.x)], 1u);
        const unsigned gen = old / nloc;
        if (old + 1u == (gen + 1u) * nloc) {
            __builtin_amdgcn_fence(__ATOMIC_RELEASE, "agent");
            asm volatile("s_waitcnt vmcnt(0)" ::: "memory");
            const unsigned og = xb_add(&bar[XB_TOP], 1u);
            const unsigned tg = og / nx;
            if (og + 1u == (tg + 1u) * nx) xb_add(&bar[XB_TOPGEN], 1u);
            else XB_SPIN(xb_ld(&bar[XB_TOPGEN]) == tg, bar);
            __builtin_amdgcn_fence(__ATOMIC_ACQUIRE, "agent");
            xb_add(&bar[XB_XGEN(b.x)], 1u);
            asm volatile("s_waitcnt vmcnt(0)" ::: "memory");
        } else {
            XB_SPIN(xb_ld(&bar[XB_XGEN(b.x)]) == gen, bar);
            __builtin_amdgcn_fence(__ATOMIC_ACQUIRE, "agent");
            asm volatile("s_waitcnt vmcnt(0)" ::: "memory");
        }
    }
    __syncthreads();
}

namespace pg8 {
constexpr int BM = 256, BK = 64, HALF = 128, HTB = HALF * BK * 2, STAGE_BYTES = 8 * HTB, NXCD = 8, WGM = 8;
__host__ __device__ __forceinline__ int lds_byte(int r, int c) { const int st = (r >> 4) * 2 + (c >> 5), rr = r & 15, cc = c & 31, ob = rr * 64 + cc * 2; return st * 1024 + (ob ^ (((ob >> 9) & 1) << 5)); }
__host__ __device__ __forceinline__ void stage_rc(int b, int& R, int& C) { const int st = b / 1024, sb = b % 1024, swz = sb ^ (((sb >> 9) & 1) << 5); R = (st >> 1) * 16 + swz / 64; C = (st & 1) * 32 + (swz % 64) / 2; }
__host__ __device__ __forceinline__ int perm32(int rho) { const int n = rho >> 4, i = rho & 15; return 8 * (i >> 2) + 4 * n + (i & 3); }

struct Unit { int pm, pn, pb; };
struct Gemm { const bf16_t* A; const bf16_t* Bt; int K; };

struct StaticOrder {
    int nM, nN, nwg, G, c;
    __device__ void init(int M, int N, int G_, int c_) { nM = M / BM; nN = N / BM; nwg = nM * nN; G = G_; c = c_; }
    __device__ bool next(int i, Unit& u) const {
        const long L = (long)i * G + c; if (L >= nwg) return false;
        int wgid = (int)L; { const int q = nwg / NXCD, r = nwg % NXCD, xcd = wgid % NXCD, off = wgid / NXCD; wgid = (xcd < r ? xcd * (q + 1) : r * (q + 1) + (xcd - r) * q) + off; }
        const int nig = WGM * nN, gid = wgid / nig, fm = gid * WGM, gsz = (nM - fm) < WGM ? (nM - fm) : WGM;
        u.pm = fm + ((wgid % nig) % gsz); u.pn = (wgid % nig) / gsz; u.pb = u.pn; return true;
    }
};
struct ListOrder {
    int n, d0, d1, d2, d3, d4, d5, d6, d7;
    __device__ bool next(int i, Unit& u) const {
        if (i >= n) return false;
        const int d = i == 0 ? d0 : i == 1 ? d1 : i == 2 ? d2 : i == 3 ? d3 : i == 4 ? d4 : i == 5 ? d5 : i == 6 ? d6 : d7;
        u.pm = d & 0xfff; u.pn = (d >> 12) & 0xf; u.pb = d >> 16; return true;
    }
};

__device__ __forceinline__ unsigned cvt_pk_bf16(float lo, float hi) { return pk2(lo, hi); }

struct EpiBf16 {
    static constexpr bool PERM = true;
    bf16_t* O; int ldc;
    __device__ __forceinline__ void operator()(const f32x4 (&acc)[2][2][4][2], const Unit& u, int wr, int wc, int fr, int fq) const {
        const int row0 = u.pm * BM + wr * 64 + fr, col0 = u.pn * BM + wc * 32 + 8 * fq;
#pragma unroll
        for (int ai = 0; ai < 2; ++ai)
#pragma unroll
            for (int m = 0; m < 4; ++m) { bf16_t* rowp = O + (size_t)(row0 + ai * HALF + m * 16) * ldc + col0;
#pragma unroll
                for (int bj = 0; bj < 2; ++bj) { const f32x4 v0 = acc[ai][bj][m][0], v1 = acc[ai][bj][m][1];
                    u32x4 w; w.x = cvt_pk_bf16(v0[0], v0[1]); w.y = cvt_pk_bf16(v0[2], v0[3]); w.z = cvt_pk_bf16(v1[0], v1[1]); w.w = cvt_pk_bf16(v1[2], v1[3]);
                    *(u32x4*)(rowp + bj * HALF) = w; } }
    }
};
struct EpiKvqNorm {
    static constexpr bool PERM = true;
    bf16_t* O; const float* k_gain; const float* q_gain; LAS float* xch;
    __device__ __forceinline__ void operator()(const f32x4 (&acc)[2][2][4][2], const Unit& u, int wr, int wc, int fr, int fq) const {
        const int row0 = u.pm * BM + wr * 64 + fr, col0 = u.pn * BM + wc * 32 + 8 * fq;
        const bool isk = u.pn < 8, isq = u.pn >= 16;
        float rs[2][4][2];
        if (isk || isq) {
#pragma unroll
            for (int ai = 0; ai < 2; ++ai)
#pragma unroll
                for (int m = 0; m < 4; ++m)
#pragma unroll
                    for (int bj = 0; bj < 2; ++bj) { const f32x4 a = acc[ai][bj][m][0], b = acc[ai][bj][m][1];
                        float s = (a[0] * a[0] + a[1] * a[1]) + (a[2] * a[2] + a[3] * a[3]) + (b[0] * b[0] + b[1] * b[1]) + (b[2] * b[2] + b[3] * b[3]);
                        s += __shfl_xor(s, 16); s += __shfl_xor(s, 32);
                        if (fq == 0) xch[((ai * HALF + wr * 64 + m * 16 + fr) * 2 + bj) * 4 + wc] = s; }
            asm volatile("s_waitcnt lgkmcnt(0)" ::: "memory"); __builtin_amdgcn_s_barrier(); asm volatile("" ::: "memory");
            const float* g = isk ? k_gain : q_gain; const float qs = isq ? 0.12751743082459868f : 1.0f;
#pragma unroll
            for (int ai = 0; ai < 2; ++ai)
#pragma unroll
                for (int m = 0; m < 4; ++m)
#pragma unroll
                    for (int bj = 0; bj < 2; ++bj) { const f32x4 p = *(const LAS f32x4*)(xch + ((ai * HALF + wr * 64 + m * 16 + fr) * 2 + bj) * 4);
                        rs[ai][m][bj] = qs / sqrtf(((p[0] + p[1]) + (p[2] + p[3])) * (1.f / HD) + EPS); }
        }
        f32x4 g0 = {1.f, 1.f, 1.f, 1.f}, g1 = g0;
        if (isk || isq) { const float* g = isk ? k_gain : q_gain; g0 = *(const f32x4*)(g + wc * 32 + 8 * fq); g1 = *(const f32x4*)(g + wc * 32 + 8 * fq + 4); }
#pragma unroll
        for (int ai = 0; ai < 2; ++ai)
#pragma unroll
            for (int m = 0; m < 4; ++m) { bf16_t* rowp = O + (size_t)(row0 + ai * HALF + m * 16) * KVQ + col0;
#pragma unroll
                for (int bj = 0; bj < 2; ++bj) { f32x4 v0 = acc[ai][bj][m][0], v1 = acc[ai][bj][m][1];
                    if (isk || isq) { const float r = rs[ai][m][bj]; v0 = v0 * r * g0; v1 = v1 * r * g1; }
                    u32x4 w; w.x = cvt_pk_bf16(v0[0], v0[1]); w.y = cvt_pk_bf16(v0[2], v0[3]); w.z = cvt_pk_bf16(v1[0], v1[1]); w.w = cvt_pk_bf16(v1[2], v1[3]);
                    *(u32x4*)(rowp + bj * HALF) = w; } }
    }
};
struct EpiResF32 {
    static constexpr bool PERM = false;
    const float* base; float* out; int ldc;
    __device__ __forceinline__ void operator()(const f32x4 (&acc)[2][2][4][2], const Unit& u, int wr, int wc, int fr, int fq) const {
        const int row0 = u.pm * BM + wr * 64 + fr, col0 = u.pn * BM + wc * 32 + 4 * fq;
        const float* __restrict__ bp = base; float* __restrict__ op = out;
#pragma unroll
        for (int ai = 0; ai < 2; ++ai)
#pragma unroll
            for (int mp = 0; mp < 2; ++mp) {
                f32x4 b[2][2][2];
#pragma unroll
                for (int mm = 0; mm < 2; ++mm) { const size_t ro = (size_t)(row0 + ai * HALF + (2 * mp + mm) * 16) * ldc + col0;
#pragma unroll
                    for (int bj = 0; bj < 2; ++bj)
#pragma unroll
                        for (int n = 0; n < 2; ++n) b[mm][bj][n] = *(const f32x4*)(bp + ro + bj * HALF + n * 16); }
#pragma unroll
                for (int mm = 0; mm < 2; ++mm) { const size_t ro = (size_t)(row0 + ai * HALF + (2 * mp + mm) * 16) * ldc + col0;
#pragma unroll
                    for (int bj = 0; bj < 2; ++bj)
#pragma unroll
                        for (int n = 0; n < 2; ++n) *(f32x4*)(op + ro + bj * HALF + n * 16) = acc[ai][bj][2 * mp + mm][n] + b[mm][bj][n]; }
            }
    }
};
struct EpiSwiGLU {
    static constexpr bool PERM = true;
    bf16_t* O; int ldc;
    __device__ __forceinline__ void operator()(const f32x4 (&acc)[2][2][4][2], const Unit& u, int wr, int wc, int fr, int fq) const {
        const int row0 = u.pm * BM + wr * 64 + fr, col0 = u.pn * HALF + wc * 32 + 8 * fq;
#pragma unroll
        for (int ai = 0; ai < 2; ++ai)
#pragma unroll
            for (int m = 0; m < 4; ++m) { bf16_t* rowp = O + (size_t)(row0 + ai * HALF + m * 16) * ldc + col0;
                float h[8];
#pragma unroll
                for (int n = 0; n < 2; ++n)
#pragma unroll
                    for (int j = 0; j < 4; ++j) { const float g = acc[ai][0][m][n][j], up = acc[ai][1][m][n][j]; h[n * 4 + j] = g * __builtin_amdgcn_rcpf(1.0f + __expf(-g)) * up; }
                u32x4 w; w.x = cvt_pk_bf16(h[0], h[1]); w.y = cvt_pk_bf16(h[2], h[3]); w.z = cvt_pk_bf16(h[4], h[5]); w.w = cvt_pk_bf16(h[6], h[7]);
                *(u32x4*)rowp = w; }
    }
};

template <class Epi, class Sched>
__device__ __forceinline__ void gemm_phase(LAS unsigned char* lds, const Gemm g, const Sched& S, const Epi& E) {
    const int tid = threadIdx.x, wid = __builtin_amdgcn_readfirstlane(tid >> 6), lane = tid & 63, wr = wid >> 2, wc = wid & 3, fr = lane & 15, fq = lane >> 4;
    const int K = g.K, nt = K / BK;
    unsigned voffA[2], voffB[2];
#pragma unroll
    for (int i = 0; i < 2; ++i) { int R, C; stage_rc(tid * 16 + i * 8192, R, C); const int Rb = Epi::PERM ? ((R & ~31) + perm32(R & 31)) : R;
        voffA[i] = (unsigned)(R * K + C) * 2u; voffB[i] = (unsigned)(Rb * K + C) * 2u; }
    const size_t kstep = (size_t)(BK * 2);
    const size_t hstep = (size_t)HALF * K * 2;
    const size_t tstep = 2 * hstep;
    const unsigned ldsw = (unsigned)wid * 1024u;
    const int aoff = lds_byte(wr * 64 + fr, fq * 8), boff = lds_byte(wc * 32 + fr, fq * 8);
#define PG8_SA(b, h) (((b) * 2 + (h)) * HTB)
#define PG8_SB(b, h) ((4 + (b) * 2 + (h)) * HTB)
#define PG8_STAGE(bufoff, gbase, voff) do { _Pragma("unroll") for (int _i = 0; _i < 2; ++_i) \
        __builtin_amdgcn_global_load_lds((const unsigned*)((const char*)(gbase) + (voff)[_i]), (LAS unsigned*)(lds + (bufoff) + ldsw + _i * 8192), 16, 0, 0); } while (0)
#define PG8_LDA(dst, b, h) do { _Pragma("unroll") for (int m = 0; m < 4; ++m) _Pragma("unroll") for (int k = 0; k < 2; ++k) dst[m][k] = *(const LAS bf16x8*)(lds + PG8_SA(b, h) + aoff + m * 2048 + k * 1024); } while (0)
#define PG8_LDB(dst, b, h) do { _Pragma("unroll") for (int n = 0; n < 2; ++n) _Pragma("unroll") for (int k = 0; k < 2; ++k) dst[n][k] = *(const LAS bf16x8*)(lds + PG8_SB(b, h) + boff + n * 2048 + k * 1024); } while (0)
#define PG8_MMA(ai, bj, At, Bt) do { __builtin_amdgcn_s_setprio(1); _Pragma("unroll") for (int m = 0; m < 4; ++m) _Pragma("unroll") for (int n = 0; n < 2; ++n) _Pragma("unroll") for (int k = 0; k < 2; ++k) \
        acc[ai][bj][m][n] = __builtin_amdgcn_mfma_f32_16x16x32_bf16(Bt[n][k], At[m][k], acc[ai][bj][m][n], 0, 0, 0); __builtin_amdgcn_s_setprio(0); } while (0)
#define PG8_WAIT_V(n) asm volatile("s_waitcnt vmcnt(" #n ")" ::: "memory")
#define PG8_WAIT_L(n) asm volatile("s_waitcnt lgkmcnt(" #n ")" ::: "memory")
#define PG8_BAR __builtin_amdgcn_s_barrier()
#define PG8_SCHED __builtin_amdgcn_sched_barrier(0)
    Unit cur, nxt; int ui = 0;
    if (!S.next(0, cur)) return;
    f32x4 acc[2][2][4][2];
#pragma unroll
    for (int a = 0; a < 2; ++a)
#pragma unroll
        for (int b = 0; b < 2; ++b)
#pragma unroll
            for (int m = 0; m < 4; ++m)
#pragma unroll
                for (int n = 0; n < 2; ++n) acc[a][b][m][n] = (f32x4){0.f, 0.f, 0.f, 0.f};
    bf16x8 At[4][2], B0[2][2], B1[2][2];
    const char* cA = (const char*)g.A + (size_t)cur.pm * tstep; const char* cB = (const char*)g.Bt + (size_t)cur.pb * tstep;
    PG8_STAGE(PG8_SB(0, 0), cB, voffB); PG8_STAGE(PG8_SA(0, 0), cA, voffA); PG8_STAGE(PG8_SB(0, 1), cB + hstep, voffB); PG8_STAGE(PG8_SA(0, 1), cA + hstep, voffA);
    if (wr == 1) PG8_BAR;
    PG8_WAIT_V(4); PG8_BAR;
    PG8_STAGE(PG8_SB(1, 0), cB + kstep, voffB); PG8_STAGE(PG8_SA(1, 0), cA + kstep, voffA); PG8_STAGE(PG8_SB(1, 1), cB + hstep + kstep, voffB);
    PG8_WAIT_V(6); PG8_BAR;
    for (;;) {
        const bool has_next = S.next(ui + 1, nxt);
        const char* nA = has_next ? (const char*)g.A + (size_t)nxt.pm * tstep : cA; const char* nB = has_next ? (const char*)g.Bt + (size_t)nxt.pb * tstep : cB;
        for (int t = 0; t < nt; t += 2) {
            const bool last = (t == nt - 2);
            const char* a1 = cA + (size_t)(t + 1) * kstep;
            const char* a2 = last ? nA : cA + (size_t)(t + 2) * kstep; const char* b2 = last ? nB : cB + (size_t)(t + 2) * kstep;
            const char* a3 = a2 + kstep; const char* b3 = b2 + kstep;
            PG8_LDB(B0, 0, 0); PG8_SCHED; PG8_LDA(At, 0, 0); PG8_STAGE(PG8_SA(1, 1), a1 + hstep, voffA);
            PG8_WAIT_L(8); PG8_BAR; PG8_WAIT_L(0); PG8_MMA(0, 0, At, B0); PG8_BAR; PG8_SCHED;
            PG8_LDB(B1, 0, 1); PG8_STAGE(PG8_SB(0, 0), b2, voffB);
            PG8_BAR; PG8_WAIT_L(0); PG8_MMA(0, 1, At, B1); PG8_BAR;
            PG8_LDA(At, 0, 1); PG8_STAGE(PG8_SA(0, 0), a2, voffA);
            PG8_BAR; PG8_WAIT_L(0); PG8_MMA(1, 0, At, B0); PG8_BAR; PG8_SCHED;
            PG8_STAGE(PG8_SB(0, 1), b2 + hstep, voffB);
            PG8_WAIT_V(6); PG8_BAR; PG8_MMA(1, 1, At, B1); PG8_BAR;
            PG8_LDB(B0, 1, 0); PG8_SCHED; PG8_LDA(At, 1, 0); PG8_STAGE(PG8_SA(0, 1), a2 + hstep, voffA);
            PG8_WAIT_L(8); PG8_BAR; PG8_WAIT_L(0); PG8_MMA(0, 0, At, B0); PG8_BAR; PG8_SCHED;
            PG8_LDB(B1, 1, 1); PG8_STAGE(PG8_SB(1, 0), b3, voffB);
            PG8_BAR; PG8_WAIT_L(0); PG8_MMA(0, 1, At, B1); PG8_BAR;
            PG8_LDA(At, 1, 1); PG8_STAGE(PG8_SA(1, 0), a3, voffA);
            PG8_BAR; PG8_WAIT_L(0); PG8_MMA(1, 0, At, B0); PG8_BAR; PG8_SCHED;
            PG8_STAGE(PG8_SB(1, 1), b3 + hstep, voffB);
            PG8_WAIT_V(6); PG8_BAR; PG8_MMA(1, 1, At, B1); PG8_BAR;
        }
        E(acc, cur, wr, wc, fr, fq);
        if (!has_next) break;
#pragma unroll
        for (int a = 0; a < 2; ++a)
#pragma unroll
            for (int b = 0; b < 2; ++b)
#pragma unroll
                for (int m = 0; m < 4; ++m)
#pragma unroll
                    for (int n = 0; n < 2; ++n) acc[a][b][m][n] = (f32x4){0.f, 0.f, 0.f, 0.f};
        cur = nxt; cA = nA; cB = nB; ++ui;
    }
    PG8_WAIT_V(0);
    if (wr == 0) PG8_BAR;
    PG8_BAR;
#undef PG8_SA
#undef PG8_SB
#undef PG8_STAGE
#undef PG8_LDA
#undef PG8_LDB
#undef PG8_MMA
#undef PG8_WAIT_V
#undef PG8_WAIT_L
#undef PG8_BAR
#undef PG8_SCHED
}
template <class Epi, class Sched>
__device__ __forceinline__ void gemm_phase_gather(LAS unsigned char* lds, const Gemm g, const Sched& S, const Epi& E, const LAS int* rowtok) {
    const int tid = threadIdx.x, wid = __builtin_amdgcn_readfirstlane(tid >> 6), lane = tid & 63, wr = wid >> 2, wc = wid & 3, fr = lane & 15, fq = lane >> 4;
    const int K = g.K, nt = K / BK;
    unsigned voffB[2]; unsigned cofA[2]; int rofA[2];
#pragma unroll
    for (int i = 0; i < 2; ++i) { int R, C; stage_rc(tid * 16 + i * 8192, R, C); const int Rb = Epi::PERM ? ((R & ~31) + perm32(R & 31)) : R;
        cofA[i] = (unsigned)C * 2u; rofA[i] = R; voffB[i] = (unsigned)(Rb * K + C) * 2u; }
    unsigned ga[2][2], gn[2][2];
#define PG8_ROWS(dst, u_) do { _Pragma("unroll") for (int h_ = 0; h_ < 2; ++h_) _Pragma("unroll") for (int i_ = 0; i_ < 2; ++i_) \
        dst[h_][i_] = (unsigned)rowtok[(u_) * 256 + h_ * HALF + rofA[i_]] * (unsigned)(K * 2) + cofA[i_]; } while (0)
    const size_t kstep = (size_t)(BK * 2);
    const size_t hstep = (size_t)HALF * K * 2;
    const size_t tstep = 2 * hstep;
    const unsigned ldsw = (unsigned)wid * 1024u;
    const int aoff = lds_byte(wr * 64 + fr, fq * 8), boff = lds_byte(wc * 32 + fr, fq * 8);
#define PG8_SA(b, h) (((b) * 2 + (h)) * HTB)
#define PG8_SB(b, h) ((4 + (b) * 2 + (h)) * HTB)
#define PG8_STAGE(bufoff, gbase, voff) do { _Pragma("unroll") for (int _i = 0; _i < 2; ++_i) \
        __builtin_amdgcn_global_load_lds((const unsigned*)((const char*)(gbase) + (voff)[_i]), (LAS unsigned*)(lds + (bufoff) + ldsw + _i * 8192), 16, 0, 0); } while (0)
#define PG8_LDA(dst, b, h) do { _Pragma("unroll") for (int m = 0; m < 4; ++m) _Pragma("unroll") for (int k = 0; k < 2; ++k) dst[m][k] = *(const LAS bf16x8*)(lds + PG8_SA(b, h) + aoff + m * 2048 + k * 1024); } while (0)
#define PG8_LDB(dst, b, h) do { _Pragma("unroll") for (int n = 0; n < 2; ++n) _Pragma("unroll") for (int k = 0; k < 2; ++k) dst[n][k] = *(const LAS bf16x8*)(lds + PG8_SB(b, h) + boff + n * 2048 + k * 1024); } while (0)
#define PG8_MMA(ai, bj, At, Bt) do { __builtin_amdgcn_s_setprio(1); _Pragma("unroll") for (int m = 0; m < 4; ++m) _Pragma("unroll") for (int n = 0; n < 2; ++n) _Pragma("unroll") for (int k = 0; k < 2; ++k) \
        acc[ai][bj][m][n] = __builtin_amdgcn_mfma_f32_16x16x32_bf16(Bt[n][k], At[m][k], acc[ai][bj][m][n], 0, 0, 0); __builtin_amdgcn_s_setprio(0); } while (0)
#define PG8_WAIT_V(n) asm volatile("s_waitcnt vmcnt(" #n ")" ::: "memory")
#define PG8_WAIT_L(n) asm volatile("s_waitcnt lgkmcnt(" #n ")" ::: "memory")
#define PG8_BAR __builtin_amdgcn_s_barrier()
#define PG8_SCHED __builtin_amdgcn_sched_barrier(0)
    Unit cur, nxt; int ui = 0;
    if (!S.next(0, cur)) return;
    f32x4 acc[2][2][4][2];
#pragma unroll
    for (int a = 0; a < 2; ++a)
#pragma unroll
        for (int b = 0; b < 2; ++b)
#pragma unroll
            for (int m = 0; m < 4; ++m)
#pragma unroll
                for (int n = 0; n < 2; ++n) acc[a][b][m][n] = (f32x4){0.f, 0.f, 0.f, 0.f};
    bf16x8 At[4][2], B0[2][2], B1[2][2];
    const char* cA = (const char*)g.A; const char* cB = (const char*)g.Bt + (size_t)cur.pb * tstep;
    PG8_ROWS(ga, 0);
    PG8_STAGE(PG8_SB(0, 0), cB, voffB); PG8_STAGE(PG8_SA(0, 0), cA, ga[0]); PG8_STAGE(PG8_SB(0, 1), cB + hstep, voffB); PG8_STAGE(PG8_SA(0, 1), cA, ga[1]);
    if (wr == 1) PG8_BAR;
    PG8_WAIT_V(4); PG8_BAR;
    PG8_STAGE(PG8_SB(1, 0), cB + kstep, voffB); PG8_STAGE(PG8_SA(1, 0), cA + kstep, ga[0]); PG8_STAGE(PG8_SB(1, 1), cB + hstep + kstep, voffB);
    PG8_WAIT_V(6); PG8_BAR;
    for (;;) {
        const bool has_next = S.next(ui + 1, nxt);
        const char* nB = has_next ? (const char*)g.Bt + (size_t)nxt.pb * tstep : cB;
        if (has_next) PG8_ROWS(gn, ui + 1); else { gn[0][0] = ga[0][0]; gn[0][1] = ga[0][1]; gn[1][0] = ga[1][0]; gn[1][1] = ga[1][1]; }
        for (int t = 0; t < nt; t += 2) {
            const bool last = (t == nt - 2);
            const char* a1 = cA + (size_t)(t + 1) * kstep;
            const char* a2 = last ? cA : cA + (size_t)(t + 2) * kstep; const char* b2 = last ? nB : cB + (size_t)(t + 2) * kstep;
            unsigned o2[2][2];
            _Pragma("unroll") for (int h_ = 0; h_ < 2; ++h_) _Pragma("unroll") for (int i_ = 0; i_ < 2; ++i_) o2[h_][i_] = last ? gn[h_][i_] : ga[h_][i_];
            const char* a3 = a2 + kstep; const char* b3 = b2 + kstep;
            PG8_LDB(B0, 0, 0); PG8_SCHED; PG8_LDA(At, 0, 0); PG8_STAGE(PG8_SA(1, 1), a1, ga[1]);
            PG8_WAIT_L(8); PG8_BAR; PG8_WAIT_L(0); PG8_MMA(0, 0, At, B0); PG8_BAR; PG8_SCHED;
            PG8_LDB(B1, 0, 1); PG8_STAGE(PG8_SB(0, 0), b2, voffB);
            PG8_BAR; PG8_WAIT_L(0); PG8_MMA(0, 1, At, B1); PG8_BAR;
            PG8_LDA(At, 0, 1); PG8_STAGE(PG8_SA(0, 0), a2, o2[0]);
            PG8_BAR; PG8_WAIT_L(0); PG8_MMA(1, 0, At, B0); PG8_BAR; PG8_SCHED;
            PG8_STAGE(PG8_SB(0, 1), b2 + hstep, voffB);
            PG8_WAIT_V(6); PG8_BAR; PG8_MMA(1, 1, At, B1); PG8_BAR;
            PG8_LDB(B0, 1, 0); PG8_SCHED; PG8_LDA(At, 1, 0); PG8_STAGE(PG8_SA(0, 1), a2, o2[1]);
            PG8_WAIT_L(8); PG8_BAR; PG8_WAIT_L(0); PG8_MMA(0, 0, At, B0); PG8_BAR; PG8_SCHED;
            PG8_LDB(B1, 1, 1); PG8_STAGE(PG8_SB(1, 0), b3, voffB);
            PG8_BAR; PG8_WAIT_L(0); PG8_MMA(0, 1, At, B1); PG8_BAR;
            PG8_LDA(At, 1, 1); PG8_STAGE(PG8_SA(1, 0), a3, o2[0]);
            PG8_BAR; PG8_WAIT_L(0); PG8_MMA(1, 0, At, B0); PG8_BAR; PG8_SCHED;
            PG8_STAGE(PG8_SB(1, 1), b3 + hstep, voffB);
            PG8_WAIT_V(6); PG8_BAR; PG8_MMA(1, 1, At, B1); PG8_BAR;
        }
        E(acc, cur, wr, wc, fr, fq);
        if (!has_next) break;
#pragma unroll
        for (int a = 0; a < 2; ++a)
#pragma unroll
            for (int b = 0; b < 2; ++b)
#pragma unroll
                for (int m = 0; m < 4; ++m)
#pragma unroll
                    for (int n = 0; n < 2; ++n) acc[a][b][m][n] = (f32x4){0.f, 0.f, 0.f, 0.f};
        cur = nxt; cB = nB; ++ui; ga[0][0] = gn[0][0]; ga[0][1] = gn[0][1]; ga[1][0] = gn[1][0]; ga[1][1] = gn[1][1];
    }
    PG8_WAIT_V(0);
    if (wr == 0) PG8_BAR;
    PG8_BAR;
#undef PG8_SA
#undef PG8_SB
#undef PG8_STAGE
#undef PG8_ROWS
#undef PG8_LDA
#undef PG8_LDB
#undef PG8_MMA
#undef PG8_WAIT_V
#undef PG8_WAIT_L
#undef PG8_BAR
#undef PG8_SCHED
}
}

struct Ctx {
    LAS unsigned char* lds;
    int tid, lane, wave, G, bid;
};

struct TrItem { const float* W; int N, k0, n0; bf16_t* WT; int ldk, drow0; const float* gain; };
template <bool NT>
__device__ __forceinline__ void tr_load(const TrItem& d, f32x4 (&v)[8], int lane) {
#pragma unroll
    for (int i = 0; i < 8; ++i) { const int kk = 8 * i + (lane >> 3); const f32x4* p = (const f32x4*)&d.W[(size_t)(d.k0 + kk) * d.N + d.n0 + 4 * (lane & 7)]; v[i] = NT ? __builtin_nontemporal_load(p) : *p; }
}
template <bool NT>
__device__ __forceinline__ void tr_finish(const TrItem& d, f32x4 (&v)[8], LAS float* scr, int lane) {
    if (d.gain) {
#pragma unroll
        for (int i = 0; i < 8; ++i) v[i] *= d.gain[d.k0 + 8 * i + (lane >> 3)];
    }
#pragma unroll
    for (int i = 0; i < 8; ++i) { LAS float* s = scr + (8 * i + (lane >> 3)) * 33 + 4 * (lane & 7); s[0] = v[i].x; s[1] = v[i].y; s[2] = v[i].z; s[3] = v[i].w; }
    LDS_WAIT(); asm volatile("" ::: "memory");
    const int c = lane & 7;
#pragma unroll
    for (int j = 0; j < 4; ++j) { const int n = (lane >> 3) + 8 * j; const LAS float* s = scr + (8 * c) * 33 + n;
        u32x4 o; o.x = pk2(s[0 * 33], s[1 * 33]); o.y = pk2(s[2 * 33], s[3 * 33]); o.z = pk2(s[4 * 33], s[5 * 33]); o.w = pk2(s[6 * 33], s[7 * 33]);
        u32x4* dp = (u32x4*)(d.WT + (size_t)(d.drow0 + n) * d.ldk + d.k0 + 8 * c); if (NT) __builtin_nontemporal_store(o, dp); else *dp = o; }
    LDS_WAIT(); asm volatile("" ::: "memory");
}
__device__ __forceinline__ void rms_row_to_bf16(const float* xrow, const f32x4 (&gv)[8], bf16_t* orow, int lane) {
    const f32x4* xr = (const f32x4*)xrow + 2 * lane;
    f32x4 v[8]; float s = 0.f;
#pragma unroll
    for (int j = 0; j < 8; ++j) { v[j] = xr[128 * (j >> 1) + (j & 1)]; s += (v[j].x * v[j].x + v[j].y * v[j].y) + (v[j].z * v[j].z + v[j].w * v[j].w); }
    const float r = 1.0f / sqrtf(wave_sum(s) * (1.f / D) + EPS);
    u32x4* o16 = (u32x4*)orow + lane;
#pragma unroll
    for (int j = 0; j < 4; ++j) {
        const f32x4 a = v[2 * j] * r * gv[2 * j], b = v[2 * j + 1] * r * gv[2 * j + 1];
        o16[64 * j] = (u32x4){pk2(a.x, a.y), pk2(a.z, a.w), pk2(b.x, b.y), pk2(b.z, b.w)}; }
}

struct P0Args { const float *x, *norm_a, *w_in, *w_out_a, *norm_kv, *w_kv, *norm_b, *w_q, *w_out_b, *w_gate, *w_up, *w_down, *w_rg, *w_re; float* WR;
                bf16_t *Win_t, *Wouta_t, *Wkvq_t, *Woutb_t, *Wgu_t, *Wd_t, *XN; };
constexpr int I_IN = 32 * (GIN / 32), I_OA = 64 * 64, I_KV = 32 * 128, I_Q = 32 * 64, I_OB = 32 * 64, I_G1 = 32 * 24, I_D1 = 12 * 64;
constexpr int I_G = 64 * I_G1, I_DN = 64 * I_D1;
constexpr int NITEMS = I_IN + I_OA + I_KV + I_Q + I_OB + 2 * I_G + I_DN;
__device__ __forceinline__ TrItem p0_desc(const P0Args& a, int it) {
    int r = it;
    if (r < I_IN) { const int nnb = GIN / 32, kb = r / nnb, nb = r % nnb; return TrItem{a.w_in, GIN, 64 * kb, 32 * nb, a.Win_t, D, 32 * nb, nullptr}; } r -= I_IN;
    if (r < I_OA) { const int kb = r / 64, nb = r % 64; return TrItem{a.w_out_a, D, 64 * kb, 32 * nb, a.Wouta_t, GVDIM, 32 * nb, nullptr}; } r -= I_OA;
    if (r < I_KV) { const int kb = r / 128, nb = r % 128; return TrItem{a.w_kv, 2 * SBDIM, 64 * kb, 32 * nb, a.Wkvq_t, D, 32 * nb, a.norm_kv}; } r -= I_KV;
    if (r < I_Q) { const int kb = r / 64, nb = r % 64; return TrItem{a.w_q, SBDIM, 64 * kb, 32 * nb, a.Wkvq_t, D, 2 * SBDIM + 32 * nb, a.norm_b}; } r -= I_Q;
    if (r < I_OB) { const int kb = r / 64, nb = r % 64; return TrItem{a.w_out_b, D, 64 * kb, 32 * nb, a.Woutb_t, SBDIM, 32 * nb, nullptr}; } r -= I_OB;
    if (r < I_G) { const int mi = r / I_G1, q = r % I_G1, kb = q / 24, nb = q % 24, n0 = 32 * nb;
        return TrItem{a.w_gate + (size_t)mi * D * HID, HID, 64 * kb, n0, a.Wgu_t + (size_t)mi * 2 * HID * D, D, 256 * (n0 / 128) + (n0 % 128), nullptr}; } r -= I_G;
    if (r < I_G) { const int mi = r / I_G1, q = r % I_G1, kb = q / 24, nb = q % 24, n0 = 32 * nb;
        return TrItem{a.w_up + (size_t)mi * D * HID, HID, 64 * kb, n0, a.Wgu_t + (size_t)mi * 2 * HID * D, D, 256 * (n0 / 128) + 128 + (n0 % 128), nullptr}; } r -= I_G;
    { const int mi = r / I_D1, q = r % I_D1, kb = q / 64, nb = q % 64;
        return TrItem{a.w_down + (size_t)mi * HID * D, D, 64 * kb, 32 * nb, a.Wd_t + (size_t)mi * D * HID, HID, 32 * nb, nullptr}; }
}
__device__ __forceinline__ void p0_prologue(const Ctx& F, const P0Args& a) {
    LAS float* scr = (LAS float*)(F.lds + F.wave * 16384);
    const int gw = F.bid * 8 + F.wave, NGW = F.G * 8;
    for (int it = gw; it < I_IN; it += NGW) { const TrItem d = p0_desc(a, it); f32x4 v[8]; tr_load<false>(d, v, F.lane); tr_finish<false>(d, v, scr, F.lane); }
    f32x4 gv[8];
#pragma unroll
    for (int j = 0; j < 8; ++j) gv[j] = ((const f32x4*)a.norm_a)[128 * (j >> 1) + 2 * F.lane + (j & 1)];
    for (int m = gw; m < T; m += NGW) rms_row_to_bf16(a.x + (size_t)m * D, gv, a.XN + (size_t)m * D, F.lane);
    for (int i = F.bid * 512 + F.tid; i < 2 * D * WRN; i += F.G * 512) { const int l = i / (D * WRN), q = i % (D * WRN), k = 4 * (q / (4 * WRN)) + (q & 3), n = (q / 4) % WRN;
        a.WR[i] = n < NGRP ? a.w_rg[(size_t)(l * D + k) * NGRP + n] : n < NGRP + NE ? a.w_re[(size_t)(l * D + k) * NE + (n - NGRP)] : 0.f; }
}
constexpr int P0_TK = 32;
__device__ __forceinline__ void p0_queue(const Ctx& F, const P0Args& a, unsigned* ticket) {
    LAS float* scr = (LAS float*)(F.lds + F.wave * 16384);
    constexpr int NREST = NITEMS - I_IN;
    for (;;) {
        unsigned t = 0;
        if (F.lane == 0) t = __hip_atomic_fetch_add(ticket, 1u, __ATOMIC_RELAXED, __HIP_MEMORY_SCOPE_AGENT);
        t = __builtin_amdgcn_readfirstlane(t);
        if ((long)t * P0_TK >= NREST) break;
        const int i0 = (int)t * P0_TK, i1 = i0 + P0_TK < NREST ? i0 + P0_TK : NREST;
        f32x4 va[8], vb[8];
        tr_load<true>(p0_desc(a, I_IN + i0), va, F.lane);
        for (int it = i0; it < i1; it += 2) {
            if (it + 1 < i1) tr_load<true>(p0_desc(a, I_IN + it + 1), vb, F.lane);
            { const TrItem d = p0_desc(a, I_IN + it); tr_finish<true>(d, va, scr, F.lane); }
            if (it + 2 < i1) tr_load<true>(p0_desc(a, I_IN + it + 2), va, F.lane);
            if (it + 1 < i1) { const TrItem d = p0_desc(a, I_IN + it + 1); tr_finish<true>(d, vb, scr, F.lane); }
        }
    }
}

constexpr int GCH = 32;
__device__ __forceinline__ void p2_gdn_ref(const Ctx& F, const bf16_t* proj, const float* conv_w, const float* a_log, const float* dt_bias, const float* out_gain, bf16_t* og) {
    LAS float* qs = (LAS float*)F.lds;
    LAS float* ks = qs + GCH * HD;
    LAS float* vs = ks + GCH * HD;
    LAS float* ob = vs + GCH * HD;
    LAS float* bet = ob + GCH * HD;
    LAS float* egs = bet + GCH;
    const int cl = F.lane & 15, qd = F.lane >> 4, c = F.wave * 16 + cl;
    for (int unit = F.bid; unit < BATCH * GVH; unit += F.G) {
        const int b = unit / GVH, hv = unit % GVH, hk = hv / 2;
        const float A = __expf(a_log[hv]), dtb = dt_bias[hv];
        float S[32];
#pragma unroll
        for (int i = 0; i < 32; ++i) S[i] = 0.f;
        for (int ch = 0; ch < SEQ / GCH; ++ch) {
            const int t0 = ch * GCH;
            for (int idx = F.tid; idx < 3 * GCH * HD; idx += 512) {
                const int which = idx / (GCH * HD), tl = (idx / HD) % GCH, cc = idx % HD;
                const int col = which == 0 ? hk * HD + cc : which == 1 ? GKDIM + hk * HD + cc : 2 * GKDIM + hv * HD + cc;
                float acc = 0.f;
#pragma unroll
                for (int j = 0; j < 4; ++j) { const int tt = t0 + tl - 3 + j; if (tt >= 0) acc += conv_w[j * GCONV + col] * bf2f(proj[(size_t)(b * SEQ + tt) * GIN_PAD + col]); }
                qs[which * GCH * HD + tl * HD + cc] = silu_f(acc);
            }
            if (F.tid < GCH) { const size_t row = (size_t)(b * SEQ + t0 + F.tid) * GIN_PAD;
                bet[F.tid] = sigmoid_f(bf2f(proj[row + GCONV + GVDIM + hv]));
                const float av = bf2f(proj[row + GCONV + GVDIM + GVH + hv]);
                egs[F.tid] = __expf(-A * softplus_f(av + dtb)); }
            __syncthreads();
            for (int tl = F.wave; tl < GCH; tl += 8) {
                const float q0 = qs[tl * HD + 2 * F.lane], q1 = qs[tl * HD + 2 * F.lane + 1], k0 = ks[tl * HD + 2 * F.lane], k1 = ks[tl * HD + 2 * F.lane + 1];
                const float rq = 1.0f / sqrtf(wave_sum(q0 * q0 + q1 * q1) + EPS) * 0.08838834764831845f, rk = 1.0f / sqrtf(wave_sum(k0 * k0 + k1 * k1) + EPS);
                qs[tl * HD + 2 * F.lane] = q0 * rq; qs[tl * HD + 2 * F.lane + 1] = q1 * rq; ks[tl * HD + 2 * F.lane] = k0 * rk; ks[tl * HD + 2 * F.lane + 1] = k1 * rk;
            }
            __syncthreads();
            for (int tl = 0; tl < GCH; ++tl) {
                const float e = egs[tl], bt = bet[tl];
                float dk = 0.f, dq = 0.f, kq = 0.f;
                const LAS f32x4* kp = (const LAS f32x4*)(ks + tl * HD + 32 * qd); const LAS f32x4* qp = (const LAS f32x4*)(qs + tl * HD + 32 * qd);
                f32x4 kv[8];
#pragma unroll
                for (int i = 0; i < 8; ++i) { kv[i] = kp[i]; const f32x4 qv = qp[i];
#pragma unroll
                    for (int j = 0; j < 4; ++j) { S[4 * i + j] *= e; dk += kv[i][j] * S[4 * i + j]; dq += qv[j] * S[4 * i + j]; kq += kv[i][j] * qv[j]; } }
                dk += __shfl_xor(dk, 16); dk += __shfl_xor(dk, 32);
                dq += __shfl_xor(dq, 16); dq += __shfl_xor(dq, 32);
                kq += __shfl_xor(kq, 16); kq += __shfl_xor(kq, 32);
                const float vn = bt * (vs[tl * HD + c] - dk);
#pragma unroll
                for (int i = 0; i < 8; ++i)
#pragma unroll
                    for (int j = 0; j < 4; ++j) S[4 * i + j] += kv[i][j] * vn;
                if (qd == 0) ob[tl * HD + c] = dq + kq * vn;
            }
            __syncthreads();
            for (int tl = F.wave; tl < GCH; tl += 8) {
                const float o0 = ob[tl * HD + 2 * F.lane], o1 = ob[tl * HD + 2 * F.lane + 1];
                const float r = 1.0f / sqrtf(wave_sum(o0 * o0 + o1 * o1) * (1.f / HD) + EPS);
                const size_t row = (size_t)(b * SEQ + t0 + tl);
                const unsigned zz = *(const unsigned*)(proj + row * GIN_PAD + GCONV + hv * HD + 2 * F.lane);
                const float z0 = bf2f(zz & 0xffffu), z1 = bf2f(zz >> 16);
                *(unsigned*)(og + row * GVDIM + hv * HD + 2 * F.lane) = pk2(o0 * r * out_gain[2 * F.lane] * silu_f(z0), o1 * r * out_gain[2 * F.lane + 1] * silu_f(z1));
            }
            __syncthreads();
        }
    }
}


namespace gdn {
typedef float f32x16 __attribute__((ext_vector_type(16)));
typedef short s16x4 __attribute__((ext_vector_type(4)));
__device__ __forceinline__ unsigned off_b(unsigned row, unsigned ch) { return 256u * row + 16u * (ch ^ (((row & 3) << 2) | ((row >> 2) & 3))); }
__device__ __forceinline__ unsigned off64(unsigned row, unsigned ch) { return 128u * row + 16u * (ch ^ (row & 7)); }
constexpr int L_KU = 0, L_QU = 16384, L_VNT = 16384, L_VV = 32768, L_ST = 49152, L_LP = 81920, L_RT = 81920, L_OB = 81920, L_TM = 98304, L_SSQ = 98304, L_AQ = 106496, L_VNTE = 114688;
constexpr int L_CW = RING_BYTES, L_SC = L_CW + 6144;
constexpr int L_TR = L_SC + 2560, L_TT = L_TR + 4096;
constexpr int SC_BETA = 0, SC_RK = 64, SC_RQ = 128, SC_G2 = 192, SC_AK = 256, SC_BQ = 320, SC_EV = 384, SC_DL = 448, SC_GAIN = 512;
static_assert(L_TT + 4096 <= LDSCTL_OFF, "gdn lds");
__device__ __forceinline__ int crow(int r, int hi) { return (r & 3) + 8 * (r >> 2) + 4 * hi; }
__device__ __forceinline__ unsigned cvtpk(float lo, float hi) { return pk2(lo, hi); }
__device__ __forceinline__ float dpp_add8(float v) {
    v += __int_as_float(__builtin_amdgcn_mov_dpp(__float_as_int(v), 0xB1, 0xF, 0xF, true));
    v += __int_as_float(__builtin_amdgcn_mov_dpp(__float_as_int(v), 0x4E, 0xF, 0xF, true));
    v += __int_as_float(__builtin_amdgcn_mov_dpp(__float_as_int(v), 0x141, 0xF, 0xF, true));
    return v;
}
__device__ __forceinline__ s16x4 tr_read(unsigned addr) { s16x4 r; asm volatile("ds_read_b64_tr_b16 %0, %1" : "=&v"(r) : "v"(addr) : "memory"); return r; }
}

__device__ __forceinline__ void p2_gdn(const Ctx& F, const bf16_t* proj, const float* conv_w, const float* a_log, const float* dt_bias, const float* out_gain, bf16_t* og) {
    using namespace gdn;
    LAS unsigned char* L = F.lds;
    const unsigned lbase = (unsigned)(size_t)L;
    LAS float* cw = (LAS float*)(L + L_CW);
    LAS float* sc = (LAS float*)(L + L_SC);
    LAS float* ssq = (LAS float*)(L + L_SSQ);
    int tid = F.tid, lane = F.lane, r32 = lane & 31, hi = lane >> 5;
    const int w = F.wave;
#define GDN_FRESH() do { asm volatile("" : "+v"(tid)); lane = tid & 63; r32 = lane & 31; hi = lane >> 5; } while (0)
    const int tb = w >> 2, vb = w & 3;
    const int kb = w >> 1, vbase = 2 * (w & 1);
    for (int unit = F.bid; unit < BATCH * GVH; unit += F.G) {
        const int b = unit / GVH, hv = unit % GVH, hk = hv / 2;
        const float Aexp = __expf(a_log[hv]), dtb = dt_bias[hv];
        __syncthreads();
        for (int idx = tid; idx < 4 * 384; idx += 512) { const int j = idx / 384, cl = idx % 384;
            const int col = cl < 128 ? hk * HD + cl : cl < 256 ? GKDIM + hk * HD + (cl - 128) : 2 * GKDIM + hv * HD + (cl - 256);
            cw[idx] = conv_w[j * GCONV + col]; }
        for (int idx = tid; idx < 32768 / 16; idx += 512) *(LAS u32x4*)(L + L_ST + idx * 16) = (u32x4){0u, 0u, 0u, 0u};
        f32x16 Sacc[2] = {};
        u32x4 pre[3][5];
#define GDN_LOADPRE(CH) do { _Pragma("unroll") for (int k_ = 0; k_ < 3; ++k_) { const int item_ = tid + 512 * k_, cc_ = item_ % 48, tok0_ = 2 * (item_ / 48); \
        const int col_ = cc_ < 16 ? hk * HD + cc_ * 8 : cc_ < 32 ? GKDIM + hk * HD + (cc_ - 16) * 8 : 2 * GKDIM + hv * HD + (cc_ - 32) * 8; \
        _Pragma("unroll") for (int rr_ = 0; rr_ < 5; ++rr_) { int tt_ = (CH) * 64 + tok0_ - 3 + rr_; tt_ = tt_ < 0 ? 0 : tt_; \
            pre[k_][rr_] = *(const u32x4*)(proj + (size_t)(b * SEQ + tt_) * GIN_PAD + col_); } } } while (0)
        GDN_LOADPRE(0);
        unsigned short braw = 0, araw = 0;
        if (w == 6) { const bf16_t* pr = proj + ((size_t)(b * SEQ) + lane) * GIN_PAD + GCONV + GVDIM; braw = pr[hv]; araw = pr[GVH + hv]; }
        for (int idx = tid; idx < HD; idx += 512) sc[SC_GAIN + idx] = out_gain[idx];
        __syncthreads();
        for (int ch = 0; ch < SEQ / 64; ++ch) {
            const int t0 = ch * 64;
            const size_t rowbase = (size_t)(b * SEQ + t0);
            GDN_FRESH();
            u32x4 zreg[2];
#pragma unroll
            for (int k = 0; k < 3; ++k) {
                const int item = tid + 512 * k, cc = item % 48, tok0 = 2 * (item / 48);
                float x[5][8];
#pragma unroll
                for (int rr = 0; rr < 5; ++rr) {
                    u32x4 u = pre[k][rr];
                    if (ch == 0 && rr < 3 && tok0 - 3 + rr < 0) u = (u32x4){0u, 0u, 0u, 0u};
                    x[rr][0] = bf2f(u.x & 0xffffu); x[rr][1] = bf2f(u.x >> 16); x[rr][2] = bf2f(u.y & 0xffffu); x[rr][3] = bf2f(u.y >> 16);
                    x[rr][4] = bf2f(u.z & 0xffffu); x[rr][5] = bf2f(u.z >> 16); x[rr][6] = bf2f(u.w & 0xffffu); x[rr][7] = bf2f(u.w >> 16);
                }
                float y[2][8];
#pragma unroll
                for (int e = 0; e < 8; ++e) { y[0][e] = 0.f; y[1][e] = 0.f; }
#pragma unroll
                for (int j = 0; j < 4; ++j) {
                    const f32x4 w0 = *(const LAS f32x4*)(cw + j * 384 + cc * 8), w1 = *(const LAS f32x4*)(cw + j * 384 + cc * 8 + 4);
#pragma unroll
                    for (int d = 0; d < 2; ++d) {
                        y[d][0] += w0.x * x[d + j][0]; y[d][1] += w0.y * x[d + j][1]; y[d][2] += w0.z * x[d + j][2]; y[d][3] += w0.w * x[d + j][3];
                        y[d][4] += w1.x * x[d + j][4]; y[d][5] += w1.y * x[d + j][5]; y[d][6] += w1.z * x[d + j][6]; y[d][7] += w1.w * x[d + j][7];
                    }
                }
                float s2[2];
#pragma unroll
                for (int d = 0; d < 2; ++d) {
                    s2[d] = 0.f;
#pragma unroll
                    for (int e = 0; e < 8; ++e) { y[d][e] = silu_f(y[d][e]); s2[d] += y[d][e] * y[d][e]; }
                    u32x4 o; o.x = cvtpk(y[d][0], y[d][1]); o.y = cvtpk(y[d][2], y[d][3]); o.z = cvtpk(y[d][4], y[d][5]); o.w = cvtpk(y[d][6], y[d][7]);
                    const int tile = cc < 16 ? L_QU : cc < 32 ? L_KU : L_VV;
                    *(LAS u32x4*)(L + tile + off_b(tok0 + d, cc & 15)) = o;
                }
                if (cc < 32) *(LAS f32x2*)(ssq + cc * 64 + tok0) = (f32x2){s2[0], s2[1]};
            }
            __syncthreads();
            GDN_FRESH();
            f32x16 accB = {};
            const int bblk = w % 3, bib = bblk == 0 ? 0 : 1, bjb = bblk == 2 ? 1 : 0;
            if (w < 6) {
                const int btile = w >= 3 ? L_QU : L_KU;
#pragma unroll
                for (int s = 0; s < 8; ++s) {
                    const bf16x8 a = *(const LAS bf16x8*)(L + L_KU + off_b(32 * bjb + r32, 2 * s + hi));
                    const bf16x8 bq = *(const LAS bf16x8*)(L + btile + off_b(32 * bib + r32, 2 * s + hi));
                    accB = __builtin_amdgcn_mfma_f32_32x32x16_bf16(a, bq, accB, 0, 0, 0);
                }
            } else if (w == 6) {
                float sq = 0.f, sk = 0.f;
#pragma unroll
                for (int c = 0; c < 16; ++c) { sq += ssq[c * 64 + lane]; sk += ssq[(16 + c) * 64 + lane]; }
                const float rq = 0.08838834764831845f / sqrtf(sq + EPS), rk = 1.0f / sqrtf(sk + EPS);
                const float blog = bf2f(braw), alog = bf2f(araw);
                if (ch + 1 < SEQ / 64) { const bf16_t* pr = proj + (rowbase + 64 + lane) * GIN_PAD + GCONV + GVDIM; braw = pr[hv]; araw = pr[GVH + hv]; }
                const float bet = sigmoid_f(blog);
                float g2 = -Aexp * softplus_f(alog + dtb) * 1.4426950408889634f;
#pragma unroll
                for (int o = 1; o < 64; o <<= 1) { const float t = __shfl_up(g2, o); if (lane >= o) g2 += t; }
                const float g2last = __shfl(g2, 63);
                const float eg = __builtin_amdgcn_exp2f(g2);
                sc[SC_BETA + lane] = bet; sc[SC_RK + lane] = rk; sc[SC_RQ + lane] = rq; sc[SC_G2 + lane] = g2;
                sc[SC_AK + lane] = rk * eg; sc[SC_BQ + lane] = rq * eg; sc[SC_EV + lane] = rk * __builtin_amdgcn_exp2f(g2last - g2);
                if (lane == 0) sc[SC_DL] = __builtin_amdgcn_exp2f(g2last);
            }
            __syncthreads();
            GDN_FRESH();
            if (w < 6) {
                const int i = 32 * bib + r32;
                const float g2i = sc[SC_G2 + i];
                const float fi = w < 3 ? sc[SC_BETA + i] * sc[SC_RK + i] : sc[SC_RQ + i];
                float val[16];
#pragma unroll
                for (int r = 0; r < 16; ++r) {
                    const int j = 32 * bjb + crow(r, hi);
                    const float dec = __builtin_amdgcn_exp2f(fminf(g2i - sc[SC_G2 + j], 0.f));
                    const bool keep = w < 3 ? (j < i) : (j <= i);
                    val[r] = keep ? fi * sc[SC_RK + j] * accB[r] * dec : 0.f;
                }
                if (w < 3) {
#pragma unroll
                    for (int g = 0; g < 4; ++g) *(LAS f32x4*)(L + L_LP + (i * 64 + 32 * bjb + 8 * g + 4 * hi) * 4) = (f32x4){val[4 * g], val[4 * g + 1], val[4 * g + 2], val[4 * g + 3]};
                } else {
#pragma unroll
                    for (int g = 0; g < 4; ++g) *(LAS u32x2*)(L + L_AQ + off64(i, 4 * bjb + g) + 8 * hi) = (u32x2){cvtpk(val[4 * g], val[4 * g + 1]), cvtpk(val[4 * g + 2], val[4 * g + 3])};
                }
            }
            { const u32x4* zp = (const u32x4*)(proj + (rowbase + (tid >> 3)) * GIN_PAD + GCONV + hv * HD + (tid & 7) * 16); zreg[0] = zp[0]; zreg[1] = zp[1]; }
            __syncthreads();
            GDN_FRESH();
            if (ch + 1 < SEQ / 64) GDN_LOADPRE(ch + 1);
            f32x16 ksacc = {}, qsacc = {};
#pragma unroll
            for (int s = 0; s < 8; ++s) {
                const bf16x8 ak = *(const LAS bf16x8*)(L + L_KU + off_b(32 * tb + r32, 2 * s + hi));
                const bf16x8 aq = *(const LAS bf16x8*)(L + L_QU + off_b(32 * tb + r32, 2 * s + hi));
                const bf16x8 bs = *(const LAS bf16x8*)(L + L_ST + off_b(32 * vb + r32, 2 * s + hi));
                ksacc = __builtin_amdgcn_mfma_f32_32x32x16_bf16(ak, bs, ksacc, 0, 0, 0);
                qsacc = __builtin_amdgcn_mfma_f32_32x32x16_bf16(aq, bs, qsacc, 0, 0, 0);
            }
            GDN_FRESH();
            {
                LAS float* TRm = (LAS float*)(L + L_TR); LAS float* TTm = (LAS float*)(L + L_TT);
                const LAS float* Lm = (const LAS float*)(L + L_LP);
                const int c16 = lane & 15, q4 = lane >> 4;
                if (w < 4) {
                    const int bb = w;
                    float Tc[16];
#pragma unroll
                    for (int rb = 0; rb < 4; ++rb) {
                        f32x4 lr[4][4];
#pragma unroll
                        for (int r = 0; r < 4; ++r)
#pragma unroll
                            for (int ch4 = 0; ch4 < 4; ++ch4) if (ch4 <= rb) lr[r][ch4] = *(const LAS f32x4*)(Lm + (16 * bb + 4 * rb + r) * 64 + 16 * bb + 4 * ch4);
#pragma unroll
                        for (int r = 0; r < 4; ++r) {
                            const int row = 4 * rb + r;
                            float s0 = 0.f, s1 = 0.f;
#pragma unroll
                            for (int rp = 0; rp < 16; ++rp) if (rp < row) { const float lv = lr[r][rp >> 2][rp & 3]; if (rp & 1) s1 += lv * Tc[rp]; else s0 += lv * Tc[rp]; }
                            Tc[row] = (c16 == row ? 1.f : 0.f) - (s0 + s1);
                        }
                    }
#pragma unroll
                    for (int e = 0; e < 4; ++e) {
                        const float tv = q4 == 0 ? Tc[e] : q4 == 1 ? Tc[4 + e] : q4 == 2 ? Tc[8 + e] : Tc[12 + e];
                        const int row = 4 * q4 + e;
                        TRm[(bb * 16 + row) * 16 + c16] = tv;
                        TTm[(bb * 16 + c16) * 16 + row] = tv;
                        const int gi = 16 * bb + row, gj = 16 * bb + c16;
                        *(LAS bf16_t*)(L + L_TM + off64(gi, gj >> 3) + (gj & 7) * 2) = (bf16_t)f2bf(tv);
                    }
                } else if (w == 4) {
                    const int blk = lane >> 5, row = (lane >> 1) & 15, chh = lane & 1;
                    *(LAS u32x4*)(L + L_TM + off64(32 * blk + row, 4 * blk + 2 + chh)) = (u32x4){0u, 0u, 0u, 0u};
                }
                __syncthreads();
                GDN_FRESH();
                if (w < 3) {
                    const int jb = w, c16b = lane & 15, q4b = lane >> 4;
                    f32x4 Tk[4];
                    Tk[jb] = *(const LAS f32x4*)(TTm + (jb * 16 + c16b) * 16 + 4 * q4b);
#pragma unroll
                    for (int ib = 1; ib < 4; ++ib) if (ib > jb) {
                        f32x4 S = {0.f, 0.f, 0.f, 0.f};
#pragma unroll
                        for (int kb2 = 0; kb2 < 3; ++kb2) if (kb2 >= jb && kb2 < ib) {
                            const f32x4 a4 = *(const LAS f32x4*)(Lm + (16 * ib + c16b) * 64 + 16 * kb2 + 4 * q4b);
#pragma unroll
                            for (int e = 0; e < 4; ++e) S = __builtin_amdgcn_mfma_f32_16x16x4f32(a4[e], Tk[kb2][e], S, 0, 0, 0);
                        }
                        const f32x4 t4 = *(const LAS f32x4*)(TRm + (ib * 16 + c16b) * 16 + 4 * q4b);
                        f32x4 Tn = {0.f, 0.f, 0.f, 0.f};
#pragma unroll
                        for (int e = 0; e < 4; ++e) Tn = __builtin_amdgcn_mfma_f32_16x16x4f32(t4[e], S[e], Tn, 0, 0, 0);
                        Tn = -Tn; Tk[ib] = Tn;
#pragma unroll
                        for (int e = 0; e < 4; ++e) { const int gi = 16 * ib + 4 * q4b + e, gj = 16 * jb + c16b;
                            *(LAS bf16_t*)(L + L_TM + off64(gi, gj >> 3) + (gj & 7) * 2) = (bf16_t)f2bf(Tn[e]); }
                    }
                }
            }
            __syncthreads();
            GDN_FRESH();
            f32x16 oacc;
            {
                const int dv = 32 * vb + r32;
                float val[16];
#pragma unroll
                for (int r = 0; r < 16; ++r) {
                    const int tok = 32 * tb + crow(r, hi);
                    const float vv = bf2f(*(const LAS bf16_t*)(L + L_VV + off_b(tok, dv >> 3) + (dv & 7) * 2));
                    val[r] = sc[SC_BETA + tok] * (vv - sc[SC_AK + tok] * ksacc[r]);
                    oacc[r] = sc[SC_BQ + tok] * qsacc[r];
                }
#pragma unroll
                for (int g = 0; g < 4; ++g) *(LAS u32x2*)(L + L_RT + off64(dv, 4 * tb + g) + 8 * hi) = (u32x2){cvtpk(val[4 * g], val[4 * g + 1]), cvtpk(val[4 * g + 2], val[4 * g + 3])};
            }
            __syncthreads();
            GDN_FRESH();
            {
                f32x16 vn = {};
#pragma unroll
                for (int s = 0; s < 4; ++s) if (s < 2 || tb) {
                    const bf16x8 a = *(const LAS bf16x8*)(L + L_TM + off64(32 * tb + r32, 2 * s + hi));
                    const bf16x8 bq = *(const LAS bf16x8*)(L + L_RT + off64(32 * vb + r32, 2 * s + hi));
                    vn = __builtin_amdgcn_mfma_f32_32x32x16_bf16(a, bq, vn, 0, 0, 0);
                }
                const int dv = 32 * vb + r32;
#pragma unroll
                for (int g = 0; g < 4; ++g) {
                    float e[4];
#pragma unroll
                    for (int c = 0; c < 4; ++c) e[c] = vn[4 * g + c] * sc[SC_EV + 32 * tb + crow(4 * g + c, hi)];
                    *(LAS u32x2*)(L + L_VNT + off64(dv, 4 * tb + g) + 8 * hi) = (u32x2){cvtpk(vn[4 * g], vn[4 * g + 1]), cvtpk(vn[4 * g + 2], vn[4 * g + 3])};
                    *(LAS u32x2*)(L + L_VNTE + off64(dv, 4 * tb + g) + 8 * hi) = (u32x2){cvtpk(e[0], e[1]), cvtpk(e[2], e[3])};
                }
            }
            __syncthreads();
            GDN_FRESH();
            {
#pragma unroll
                for (int s = 0; s < 4; ++s) if (s < 2 || tb) {
                    const bf16x8 a = *(const LAS bf16x8*)(L + L_AQ + off64(32 * tb + r32, 2 * s + hi));
                    const bf16x8 bq = *(const LAS bf16x8*)(L + L_VNT + off64(32 * vb + r32, 2 * s + hi));
                    oacc = __builtin_amdgcn_mfma_f32_32x32x16_bf16(a, bq, oacc, 0, 0, 0);
                }
                const int dv = 32 * vb + r32;
#pragma unroll
                for (int r = 0; r < 16; ++r) *(LAS bf16_t*)(L + L_OB + (32 * tb + crow(r, hi)) * 256 + dv * 2) = (bf16_t)f2bf(oacc[r]);
            }
            GDN_FRESH();
            {
                const float dl = sc[SC_DL];
                Sacc[0] *= dl; Sacc[1] *= dl;
                const unsigned blk = (lane >> 4) & 1, q = (lane & 15) >> 2, p = lane & 3;
#pragma unroll
                for (int ks = 0; ks < 4; ++ks) {
                    const s16x4 t0v = tr_read(lbase + L_KU + off_b(16 * ks + 8 * hi + q, 4 * kb + 2 * blk + (p >> 1)) + 8 * (p & 1));
                    const s16x4 t1v = tr_read(lbase + L_KU + off_b(16 * ks + 8 * hi + 4 + q, 4 * kb + 2 * blk + (p >> 1)) + 8 * (p & 1));
                    const bf16x8 b0 = *(const LAS bf16x8*)(L + L_VNTE + off64(32 * vbase + r32, 2 * ks + hi));
                    const bf16x8 b1 = *(const LAS bf16x8*)(L + L_VNTE + off64(32 * (vbase + 1) + r32, 2 * ks + hi));
                    asm volatile("s_waitcnt lgkmcnt(0)" ::: "memory"); __builtin_amdgcn_sched_barrier(0);
                    const bf16x8 a = (bf16x8){t0v[0], t0v[1], t0v[2], t0v[3], t1v[0], t1v[1], t1v[2], t1v[3]};
                    Sacc[0] = __builtin_amdgcn_mfma_f32_32x32x16_bf16(a, b0, Sacc[0], 0, 0, 0);
                    Sacc[1] = __builtin_amdgcn_mfma_f32_32x32x16_bf16(a, b1, Sacc[1], 0, 0, 0);
                }
#pragma unroll
                for (int v2 = 0; v2 < 2; ++v2)
#pragma unroll
                    for (int g = 0; g < 4; ++g)
                        *(LAS u32x2*)(L + L_ST + off_b(32 * (vbase + v2) + r32, 4 * kb + g) + 8 * hi) = (u32x2){cvtpk(Sacc[v2][4 * g], Sacc[v2][4 * g + 1]), cvtpk(Sacc[v2][4 * g + 2], Sacc[v2][4 * g + 3])};
            }
            __syncthreads();
            GDN_FRESH();
            {
                const int tok = tid >> 3, seg = tid & 7;
                const u32x4 oa = *(const LAS u32x4*)(L + L_OB + tok * 256 + seg * 32), ob2 = *(const LAS u32x4*)(L + L_OB + tok * 256 + seg * 32 + 16);
                float o[16], z[16];
                const unsigned ow[8] = {oa.x, oa.y, oa.z, oa.w, ob2.x, ob2.y, ob2.z, ob2.w};
                const unsigned zw[8] = {zreg[0].x, zreg[0].y, zreg[0].z, zreg[0].w, zreg[1].x, zreg[1].y, zreg[1].z, zreg[1].w};
                float ss = 0.f;
#pragma unroll
                for (int e = 0; e < 8; ++e) { o[2 * e] = bf2f(ow[e] & 0xffffu); o[2 * e + 1] = bf2f(ow[e] >> 16); z[2 * e] = bf2f(zw[e] & 0xffffu); z[2 * e + 1] = bf2f(zw[e] >> 16);
                    ss += o[2 * e] * o[2 * e] + o[2 * e + 1] * o[2 * e + 1]; }
                const float r = 1.0f / sqrtf(dpp_add8(ss) * (1.f / HD) + EPS);
                unsigned res[8];
#pragma unroll
                for (int e = 0; e < 8; ++e) { const f32x2 gg = *(const LAS f32x2*)(sc + SC_GAIN + seg * 16 + 2 * e);
                    res[e] = pk2(o[2 * e] * r * gg.x * silu_f(z[2 * e]), o[2 * e + 1] * r * gg.y * silu_f(z[2 * e + 1])); }
                u32x4* op = (u32x4*)(og + (rowbase + tok) * GVDIM + hv * HD + seg * 16);
                op[0] = (u32x4){res[0], res[1], res[2], res[3]}; op[1] = (u32x4){res[4], res[5], res[6], res[7]};
            }
        }
#undef GDN_LOADPRE
    }
}
#undef GDN_FRESH

struct MoeBufs { int* blk_cnt; int* pad_start; int* tok_e; float* tok_w; int* tok_slot; };
__device__ __forceinline__ void p_moe_route(const Ctx& F, const float* h, const float* gain, const float* WR, const float* b_rg, const float* b_re, bf16_t* XN, const MoeBufs& mb) {
    constexpr int YS = D + 4;
    LAS float* y = (LAS float*)F.lds;
    LAS float* part = y + 16 * YS;
    LAS float* lgt = part + 8 * 16 * WRN;
    LAS int* lcnt = (LAS int*)(lgt + 16 * 40);
    static_assert((16 * YS + 8 * 16 * WRN + 16 * 40 + 32) * 4 <= LDSCTL_OFF, "route lds");
    constexpr int TPB = 64;
    const int lane = F.lane, w = F.wave;
    f32x4 gv[8];
#pragma unroll
    for (int j = 0; j < 8; ++j) gv[j] = ((const f32x4*)gain)[128 * (j >> 1) + 2 * lane + (j & 1)];
    for (int blk = F.bid; blk < T / TPB; blk += F.G) {
        if (F.tid < NE) lcnt[F.tid] = 0;
        __syncthreads();
        for (int rd = 0; rd < 4; ++rd) {
            const float* wb = WR + ((size_t)(64 * w + (lane >> 4)) * WRN + (lane & 15)) * 4;
            f32x4 B0[12], B1[12];
            f32x4 vv[2][8];
#pragma unroll
            for (int q = 0; q < 2; ++q) { const f32x4* xr = (const f32x4*)(h + (size_t)(blk * TPB + rd * 16 + 2 * w + q) * D) + 2 * lane;
#pragma unroll
                for (int j = 0; j < 8; ++j) vv[q][j] = xr[128 * (j >> 1) + (j & 1)]; }
            asm volatile("" ::: "memory");
#pragma unroll
            for (int q = 0; q < 2; ++q) {
                const int tl = 2 * w + q, t = blk * TPB + rd * 16 + tl;
                f32x4 (&v)[8] = vv[q]; float s = 0.f;
#pragma unroll
                for (int j = 0; j < 8; ++j) s += (v[j].x * v[j].x + v[j].y * v[j].y) + (v[j].z * v[j].z + v[j].w * v[j].w);
                const float r = 1.0f / sqrtf(wave_sum(s) * (1.f / D) + EPS);
                u32x4* o16 = (u32x4*)(XN + (size_t)t * D) + lane;
#pragma unroll
                for (int j = 0; j < 4; ++j) {
                    const f32x4 a = v[2 * j] * r * gv[2 * j], b = v[2 * j + 1] * r * gv[2 * j + 1];
                    o16[64 * j] = (u32x4){pk2(a.x, a.y), pk2(a.z, a.w), pk2(b.x, b.y), pk2(b.z, b.w)};
                    LAS f32x4* yp = (LAS f32x4*)(y + tl * YS + 8 * (64 * j + lane)); yp[0] = a; yp[1] = b; }
            }
            __syncthreads();
            {
                f32x4 acc0 = {0.f, 0.f, 0.f, 0.f}, acc1 = acc0, acc2 = acc0;
                const LAS float* ya = y + (lane & 15) * YS + 256 * w + 4 * (lane >> 4);
#define RT_BLOCK(BB, jb) _Pragma("unroll") for (int jj = 0; jj < 4; ++jj) { const f32x4 a4 = *(const LAS f32x4*)(ya + 16 * ((jb) + jj)); \
                    _Pragma("unroll") for (int e = 0; e < 4; ++e) { \
                        acc0 = __builtin_amdgcn_mfma_f32_16x16x4f32(a4[e], BB[3 * jj][e], acc0, 0, 0, 0); \
                        acc1 = __builtin_amdgcn_mfma_f32_16x16x4f32(a4[e], BB[3 * jj + 1][e], acc1, 0, 0, 0); \
                        acc2 = __builtin_amdgcn_mfma_f32_16x16x4f32(a4[e], BB[3 * jj + 2][e], acc2, 0, 0, 0); } }
#define RT_LOAD(BB, jb) _Pragma("unroll") for (int i = 0; i < 12; ++i) BB[i] = *(const f32x4*)(wb + (size_t)(4 * ((jb) + i / 3)) * WRN * 4 + 64 * (i % 3));
                RT_LOAD(B0, 0)
                RT_LOAD(B1, 4)
                asm volatile("" ::: "memory");
                RT_BLOCK(B0, 0)
                asm volatile("" ::: "memory");
                RT_LOAD(B0, 8)
                asm volatile("" ::: "memory");
                RT_BLOCK(B1, 4)
                asm volatile("" ::: "memory");
                RT_LOAD(B1, 12)
                asm volatile("" ::: "memory");
                RT_BLOCK(B0, 8)
                RT_BLOCK(B1, 12)
#undef RT_BLOCK
#undef RT_LOAD
#pragma unroll
                for (int r = 0; r < 4; ++r) { LAS float* pp = part + (w * 16 + 4 * (lane >> 4) + r) * WRN + (lane & 15);
                    pp[0] = acc0[r]; pp[16] = acc1[r]; pp[32] = acc2[r]; }
            }
            __syncthreads();
            for (int idx = F.tid; idx < 16 * 36; idx += 512) {
                const int tok = idx / 36, n = idx % 36;
                float s = 0.f;
#pragma unroll
                for (int ww = 0; ww < 8; ++ww) s += part[(ww * 16 + tok) * WRN + n];
                lgt[tok * 40 + n] = s + (n < NGRP ? b_rg[n] : b_re[n - NGRP]);
            }
            __syncthreads();
#pragma unroll
            for (int q = 0; q < 2; ++q) {
                const int tl = 2 * w + q, t = blk * TPB + rd * 16 + tl;
                const LAS float* lg = lgt + tl * 40;
                int gi = 0; float gm = lg[0];
#pragma unroll
                for (int i = 1; i < NGRP; ++i) { const float v = lg[i]; if (v > gm) { gm = v; gi = i; } }
                float den = 0.f;
#pragma unroll
                for (int i = 0; i < NGRP; ++i) den += __expf(lg[i] - gm);
                const float gval = 1.0f / den;
                const LAS float* le = lg + NGRP + gi * EPG;
                int i1 = 0; float l1 = le[0];
#pragma unroll
                for (int i = 1; i < EPG; ++i) { const float v = le[i]; if (v > l1) { l1 = v; i1 = i; } }
                int i2 = -1; float l2 = -3.0e38f;
#pragma unroll
                for (int i = 0; i < EPG; ++i) { const float v = le[i]; if (i != i1 && v > l2) { l2 = v; i2 = i; } }
                const float ex = __expf(l2 - l1), w1 = 1.0f / (1.0f + ex), w2 = ex / (1.0f + ex);
                if (lane == 0) {
                    const int e1 = gi * EPG + i1, e2 = gi * EPG + i2;
                    const int p1 = atomicAdd((int*)&lcnt[e1], 1), p2 = atomicAdd((int*)&lcnt[e2], 1);
                    mb.tok_e[2 * t] = e1 | (p1 << 8); mb.tok_e[2 * t + 1] = e2 | (p2 << 8);
                    mb.tok_w[2 * t] = gval * w1; mb.tok_w[2 * t + 1] = gval * w2;
                }
            }
        }
        __syncthreads();
        if (F.tid < NE) mb.blk_cnt[blk * NE + F.tid] = lcnt[F.tid];
        __syncthreads();
    }
}
__device__ __forceinline__ void p_moe_scatter(const Ctx& F, const bf16_t* XN, bf16_t* XS, const MoeBufs& mb) {
    LAS int* tot = (LAS int*)F.lds;
    LAS int* base = tot + 32;
    LAS int* pst = base + 32;
    constexpr int TPB = 64, NBLK = T / TPB;
    for (int blk = F.bid; blk < NBLK; blk += F.G) {
        if (F.tid < NE) { int s = 0, bs = 0; for (int j = 0; j < NBLK; ++j) { const int c = mb.blk_cnt[j * NE + F.tid]; s += c; bs += (j < blk) ? c : 0; } tot[F.tid] = s; base[F.tid] = bs; }
        __syncthreads();
        if (F.tid == 0) { int s = 0; for (int e = 0; e < NE; ++e) { pst[e] = s; s += (tot[e] + 255) & ~255; } pst[NE] = s;
            if (blk == 0) for (int e = 0; e <= NE; ++e) mb.pad_start[e] = pst[e]; }
        __syncthreads();
        for (int a = F.wave; a < 2 * TPB; a += 8) {
            const int ai = blk * 2 * TPB + a, t = ai >> 1;
            const int ep = mb.tok_e[ai], e = ep & 0xff, lp = ep >> 8;
            const int slot = pst[e] + base[e] + lp;
            const u32x4* src = (const u32x4*)(XN + (size_t)t * D) + F.lane; u32x4* dst = (u32x4*)(XS + (size_t)slot * D) + F.lane;
#pragma unroll
            for (int j = 0; j < 4; ++j) dst[64 * j] = src[64 * j];
            if (F.lane == 0) mb.tok_slot[ai] = slot;
        }
        __syncthreads();
    }
}
__device__ __forceinline__ void moe_units(const Ctx& F, const MoeBufs& mb, int nN, pg8::ListOrder& S) {
    LAS int* pst = (LAS int*)(F.lds + LDSCTL_OFF + 256);
    if (F.tid <= NE) pst[F.tid] = mb.pad_start[F.tid];
    __syncthreads();
    const int nmt = pst[NE] / 256, n = nmt * nN;
    int d[8]; int cnt = 0;
#pragma unroll
    for (int i = 0; i < 8; ++i) {
        const int L = i * F.G + F.bid; d[i] = 0;
        if (L < n) {
            int wgid = L; { const int q = n / 8, r = n % 8, xcd = wgid % 8, off = wgid / 8; wgid = (xcd < r ? xcd * (q + 1) : r * (q + 1) + (xcd - r) * q) + off; }
            const int mt = wgid / nN, pn = wgid % nN;
            int e = 0; for (int j = 1; j <= NE - 1; ++j) e += (pst[j] <= mt * 256) ? 1 : 0;
            d[i] = __builtin_amdgcn_readfirstlane(mt | (pn << 12) | ((e * nN + pn) << 16)); cnt = i + 1;
        }
    }
    S.n = __builtin_amdgcn_readfirstlane(cnt); S.d0 = d[0]; S.d1 = d[1]; S.d2 = d[2]; S.d3 = d[3]; S.d4 = d[4]; S.d5 = d[5]; S.d6 = d[6]; S.d7 = d[7];
    __syncthreads();
}
__device__ __forceinline__ void moe_gather_prep(const Ctx& F, const MoeBufs& mb, int nN, pg8::ListOrder& S, LAS int* rowtok) {
    constexpr int TPB = 64, NBLK = T / TPB;
    LAS int* base = (LAS int*)F.lds;
    LAS int* segsum = base + NBLK * NE;
    LAS int* segoff = segsum + 16 * NE;
    LAS int* pst = segoff + 16 * NE;
    LAS int* umt = pst + 64;
    {   const int e = F.tid & 31, seg = F.tid >> 5; int s = 0;
        for (int j = seg * 16; j < seg * 16 + 16; ++j) { base[j * NE + e] = s; s += mb.blk_cnt[j * NE + e]; }
        segsum[seg * NE + e] = s; }
    __syncthreads();
    if (F.tid < NE) { int run = 0; for (int sg = 0; sg < 16; ++sg) { segoff[sg * NE + F.tid] = run; run += segsum[sg * NE + F.tid]; } segsum[F.tid] = run; }
    __syncthreads();
    if (F.tid == 0) { int s = 0; for (int e = 0; e < NE; ++e) { pst[e] = s; s += (segsum[e] + 255) & ~255; } pst[NE] = s;
        if (F.bid == 0) for (int e = 0; e <= NE; ++e) mb.pad_start[e] = pst[e]; }
    for (int i = F.tid; i < 8 * 256; i += 512) rowtok[i] = 0;
    __syncthreads();
    const int nmt = pst[NE] / 256, n = nmt * nN;
    int d[8]; int cnt = 0;
#pragma unroll
    for (int i = 0; i < 8; ++i) {
        const int Lq = i * F.G + F.bid; d[i] = 0;
        if (Lq < n) {
            int wgid = Lq; { const int q = n / 8, r = n % 8, xcd = wgid % 8, off = wgid / 8; wgid = (xcd < r ? xcd * (q + 1) : r * (q + 1) + (xcd - r) * q) + off; }
            const int mt = wgid / nN, pn = wgid % nN;
            int e = 0; for (int j = 1; j <= NE - 1; ++j) e += (pst[j] <= mt * 256) ? 1 : 0;
            d[i] = __builtin_amdgcn_readfirstlane(mt | (pn << 12) | ((e * nN + pn) << 16)); cnt = i + 1;
            if (F.tid == 0) umt[i] = mt;
        } else if (F.tid == 0) umt[i] = -1;
    }
    S.n = __builtin_amdgcn_readfirstlane(cnt); S.d0 = d[0]; S.d1 = d[1]; S.d2 = d[2]; S.d3 = d[3]; S.d4 = d[4]; S.d5 = d[5]; S.d6 = d[6]; S.d7 = d[7];
    __syncthreads();
    int um[8];
#pragma unroll
    for (int i = 0; i < 8; ++i) um[i] = umt[i];
    for (int a = F.tid; a < 2 * T; a += 512) {
        const int ep = mb.tok_e[a], e = ep & 0xff, lp = ep >> 8, blk = a >> 7;
        const int slot = pst[e] + segoff[(blk >> 4) * NE + e] + base[blk * NE + e] + lp;
        if (blk % F.G == F.bid) mb.tok_slot[a] = slot;
        const int mt = slot >> 8;
#pragma unroll
        for (int i = 0; i < 8; ++i) if (mt == um[i]) rowtok[i * 256 + (slot & 255)] = a >> 1;
    }
    __syncthreads();
}

__device__ __forceinline__ void p_moe_combine(const Ctx& F, float* h, const bf16_t* YS, const MoeBufs& mb, bf16_t* XN) {
    const int gw = F.bid * 8 + F.wave, NGW = F.G * 8;
    for (int t = gw; t < T; t += NGW) {
        const int s0 = mb.tok_slot[2 * t], s1 = mb.tok_slot[2 * t + 1]; const float w0 = mb.tok_w[2 * t], w1 = mb.tok_w[2 * t + 1];
        f32x4* hr = (f32x4*)(h + (size_t)t * D) + 2 * F.lane;
        const u32x4* y0 = (const u32x4*)(YS + (size_t)s0 * D) + F.lane; const u32x4* y1 = (const u32x4*)(YS + (size_t)s1 * D) + F.lane;
        f32x4 v[8]; float s = 0.f;
#pragma unroll
        for (int j = 0; j < 4; ++j) { const u32x4 a = y0[64 * j], b = y1[64 * j];
            f32x4 lo = hr[128 * j], hi4 = hr[128 * j + 1];
            lo.x += w0 * bf2f(a.x & 0xffffu) + w1 * bf2f(b.x & 0xffffu); lo.y += w0 * bf2f(a.x >> 16) + w1 * bf2f(b.x >> 16);
            lo.z += w0 * bf2f(a.y & 0xffffu) + w1 * bf2f(b.y & 0xffffu); lo.w += w0 * bf2f(a.y >> 16) + w1 * bf2f(b.y >> 16);
            hi4.x += w0 * bf2f(a.z & 0xffffu) + w1 * bf2f(b.z & 0xffffu); hi4.y += w0 * bf2f(a.z >> 16) + w1 * bf2f(b.z >> 16);
            hi4.z += w0 * bf2f(a.w & 0xffffu) + w1 * bf2f(b.w & 0xffffu); hi4.w += w0 * bf2f(a.w >> 16) + w1 * bf2f(b.w >> 16);
            hr[128 * j] = lo; hr[128 * j + 1] = hi4; v[2 * j] = lo; v[2 * j + 1] = hi4;
            s += (lo.x * lo.x + lo.y * lo.y) + (lo.z * lo.z + lo.w * lo.w) + (hi4.x * hi4.x + hi4.y * hi4.y) + (hi4.z * hi4.z + hi4.w * hi4.w); }
        if (XN) { const float r = 1.0f / sqrtf(wave_sum(s) * (1.f / D) + EPS); u32x4* o16 = (u32x4*)(XN + (size_t)t * D) + F.lane;
#pragma unroll
            for (int j = 0; j < 4; ++j) o16[64 * j] = (u32x4){pk2(v[2 * j].x * r, v[2 * j].y * r), pk2(v[2 * j].z * r, v[2 * j].w * r), pk2(v[2 * j + 1].x * r, v[2 * j + 1].y * r), pk2(v[2 * j + 1].z * r, v[2 * j + 1].w * r)}; }
    }
}
__device__ __forceinline__ void p_qk_norm(const Ctx& F, bf16_t* kvq, const float* k_gain, const float* q_gain) {
    const int gw = F.bid * 8 + F.wave, NGW = F.G * 8;
    for (int r = gw; r < T * 2 * SBH; r += NGW) {
        const int t = r / (2 * SBH), hh = r % (2 * SBH); const bool isq = hh >= SBH;
        unsigned* p = (unsigned*)(kvq + (size_t)t * KVQ + (isq ? 2 * SBDIM + (hh - SBH) * HD : hh * HD)) + F.lane;
        const unsigned u = *p; const float a = bf2f(u & 0xffffu), b = bf2f(u >> 16);
        const float rr = 1.0f / sqrtf(wave_sum(a * a + b * b) * (1.f / HD) + EPS);
        const float* g = isq ? q_gain : k_gain;
        const float qs = isq ? 0.12751743082459868f : 1.0f;
        *p = pk2(a * rr * g[2 * F.lane] * qs, b * rr * g[2 * F.lane + 1] * qs);
    }
}
__device__ __forceinline__ void p_sb_attn_ref(const Ctx& F, const bf16_t* kvq, bf16_t* ao) {
    LAS float* Kt = (LAS float*)F.lds;
    LAS float* Vt = Kt + 64 * HD;
    const int il = F.tid >> 1, half = F.tid & 1;
    for (int unit = F.bid; unit < BATCH * SBH * 4; unit += F.G) {
        const int p = unit & 3, bh = unit >> 2, b = bh / SBH, hh = bh % SBH;
        for (int side = 0; side < 2; ++side) {
            const int qb = side == 0 ? 7 - p : p;
            const int i = qb * 256 + il;
            float q[64], o[64];
            { const u32x4* qp = (const u32x4*)(kvq + (size_t)(b * SEQ + i) * KVQ + 2 * SBDIM + hh * HD + half * 64);
#pragma unroll
              for (int j = 0; j < 8; ++j) { const u32x4 u = qp[j];
                  q[8 * j + 0] = bf2f(u.x & 0xffffu); q[8 * j + 1] = bf2f(u.x >> 16); q[8 * j + 2] = bf2f(u.y & 0xffffu); q[8 * j + 3] = bf2f(u.y >> 16);
                  q[8 * j + 4] = bf2f(u.z & 0xffffu); q[8 * j + 5] = bf2f(u.z >> 16); q[8 * j + 6] = bf2f(u.w & 0xffffu); q[8 * j + 7] = bf2f(u.w >> 16); } }
#pragma unroll
            for (int d = 0; d < 64; ++d) { q[d] *= 0.08838834764831845f; o[d] = 0.f; }
            float csum = 0.f;
            for (int kt = qb * 4 + 3; kt >= 0; --kt) {
                __syncthreads();
                for (int idx = F.tid; idx < 64 * 16 * 2; idx += 512) {
                    const int which = idx / 1024, r = (idx / 16) % 64, c8 = idx % 16;
                    const u32x4 u = *(const u32x4*)(kvq + (size_t)(b * SEQ + kt * 64 + r) * KVQ + which * SBDIM + hh * HD + c8 * 8);
                    LAS float* dst = (which ? Vt : Kt) + r * HD + c8 * 8;
                    dst[0] = bf2f(u.x & 0xffffu); dst[1] = bf2f(u.x >> 16); dst[2] = bf2f(u.y & 0xffffu); dst[3] = bf2f(u.y >> 16);
                    dst[4] = bf2f(u.z & 0xffffu); dst[5] = bf2f(u.z >> 16); dst[6] = bf2f(u.w & 0xffffu); dst[7] = bf2f(u.w >> 16);
                }
                __syncthreads();
                for (int jl = 63; jl >= 0; --jl) {
                    const int j = kt * 64 + jl;
                    if (j < i) {
                        const LAS f32x4* kp = (const LAS f32x4*)(Kt + jl * HD + half * 64);
                        float z = 0.f;
#pragma unroll
                        for (int d = 0; d < 16; ++d) { const f32x4 kk = kp[d]; z += q[4 * d] * kk.x + q[4 * d + 1] * kk.y + q[4 * d + 2] * kk.z + q[4 * d + 3] * kk.w; }
                        z += __shfl_xor(z, 1);
                        csum -= softplus_f(z);
                        const float w = __expf(z + csum);
                        const LAS f32x4* vp = (const LAS f32x4*)(Vt + jl * HD + half * 64);
#pragma unroll
                        for (int d = 0; d < 16; ++d) { const f32x4 vv = vp[d]; o[4 * d] += w * vv.x; o[4 * d + 1] += w * vv.y; o[4 * d + 2] += w * vv.z; o[4 * d + 3] += w * vv.w; }
                    }
                }
            }
            u32x4* op = (u32x4*)(ao + (size_t)(b * SEQ + i) * SBDIM + hh * HD + half * 64);
#pragma unroll
            for (int j = 0; j < 8; ++j) { u32x4 w; w.x = pk2(o[8 * j], o[8 * j + 1]); w.y = pk2(o[8 * j + 2], o[8 * j + 3]); w.z = pk2(o[8 * j + 4], o[8 * j + 5]); w.w = pk2(o[8 * j + 6], o[8 * j + 7]); op[j] = w; }
        }
    }
}


namespace sba {
typedef float f32x16 __attribute__((ext_vector_type(16)));
typedef short s16x4 __attribute__((ext_vector_type(4)));
constexpr int SHM_V = 64 * HD * 2, SHM_K = 64 * HD * 2;
#define SBA_KSWZ(row, colB) ((row) * 256 + ((colB) ^ (((row) & 7) << 4)))
__device__ __forceinline__ int crow(int r, int hi) { return (r & 3) + 8 * (r >> 2) + 4 * hi; }
__device__ __forceinline__ unsigned cvtpk(float lo, float hi) { return pk2(lo, hi); }
__device__ __forceinline__ void qkt(f32x16& p0, f32x16& p1, const LAS char* Ks, const bf16x8* qr, int r32, int hi) {
    p0 = f32x16{}; p1 = f32x16{};
#pragma unroll
    for (int d0 = 0; d0 < 8; ++d0) { const int cb = (d0 * 16 + hi * 8) * 2;
        const bf16x8 b0 = *(const LAS bf16x8*)(Ks + SBA_KSWZ(r32, cb));
        const bf16x8 b1 = *(const LAS bf16x8*)(Ks + SBA_KSWZ(32 + r32, cb));
        p0 = __builtin_amdgcn_mfma_f32_32x32x16_bf16(b0, qr[d0], p0, 0, 0, 0);
        p1 = __builtin_amdgcn_mfma_f32_32x32x16_bf16(b1, qr[d0], p1, 0, 0, 0); }
}
__device__ __forceinline__ int v_st(int k, int c) { const int kk = (k & ~0xC) | ((k & 4) << 1) | ((k & 8) >> 1); return ((kk >> 3) * 4 + (c >> 5)) * 512 + ((kk & 7) * 32 + (c & 31)) * 2; }
__device__ __forceinline__ int v_rd_base(int lane) { return ((lane & 3) << 3) | (((lane >> 2) & 3) << 6) | (((lane >> 4) & 1) << 5) | (((lane >> 5) & 1) << 8); }
constexpr int v_rd_off(int d0, int ks, int half) { return d0 * 512 + ks * 4096 + half * 2048; }
template <int OFF> __device__ __forceinline__ s16x4 tr_read(int vb) { s16x4 r; asm volatile("ds_read_b64_tr_b16 %0, %1 offset:%2" : "=&v"(r) : "v"(vb), "i"(OFF) : "memory"); return r; }
template <int D0> __device__ __forceinline__ void pv_one(f32x16& od, int vb, bf16x8 pa0, bf16x8 pa1, bf16x8 pa2, bf16x8 pa3) {
    const s16x4 l0 = tr_read<v_rd_off(D0, 0, 0)>(vb), h0 = tr_read<v_rd_off(D0, 0, 1)>(vb), l1 = tr_read<v_rd_off(D0, 1, 0)>(vb), h1 = tr_read<v_rd_off(D0, 1, 1)>(vb);
    const s16x4 l2 = tr_read<v_rd_off(D0, 2, 0)>(vb), h2 = tr_read<v_rd_off(D0, 2, 1)>(vb), l3 = tr_read<v_rd_off(D0, 3, 0)>(vb), h3 = tr_read<v_rd_off(D0, 3, 1)>(vb);
    asm volatile("s_waitcnt lgkmcnt(0)" ::: "memory"); __builtin_amdgcn_sched_barrier(0);
#define SBA_PK(L, H) (bf16x8){L[0], L[1], L[2], L[3], H[0], H[1], H[2], H[3]}
    od = __builtin_amdgcn_mfma_f32_32x32x16_bf16(pa0, SBA_PK(l0, h0), od, 0, 0, 0);
    od = __builtin_amdgcn_mfma_f32_32x32x16_bf16(pa1, SBA_PK(l1, h1), od, 0, 0, 0);
    od = __builtin_amdgcn_mfma_f32_32x32x16_bf16(pa2, SBA_PK(l2, h2), od, 0, 0, 0);
    od = __builtin_amdgcn_mfma_f32_32x32x16_bf16(pa3, SBA_PK(l3, h3), od, 0, 0, 0);
#undef SBA_PK
}
__device__ __forceinline__ void sb_weights(f32x16& p0, f32x16& p1, float& carry, float hmask, bf16x8& pa0, bf16x8& pa1, bf16x8& pa2, bf16x8& pa3) {
    f32x16 l0, l1;
#pragma unroll
    for (int r = 0; r < 16; ++r) {
        const float t0 = __builtin_amdgcn_exp2f(fminf(p0[r], 64.f)), t1 = __builtin_amdgcn_exp2f(fminf(p1[r], 64.f));
        l0[r] = __builtin_amdgcn_rcpf(1.0f + t0); l1[r] = __builtin_amdgcn_rcpf(1.0f + t1);
        p0[r] = t0 * l0[r]; p1[r] = t1 * l1[r];
    }
#pragma unroll
    for (int m = 0; m < 4; ++m) {
        p0[4 * m + 2] *= l0[4 * m + 3]; l0[4 * m + 2] *= l0[4 * m + 3]; p0[4 * m + 1] *= l0[4 * m + 2]; l0[4 * m + 1] *= l0[4 * m + 2]; p0[4 * m] *= l0[4 * m + 1]; l0[4 * m] *= l0[4 * m + 1];
        p1[4 * m + 2] *= l1[4 * m + 3]; l1[4 * m + 2] *= l1[4 * m + 3]; p1[4 * m + 1] *= l1[4 * m + 2]; l1[4 * m + 1] *= l1[4 * m + 2]; p1[4 * m] *= l1[4 * m + 1]; l1[4 * m] *= l1[4 * m + 1];
    }
    float Pm[8], Om[8];
#pragma unroll
    for (int m = 0; m < 8; ++m) {
        const float tm = m < 4 ? l0[4 * m] : l1[4 * (m - 4)];
        auto rr = __builtin_amdgcn_permlane32_swap(__float_as_uint(tm), __float_as_uint(tm), false, false);
        const float e = __uint_as_float(rr[0]), o = __uint_as_float(rr[1]);
        Pm[m] = e * o; Om[m] = hmask * o + (1.0f - hmask);
    }
    float sp = carry;
#pragma unroll
    for (int m = 7; m >= 0; --m) {
        const float off = sp * Om[m];
        if (m < 4) {
#pragma unroll
            for (int j = 0; j < 4; ++j) p0[4 * m + j] *= off;
        } else {
#pragma unroll
            for (int j = 0; j < 4; ++j) p1[4 * (m - 4) + j] *= off;
        }
        sp *= Pm[m];
    }
    carry = sp;
#define SBA_PK4(P, BASE, OUT) do { unsigned a0 = cvtpk(P[BASE + 0], P[BASE + 1]), a1 = cvtpk(P[BASE + 2], P[BASE + 3]); \
    unsigned b0 = cvtpk(P[BASE + 4], P[BASE + 5]), b1 = cvtpk(P[BASE + 6], P[BASE + 7]); \
    auto r0 = __builtin_amdgcn_permlane32_swap(a0, b0, false, false); auto r1 = __builtin_amdgcn_permlane32_swap(a1, b1, false, false); \
    u32x4 w = {r0[0], r1[0], r0[1], r1[1]}; OUT = *reinterpret_cast<bf16x8*>(&w); } while (0)
    SBA_PK4(p0, 0, pa0); SBA_PK4(p0, 8, pa1); SBA_PK4(p1, 0, pa2); SBA_PK4(p1, 8, pa3);
#undef SBA_PK4
}
}

__device__ __forceinline__ void p_sb_attn(const Ctx& F, const bf16_t* kvq, bf16_t* ao) {
    using namespace sba;
    LAS char* V_lds = (LAS char*)F.lds; LAS char* K_lds = V_lds + 2 * SHM_V;
    const int tid = F.tid, wid = F.wave, lane = F.lane, r32 = lane & 31, hi = lane >> 5;
    const int sr = tid >> 4, sc = (tid & 15) * 8, vst0 = v_st(sr, sc), vst1 = v_st(32 + sr, sc);
    const int vb0 = (int)(unsigned)(size_t)V_lds + v_rd_base(lane);
    const float hmask = hi ? 0.f : 1.f;
    const int vcu = (F.G % 8 == 0) ? (F.bid % 8) * (F.G / 8) + F.bid / 8 : F.bid;
    for (int unit = vcu; unit < BATCH * SBH * 4; unit += F.G) {
        const int p = unit & 3, bh = unit >> 2, b = bh / SBH, hh = bh % SBH;
        const bf16_t* Kh = kvq + (size_t)(b * SEQ) * KVQ + hh * HD; const bf16_t* Vh = Kh + SBDIM; const bf16_t* Qh = Kh + 2 * SBDIM;
        for (int side = 0; side < 2; ++side) {
            const int qb = side == 0 ? 7 - p : p;
            const int i0 = qb * 256 + wid * 32;
            bf16x8 qr[8];
            { const bf16_t* Qw = Qh + (size_t)(i0 + r32) * KVQ + hi * 8;
#pragma unroll
              for (int d0 = 0; d0 < 8; ++d0) qr[d0] = *(const bf16x8*)(Qw + d0 * 16); }
            f32x16 o[4] = {};
            float carry = 1.f;
            const int NT = 4 * qb + 4;
            bf16x8 vs0, vs1, ks0, ks1;
#define SBA_SLOAD(k0) do { vs0 = *(const bf16x8*)(Vh + (size_t)((k0) + sr) * KVQ + sc); vs1 = *(const bf16x8*)(Vh + (size_t)((k0) + 32 + sr) * KVQ + sc); \
    ks0 = *(const bf16x8*)(Kh + (size_t)((k0) + sr) * KVQ + sc); ks1 = *(const bf16x8*)(Kh + (size_t)((k0) + 32 + sr) * KVQ + sc); } while (0)
#define SBA_SWRITE(bf) do { *(LAS bf16x8*)(V_lds + (bf) * SHM_V + vst0) = vs0; *(LAS bf16x8*)(V_lds + (bf) * SHM_V + vst1) = vs1; const int kc = sc * 2; \
    *(LAS bf16x8*)(K_lds + (bf) * SHM_K + SBA_KSWZ(sr, kc)) = ks0; *(LAS bf16x8*)(K_lds + (bf) * SHM_K + SBA_KSWZ(32 + sr, kc)) = ks1; } while (0)
            __syncthreads();
            SBA_SLOAD((NT - 1) * 64); SBA_SWRITE(0);
            if (NT > 1) SBA_SLOAD((NT - 2) * 64);
            __syncthreads();
            for (int n = 0; n < NT; ++n) {
                const int kt = NT - 1 - n, buf = n & 1;
                if (n + 1 < NT) { SBA_SWRITE(buf ^ 1); if (n + 2 < NT) SBA_SLOAD((kt - 2) * 64); }
                if (64 * kt < i0 + 31) {
                    f32x16 p0, p1;
                    qkt(p0, p1, K_lds + buf * SHM_K, qr, r32, hi);
                    if (64 * kt + 63 >= i0) {
                        const int irow = i0 + r32;
#pragma unroll
                        for (int r = 0; r < 16; ++r) { const int j = 64 * kt + crow(r, hi); p0[r] = (j < irow) ? p0[r] : -1.0e30f; p1[r] = (j + 32 < irow) ? p1[r] : -1.0e30f; }
                    }
                    bf16x8 pa0, pa1, pa2, pa3;
                    sb_weights(p0, p1, carry, hmask, pa0, pa1, pa2, pa3);
                    const int vb = vb0 + buf * SHM_V;
                    pv_one<0>(o[0], vb, pa0, pa1, pa2, pa3); pv_one<1>(o[1], vb, pa0, pa1, pa2, pa3); pv_one<2>(o[2], vb, pa0, pa1, pa2, pa3); pv_one<3>(o[3], vb, pa0, pa1, pa2, pa3);
                }
                __syncthreads();
            }
#undef SBA_SLOAD
#undef SBA_SWRITE
            bf16_t* Ow = ao + (size_t)(b * SEQ + i0) * SBDIM + hh * HD;
#pragma unroll
            for (int r = 0; r < 16; ++r) { const int orow = crow(r, hi);
#pragma unroll
                for (int d0 = 0; d0 < 4; ++d0) Ow[(size_t)orow * SBDIM + d0 * 32 + r32] = (bf16_t)f2bf(o[d0][r]); }
        }
    }
}

constexpr int NPH = 18;
struct Args { const float* in[23]; float* out; unsigned char* ws; int ph_lo, ph_hi; };
__global__ void __launch_bounds__(512, 2) yoco_fwd(Args args) {
    extern __shared__ __attribute__((aligned(16))) unsigned char lds_raw[];
    Ctx F;
    F.lds = (LAS unsigned char*)lds_raw;
    F.tid = threadIdx.x; F.lane = F.tid & 63; F.wave = __builtin_amdgcn_readfirstlane(F.tid >> 6);
    F.G = gridDim.x; F.bid = blockIdx.x;
    unsigned char* ws = args.ws;
    const float* x = args.in[0];
    float* h = args.out;
    bf16_t* Win_t = (bf16_t*)(ws + WS_WIN); bf16_t* Wouta_t = (bf16_t*)(ws + WS_WOUTA); bf16_t* Wkvq_t = (bf16_t*)(ws + WS_WKVQ); bf16_t* Woutb_t = (bf16_t*)(ws + WS_WOUTB);
    bf16_t* Wgu_t = (bf16_t*)(ws + WS_WGU); bf16_t* Wd_t = (bf16_t*)(ws + WS_WD);
    bf16_t* XN = (bf16_t*)(ws + WS_XN); bf16_t* OG = (bf16_t*)(ws + WS_OG); bf16_t* PROJ = (bf16_t*)(ws + WS_BIG);
    bf16_t* XS = (bf16_t*)(ws + WS_XS); bf16_t* HB = (bf16_t*)(ws + WS_HB); bf16_t* YS = (bf16_t*)(ws + WS_YS);
    bf16_t* KVQB = (bf16_t*)(ws + WS_KVQ); bf16_t* AO = (bf16_t*)(ws + WS_AO);
    MoeBufs mb; mb.blk_cnt = (int*)(ws + WS_MISC + MI_BLKCNT); mb.pad_start = (int*)(ws + WS_MISC + MI_PADSTART); mb.tok_e = (int*)(ws + WS_MISC + MI_TOKE);
    mb.tok_w = (float*)(ws + WS_MISC + MI_TOKW); mb.tok_slot = (int*)(ws + WS_MISC + MI_TOKSLOT);

    for (int u = F.tid; u < (LDS_BYTES - LDSCTL_OFF) / 4; u += 512) ((LAS unsigned*)(F.lds + LDSCTL_OFF))[u] = 0u;
    __syncthreads();
    const int lo = args.ph_lo, hi = args.ph_hi;
    const bool multi = (hi - lo) > 1;
    XcdBarrier bar; bar.bar = (unsigned*)(ws + WS_CTL) + CW_BAR; bar.x = 0; bar.st = nullptr;
    if (multi) bar = xcd_barrier_post((unsigned*)(ws + WS_CTL) + CW_BAR, (volatile LAS unsigned*)(F.lds + LDSCTL_OFF));
#define IN(k) (lo <= (k) && (k) < hi)
#define SEAM(k) do { if (IN(k) && IN((k) + 1)) xcd_barrier(bar); } while (0)

    P0Args pa; pa.x = x; pa.norm_a = args.in[1]; pa.w_in = args.in[2]; pa.w_out_a = args.in[7]; pa.norm_kv = args.in[8]; pa.w_kv = args.in[9]; pa.norm_b = args.in[11]; pa.w_q = args.in[12];
    pa.w_out_b = args.in[14]; pa.w_gate = args.in[20]; pa.w_up = args.in[21]; pa.w_down = args.in[22]; pa.w_rg = args.in[16]; pa.w_re = args.in[18]; pa.WR = (float*)(ws + WS_WR);
    pa.Win_t = Win_t; pa.Wouta_t = Wouta_t; pa.Wkvq_t = Wkvq_t; pa.Woutb_t = Woutb_t; pa.Wgu_t = Wgu_t; pa.Wd_t = Wd_t; pa.XN = XN;
    if (IN(0)) { for (int rep = 0; rep < (MK_REP_PHASE == 0 ? 2 : 1); ++rep) p0_prologue(F, pa); }
    SEAM(0);
    if (IN(1)) {
        const int GG = F.G >= 128 ? F.G - 60 : F.G;
        if (F.bid < GG) {
            pg8::Gemm g{XN, Win_t, D}; pg8::StaticOrder S; S.init(T, GIN_PAD, GG, F.bid);
            pg8::EpiBf16 E{PROJ, GIN_PAD};
            pg8::gemm_phase<pg8::EpiBf16, pg8::StaticOrder>(F.lds, g, S, E);
            if (MK_REP_PHASE == 1) { __syncthreads(); pg8::gemm_phase<pg8::EpiBf16, pg8::StaticOrder>(F.lds, g, S, E); }
        }
        __syncthreads();
        p0_queue(F, pa, (unsigned*)(ws + WS_CTL) + CW_TICKET);
    }
    SEAM(1);
    if (IN(2)) { for (int rep = 0; rep < (MK_REP_PHASE == 2 ? 2 : 1); ++rep) p2_gdn(F, PROJ, args.in[3], args.in[4], args.in[5], args.in[6], OG); }
    SEAM(2);
    if (IN(3)) {
        pg8::Gemm g{OG, Wouta_t, GVDIM}; pg8::StaticOrder S; S.init(T, D, F.G, F.bid);
        pg8::EpiResF32 E{x, h, D};
        pg8::gemm_phase<pg8::EpiResF32, pg8::StaticOrder>(F.lds, g, S, E);
        if (MK_REP_PHASE == 3) { __syncthreads(); pg8::gemm_phase<pg8::EpiResF32, pg8::StaticOrder>(F.lds, g, S, E); }
    }
    SEAM(3);
#define MOE_PHASES(layer, pb, XNOUT) \
    if (IN(pb)) for (int rep = 0; rep < ((MK_REP_PHASE == 4 && (layer) == 0) ? 2 : 1); ++rep) p_moe_route(F, h, args.in[15] + (layer) * D, (const float*)(ws + WS_WR) + (size_t)(layer) * D * WRN, args.in[17] + (layer) * NGRP, args.in[19] + (layer) * NE, XN, mb); \
    do { if (IN(pb) && IN((pb) + 2)) xcd_barrier(bar); } while (0); \
    if (IN((pb) + 2)) { pg8::ListOrder S; LAS int* rowtok = (LAS int*)(F.lds + RING_BYTES + 8192); moe_gather_prep(F, mb, 2 * HID / 256, S, rowtok); \
        pg8::Gemm g{XN, Wgu_t + (size_t)(layer) * NE * 2 * HID * D, D}; pg8::EpiSwiGLU E{HB, HID}; \
        pg8::gemm_phase_gather<pg8::EpiSwiGLU, pg8::ListOrder>(F.lds, g, S, E, rowtok); } \
    SEAM((pb) + 2); \
    if (IN((pb) + 3)) { pg8::ListOrder S; moe_units(F, mb, D / 256, S); \
        pg8::Gemm g{HB, Wd_t + (size_t)(layer) * NE * D * HID, HID}; pg8::EpiBf16 E{YS, D}; \
        pg8::gemm_phase<pg8::EpiBf16, pg8::ListOrder>(F.lds, g, S, E); \
        if (MK_REP_PHASE == 7 && (layer) == 0) { __syncthreads(); pg8::gemm_phase<pg8::EpiBf16, pg8::ListOrder>(F.lds, g, S, E); } } \
    SEAM((pb) + 3); \
    if (IN((pb) + 4)) p_moe_combine(F, h, YS, mb, XNOUT);

    MOE_PHASES(0, 4, XN)
    SEAM(8);
    if (IN(9)) {
        pg8::Gemm g{XN, Wkvq_t, D}; pg8::StaticOrder S; S.init(T, KVQ, F.G, F.bid);
        pg8::EpiKvqNorm E{KVQB, args.in[10], args.in[13], (LAS float*)(F.lds + RING_BYTES)};
        pg8::gemm_phase<pg8::EpiKvqNorm, pg8::StaticOrder>(F.lds, g, S, E);
        if (MK_REP_PHASE == 9) { __syncthreads(); pg8::gemm_phase<pg8::EpiKvqNorm, pg8::StaticOrder>(F.lds, g, S, E); }
    }
    do { if (IN(9) && IN(11)) xcd_barrier(bar); } while (0);
    if (IN(11)) { for (int rep = 0; rep < (MK_REP_PHASE == 11 ? 2 : 1); ++rep) p_sb_attn(F, KVQB, AO); }
    SEAM(11);
    if (IN(12)) {
        pg8::Gemm g{AO, Woutb_t, SBDIM}; pg8::StaticOrder S; S.init(T, D, F.G, F.bid);
        pg8::EpiResF32 E{h, h, D};
        pg8::gemm_phase<pg8::EpiResF32, pg8::StaticOrder>(F.lds, g, S, E);
    }
    SEAM(12);
    MOE_PHASES(1, 13, (bf16_t*)nullptr)
#undef MOE_PHASES
#undef IN
#undef SEAM
}

extern "C" void kernel_launch(void* const* d_in, const int* in_sizes, int n_in, void* d_out, int out_size, void* d_ws, size_t ws_size, hipStream_t stream) {
    static int grid = 0;
    if (grid == 0) {
        if (n_in != 23 || out_size != T * D || ws_size < WS_END) { fprintf(stderr, "kernel_launch: unexpected shapes (n_in %d, out %d, ws %zu)\n", n_in, out_size, ws_size); grid = -1; return; }
        int dev = 0, cus = 0, per_cu = 0;
        if (hipGetDevice(&dev) != hipSuccess || hipDeviceGetAttribute(&cus, hipDeviceAttributeMultiprocessorCount, dev) != hipSuccess) { grid = -1; return; }
        if (hipFuncSetAttribute((const void*)yoco_fwd, hipFuncAttributeMaxDynamicSharedMemorySize, LDS_BYTES) != hipSuccess) { fprintf(stderr, "kernel_launch: hipFuncSetAttribute failed\n"); grid = -1; return; }
        if (hipOccupancyMaxActiveBlocksPerMultiprocessor(&per_cu, (const void*)yoco_fwd, 512, LDS_BYTES) != hipSuccess || per_cu < 1) fprintf(stderr, "kernel_launch: occupancy query reports %d\n", per_cu);
        (void)hipGetLastError();
        grid = cus;
        if (grid > 256) grid = 256;
    }
    if (grid < 0) return;
    (void)hipMemsetAsync((char*)d_ws + WS_CTL, 0, CTL_ZERO_BYTES, stream);
    Args a{};
    for (int i = 0; i < 23; ++i) a.in[i] = (const float*)d_in[i];
    a.out = (float*)d_out; a.ws = (unsigned char*)d_ws;
#if MK_ONE_LAUNCH
    a.ph_lo = 0; a.ph_hi = MK_LAST_PHASE;
    hipLaunchKernelGGL(yoco_fwd, dim3(grid), dim3(512), LDS_BYTES, stream, a);
#else
    for (int p = 0; p < MK_LAST_PHASE; ++p) { if (p == 10 || p == 5 || p == 14) continue; a.ph_lo = p; a.ph_hi = p + 1; hipLaunchKernelGGL(yoco_fwd, dim3(grid), dim3(512), LDS_BYTES, stream, a); }
#endif
}
```

```cpp
#include <hip/hip_runtime.h>
#include <cstdio>

#ifndef MK_ONE_LAUNCH
#define MK_ONE_LAUNCH 1
#endif
#ifndef MK_REP_PHASE
#define MK_REP_PHASE -1
#endif
#ifndef MK_LAST_PHASE
#define MK_LAST_PHASE 18
#endif

#define GAS __attribute__((address_space(1)))
#define LAS __attribute__((address_space(3)))
typedef unsigned short bf16_t;
typedef short bf16x8 __attribute__((ext_vector_type(8)));
typedef float f32x4 __attribute__((ext_vector_type(4)));
typedef float f32x2 __attribute__((ext_vector_type(2)));
typedef unsigned u32x4 __attribute__((ext_vector_type(4)));
typedef unsigned u32x2 __attribute__((ext_vector_type(2)));

constexpr int D = 2048, BATCH = 8, SEQ = 2048, T = BATCH * SEQ;
constexpr int HD = 128;
constexpr int GKH = 16, GVH = 32, GKDIM = 2048, GVDIM = 4096, GCONV = 8192, GIN = 12352, GIN_PAD = 12544;
constexpr int SBH = 16, SBDIM = 2048, KVQ = 6144;
constexpr int NGRP = 4, EPG = 8, NE = 32, HID = 768;
constexpr float EPS = 1e-6f;
constexpr int MAXSLOTS = T * 2 + NE * 256;

constexpr size_t MiB = 1u << 20;
constexpr size_t WS_CTL = 0, CTL_ZERO_BYTES = 1 * MiB;
constexpr size_t WS_MISC = 1 * MiB;
constexpr size_t WS_WIN = 2 * MiB, WS_WOUTA = 51 * MiB, WS_WKVQ = 67 * MiB, WS_WOUTB = 91 * MiB, WS_WGU = 99 * MiB, WS_WD = 483 * MiB;
constexpr size_t WS_XN = 675 * MiB, WS_OG = 739 * MiB, WS_BIG = 867 * MiB, WS_WR = 1259 * MiB, WS_END = 1260 * MiB;
constexpr int WRN = 48;
constexpr size_t WS_XS = WS_BIG, WS_HB = WS_BIG + 160 * MiB, WS_YS = WS_BIG + 220 * MiB;
constexpr size_t WS_KVQ = WS_BIG, WS_AO = WS_BIG + 192 * MiB;
static_assert((size_t)GIN_PAD * D * 2 <= 49 * MiB && (size_t)T * GIN_PAD * 2 <= 392 * MiB, "map");
static_assert((size_t)MAXSLOTS * D * 2 <= 160 * MiB && (size_t)MAXSLOTS * HID * 2 <= 60 * MiB, "map");
constexpr size_t MI_BLKCNT = 0, MI_PADSTART = 32768, MI_TOKE = 65536, MI_TOKW = 65536 + 131072, MI_TOKSLOT = 65536 + 262144;
constexpr int CW_BAR = 4096, CW_TICKET = 64;

constexpr int RING_BYTES = 131072;
constexpr int LDS_BYTES = 163840;
constexpr int LDSCTL_OFF = LDS_BYTES - 1024;

#define LDS_WAIT() asm volatile("s_waitcnt lgkmcnt(0)" ::: "memory")
#define VM_WAIT() asm volatile("s_waitcnt vmcnt(0)" ::: "memory")
__device__ __forceinline__ float bf2f(unsigned b) { return __uint_as_float(b << 16); }
__device__ __forceinline__ unsigned f2bf(float f) { unsigned u = __float_as_uint(f); return (u + 0x7fffu + ((u >> 16) & 1u)) >> 16; }
typedef __bf16 bf16v2_t __attribute__((ext_vector_type(2)));
__device__ __forceinline__ unsigned pk2(float lo, float hi) { bf16v2_t v = __builtin_convertvector((f32x2){lo, hi}, bf16v2_t); return __builtin_bit_cast(unsigned, v); }
__device__ __forceinline__ float wave_sum(float v) {
#pragma unroll
    for (int o = 1; o < 64; o <<= 1) v += __shfl_xor(v, o);
    return v;
}
__device__ __forceinline__ float silu_f(float x) { return x * __builtin_amdgcn_rcpf(1.0f + __builtin_amdgcn_exp2f(-1.4426950408889634f * x)); }
__device__ __forceinline__ float sigmoid_f(float x) { return __builtin_amdgcn_rcpf(1.0f + __builtin_amdgcn_exp2f(-1.4426950408889634f * x)); }
__device__ __forceinline__ float softplus_f(float x) { return fmaxf(x, 0.f) + __logf(1.0f + __expf(-fabsf(x))); }

#define XB_TMO      128
#define XB_XCNT(j)  (256  + 64 * (j))
#define XB_XSUB(j)  (1280 + 64 * (j))
#define XB_XGEN(j)  (2304 + 64 * (j))
#define XB_TOP      3328
#define XB_TOPGEN   3392
#define XCD_BAR_WORDS 3456
#define XB_SPIN_CAP (1u << 20)
__device__ __forceinline__ unsigned xb_ld(unsigned* p)              { return __hip_atomic_load(p, __ATOMIC_RELAXED, __HIP_MEMORY_SCOPE_AGENT); }
__device__ __forceinline__ unsigned xb_add(unsigned* p, unsigned v) { return __hip_atomic_fetch_add(p, v, __ATOMIC_RELAXED, __HIP_MEMORY_SCOPE_AGENT); }
__device__ __forceinline__ unsigned xb_xcc_id() { return (unsigned)__builtin_amdgcn_s_getreg((3 << 11) | 20) & 0xFu; }
#define XB_SPIN(cond, bar) do { unsigned _sp = 0; while (cond) { __builtin_amdgcn_s_sleep(1); \
    if ((++_sp & 255u) == 0u) { if (xb_ld(&(bar)[XB_TMO])) break; if (_sp > XB_SPIN_CAP) { atomicAdd(&(bar)[XB_TMO], 1u); break; } } } } while (0)
struct XcdBarrier { unsigned* bar; unsigned x; volatile LAS unsigned* st; };
__device__ __forceinline__ XcdBarrier xcd_barrier_post(unsigned* bar, volatile LAS unsigned* st) {
    XcdBarrier b; b.bar = bar; b.x = xb_xcc_id(); b.st = st;
    if (threadIdx.x == 0) (void)xb_add(&bar[XB_XCNT(b.x)], 1u);
    return b;
}
__device__ __forceinline__ void xcd_barrier_complete(unsigned* bar, unsigned x, unsigned& nloc, unsigned& nx) {
    const unsigned G = gridDim.x * gridDim.y * gridDim.z;
    unsigned sum, cnt, mine, sp = 0u;
    for (;;) {
        sum = 0u; cnt = 0u; mine = 0u;
#pragma unroll
        for (unsigned j = 0; j < 16; ++j) { const unsigned c = xb_ld(&bar[XB_XCNT(j)]); sum += c; cnt += (c > 0u) ? 1u : 0u; mine = (j == x) ? c : mine; }
        if (sum == G) break;
        __builtin_amdgcn_s_sleep(1);
        if ((++sp & 255u) == 0u) { if (xb_ld(&bar[XB_TMO])) break; if (sp > XB_SPIN_CAP) { atomicAdd(&bar[XB_TMO], 1u); break; } }
    }
    nloc = mine > 0u ? mine : 1u; nx = cnt > 0u ? cnt : 1u;
}
__device__ __forceinline__ void xcd_barrier(const XcdBarrier& b) {
    asm volatile("s_waitcnt vmcnt(0)" ::: "memory");
    __syncthreads();
    if (threadIdx.x == 0) {
        unsigned* bar = b.bar;
        __builtin_amdgcn_s_waitcnt(0);
        unsigned nloc = b.st[0], nx = b.st[1];
        if (nloc == 0u) { xcd_barrier_complete(bar, b.x, nloc, nx); b.st[0] = nloc; b.st[1] = nx; }
        const unsigned old = xb_add(&bar[XB_XSUB(b.x)], 1u);
        const unsigned gen = old / nloc;
        if (old + 1u == (gen + 1u) * nloc) {
            __builtin_amdgcn_fence(__ATOMIC_RELEASE, "agent");
            asm volatile("s_waitcnt vmcnt(0)" ::: "memory");
            const unsigned og = xb_add(&bar[XB_TOP], 1u);
            const unsigned tg = og / nx;
            if (og + 1u == (tg + 1u) * nx) xb_add(&bar[XB_TOPGEN], 1u);
            else XB_SPIN(xb_ld(&bar[XB_TOPGEN]) == tg, bar);
            __builtin_amdgcn_fence(__ATOMIC_ACQUIRE, "agent");
            xb_add(&bar[XB_XGEN(b.x)], 1u);
            asm volatile("s_waitcnt vmcnt(0)" ::: "memory");
        } else {
            XB_SPIN(xb_ld(&bar[XB_XGEN(b.x)]) == gen, bar);
            __builtin_amdgcn_fence(__ATOMIC_ACQUIRE, "agent");
            asm volatile("s_waitcnt vmcnt(0)" ::: "memory");
        }
    }
    __syncthreads();
}

namespace pg8 {
constexpr int BM = 256, BK = 64, HALF = 128, HTB = HALF * BK * 2, STAGE_BYTES = 8 * HTB, NXCD = 8, WGM = 8;
__host__ __device__ __forceinline__ int lds_byte(int r, int c) { const int st = (r >> 4) * 2 + (c >> 5), rr = r & 15, cc = c & 31, ob = rr * 64 + cc * 2; return st * 1024 + (ob ^ (((ob >> 9) & 1) << 5)); }
__host__ __device__ __forceinline__ void stage_rc(int b, int& R, int& C) { const int st = b / 1024, sb = b % 1024, swz = sb ^ (((sb >> 9) & 1) << 5); R = (st >> 1) * 16 + swz / 64; C = (st & 1) * 32 + (swz % 64) / 2; }
__host__ __device__ __forceinline__ int perm32(int rho) { const int n = rho >> 4, i = rho & 15; return 8 * (i >> 2) + 4 * n + (i & 3); }

struct Unit { int pm, pn, pb; };
struct Gemm { const bf16_t* A; const bf16_t* Bt; int K; };

struct StaticOrder {
    int nM, nN, nwg, G, c;
    __device__ void init(int M, int N, int G_, int c_) { nM = M / BM; nN = N / BM; nwg = nM * nN; G = G_; c = c_; }
    __device__ bool next(int i, Unit& u) const {
        const long L = (long)i * G + c; if (L >= nwg) return false;
        int wgid = (int)L; { const int q = nwg / NXCD, r = nwg % NXCD, xcd = wgid % NXCD, off = wgid / NXCD; wgid = (xcd < r ? xcd * (q + 1) : r * (q + 1) + (xcd - r) * q) + off; }
        const int nig = WGM * nN, gid = wgid / nig, fm = gid * WGM, gsz = (nM - fm) < WGM ? (nM - fm) : WGM;
        u.pm = fm + ((wgid % nig) % gsz); u.pn = (wgid % nig) / gsz; u.pb = u.pn; return true;
    }
};
struct ListOrder {
    int n, d0, d1, d2, d3, d4, d5, d6, d7;
    __device__ bool next(int i, Unit& u) const {
        if (i >= n) return false;
        const int d = i == 0 ? d0 : i == 1 ? d1 : i == 2 ? d2 : i == 3 ? d3 : i == 4 ? d4 : i == 5 ? d5 : i == 6 ? d6 : d7;
        u.pm = d & 0xfff; u.pn = (d >> 12) & 0xf; u.pb = d >> 16; return true;
    }
};

__device__ __forceinline__ unsigned cvt_pk_bf16(float lo, float hi) { return pk2(lo, hi); }

struct EpiBf16 {
    static constexpr bool PERM = true;
    bf16_t* O; int ldc;
    __device__ __forceinline__ void operator()(const f32x4 (&acc)[2][2][4][2], const Unit& u, int wr, int wc, int fr, int fq) const {
        const int row0 = u.pm * BM + wr * 64 + fr, col0 = u.pn * BM + wc * 32 + 8 * fq;
#pragma unroll
        for (int ai = 0; ai < 2; ++ai)
#pragma unroll
            for (int m = 0; m < 4; ++m) { bf16_t* rowp = O + (size_t)(row0 + ai * HALF + m * 16) * ldc + col0;
#pragma unroll
                for (int bj = 0; bj < 2; ++bj) { const f32x4 v0 = acc[ai][bj][m][0], v1 = acc[ai][bj][m][1];
                    u32x4 w; w.x = cvt_pk_bf16(v0[0], v0[1]); w.y = cvt_pk_bf16(v0[2], v0[3]); w.z = cvt_pk_bf16(v1[0], v1[1]); w.w = cvt_pk_bf16(v1[2], v1[3]);
                    *(u32x4*)(rowp + bj * HALF) = w; } }
    }
};
struct EpiKvqNorm {
    static constexpr bool PERM = true;
    bf16_t* O; const float* k_gain; const float* q_gain; LAS float* xch;
    __device__ __forceinline__ void operator()(const f32x4 (&acc)[2][2][4][2], const Unit& u, int wr, int wc, int fr, int fq) const {
        const int row0 = u.pm * BM + wr * 64 + fr, col0 = u.pn * BM + wc * 32 + 8 * fq;
        const bool isk = u.pn < 8, isq = u.pn >= 16;
        float rs[2][4][2];
        if (isk || isq) {
#pragma unroll
            for (int ai = 0; ai < 2; ++ai)
#pragma unroll
                for (int m = 0; m < 4; ++m)
#pragma unroll
                    for (int bj = 0; bj < 2; ++bj) { const f32x4 a = acc[ai][bj][m][0], b = acc[ai][bj][m][1];
                        float s = (a[0] * a[0] + a[1] * a[1]) + (a[2] * a[2] + a[3] * a[3]) + (b[0] * b[0] + b[1] * b[1]) + (b[2] * b[2] + b[3] * b[3]);
                        s += __shfl_xor(s, 16); s += __shfl_xor(s, 32);
                        if (fq == 0) xch[((ai * HALF + wr * 64 + m * 16 + fr) * 2 + bj) * 4 + wc] = s; }
            asm volatile("s_waitcnt lgkmcnt(0)" ::: "memory"); __builtin_amdgcn_s_barrier(); asm volatile("" ::: "memory");
            const float* g = isk ? k_gain : q_gain; const float qs = isq ? 0.12751743082459868f : 1.0f;
#pragma unroll
            for (int ai = 0; ai < 2; ++ai)
#pragma unroll
                for (int m = 0; m < 4; ++m)
#pragma unroll
                    for (int bj = 0; bj < 2; ++bj) { const f32x4 p = *(const LAS f32x4*)(xch + ((ai * HALF + wr * 64 + m * 16 + fr) * 2 + bj) * 4);
                        rs[ai][m][bj] = qs / sqrtf(((p[0] + p[1]) + (p[2] + p[3])) * (1.f / HD) + EPS); }
        }
        f32x4 g0 = {1.f, 1.f, 1.f, 1.f}, g1 = g0;
        if (isk || isq) { const float* g = isk ? k_gain : q_gain; g0 = *(const f32x4*)(g + wc * 32 + 8 * fq); g1 = *(const f32x4*)(g + wc * 32 + 8 * fq + 4); }
#pragma unroll
        for (int ai = 0; ai < 2; ++ai)
#pragma unroll
            for (int m = 0; m < 4; ++m) { bf16_t* rowp = O + (size_t)(row0 + ai * HALF + m * 16) * KVQ + col0;
#pragma unroll
                for (int bj = 0; bj < 2; ++bj) { f32x4 v0 = acc[ai][bj][m][0], v1 = acc[ai][bj][m][1];
                    if (isk || isq) { const float r = rs[ai][m][bj]; v0 = v0 * r * g0; v1 = v1 * r * g1; }
                    u32x4 w; w.x = cvt_pk_bf16(v0[0], v0[1]); w.y = cvt_pk_bf16(v0[2], v0[3]); w.z = cvt_pk_bf16(v1[0], v1[1]); w.w = cvt_pk_bf16(v1[2], v1[3]);
                    *(u32x4*)(rowp + bj * HALF) = w; } }
    }
};
struct EpiResF32 {
    static constexpr bool PERM = false;
    const float* base; float* out; int ldc;
    __device__ __forceinline__ void operator()(const f32x4 (&acc)[2][2][4][2], const Unit& u, int wr, int wc, int fr, int fq) const {
        const int row0 = u.pm * BM + wr * 64 + fr, col0 = u.pn * BM + wc * 32 + 4 * fq;
        const float* __restrict__ bp = base; float* __restrict__ op = out;
#pragma unroll
        for (int ai = 0; ai < 2; ++ai)
#pragma unroll
            for (int mp = 0; mp < 2; ++mp) {
                f32x4 b[2][2][2];
#pragma unroll
                for (int mm = 0; mm < 2; ++mm) { const size_t ro = (size_t)(row0 + ai * HALF + (2 * mp + mm) * 16) * ldc + col0;
#pragma unroll
                    for (int bj = 0; bj < 2; ++bj)
#pragma unroll
                        for (int n = 0; n < 2; ++n) b[mm][bj][n] = *(const f32x4*)(bp + ro + bj * HALF + n * 16); }
#pragma unroll
                for (int mm = 0; mm < 2; ++mm) { const size_t ro = (size_t)(row0 + ai * HALF + (2 * mp + mm) * 16) * ldc + col0;
#pragma unroll
                    for (int bj = 0; bj < 2; ++bj)
#pragma unroll
                        for (int n = 0; n < 2; ++n) *(f32x4*)(op + ro + bj * HALF + n * 16) = acc[ai][bj][2 * mp + mm][n] + b[mm][bj][n]; }
            }
    }
};
struct EpiSwiGLU {
    static constexpr bool PERM = true;
    bf16_t* O; int ldc;
    __device__ __forceinline__ void operator()(const f32x4 (&acc)[2][2][4][2], const Unit& u, int wr, int wc, int fr, int fq) const {
        const int row0 = u.pm * BM + wr * 64 + fr, col0 = u.pn * HALF + wc * 32 + 8 * fq;
#pragma unroll
        for (int ai = 0; ai < 2; ++ai)
#pragma unroll
            for (int m = 0; m < 4; ++m) { bf16_t* rowp = O + (size_t)(row0 + ai * HALF + m * 16) * ldc + col0;
                float h[8];
#pragma unroll
                for (int n = 0; n < 2; ++n)
#pragma unroll
                    for (int j = 0; j < 4; ++j) { const float g = acc[ai][0][m][n][j], up = acc[ai][1][m][n][j]; h[n * 4 + j] = g * __builtin_amdgcn_rcpf(1.0f + __expf(-g)) * up; }
                u32x4 w; w.x = cvt_pk_bf16(h[0], h[1]); w.y = cvt_pk_bf16(h[2], h[3]); w.z = cvt_pk_bf16(h[4], h[5]); w.w = cvt_pk_bf16(h[6], h[7]);
                *(u32x4*)rowp = w; }
    }
};

template <class Epi, class Sched>
__device__ __forceinline__ void gemm_phase(LAS unsigned char* lds, const Gemm g, const Sched& S, const Epi& E) {
    const int tid = threadIdx.x, wid = __builtin_amdgcn_readfirstlane(tid >> 6), lane = tid & 63, wr = wid >> 2, wc = wid & 3, fr = lane & 15, fq = lane >> 4;
    const int K = g.K, nt = K / BK;
    unsigned voffA[2], voffB[2];
#pragma unroll
    for (int i = 0; i < 2; ++i) { int R, C; stage_rc(tid * 16 + i * 8192, R, C); const int Rb = Epi::PERM ? ((R & ~31) + perm32(R & 31)) : R;
        voffA[i] = (unsigned)(R * K + C) * 2u; voffB[i] = (unsigned)(Rb * K + C) * 2u; }
    const size_t kstep = (size_t)(BK * 2);
    const size_t hstep = (size_t)HALF * K * 2;
    const size_t tstep = 2 * hstep;
    const unsigned ldsw = (unsigned)wid * 1024u;
    const int aoff = lds_byte(wr * 64 + fr, fq * 8), boff = lds_byte(wc * 32 + fr, fq * 8);
#define PG8_SA(b, h) (((b) * 2 + (h)) * HTB)
#define PG8_SB(b, h) ((4 + (b) * 2 + (h)) * HTB)
#define PG8_STAGE(bufoff, gbase, voff) do { _Pragma("unroll") for (int _i = 0; _i < 2; ++_i) \
        __builtin_amdgcn_global_load_lds((const unsigned*)((const char*)(gbase) + (voff)[_i]), (LAS unsigned*)(lds + (bufoff) + ldsw + _i * 8192), 16, 0, 0); } while (0)
#define PG8_LDA(dst, b, h) do { _Pragma("unroll") for (int m = 0; m < 4; ++m) _Pragma("unroll") for (int k = 0; k < 2; ++k) dst[m][k] = *(const LAS bf16x8*)(lds + PG8_SA(b, h) + aoff + m * 2048 + k * 1024); } while (0)
#define PG8_LDB(dst, b, h) do { _Pragma("unroll") for (int n = 0; n < 2; ++n) _Pragma("unroll") for (int k = 0; k < 2; ++k) dst[n][k] = *(const LAS bf16x8*)(lds + PG8_SB(b, h) + boff + n * 2048 + k * 1024); } while (0)
#define PG8_MMA(ai, bj, At, Bt) do { __builtin_amdgcn_s_setprio(1); _Pragma("unroll") for (int m = 0; m < 4; ++m) _Pragma("unroll") for (int n = 0; n < 2; ++n) _Pragma("unroll") for (int k = 0; k < 2; ++k) \
        acc[ai][bj][m][n] = __builtin_amdgcn_mfma_f32_16x16x32_bf16(Bt[n][k], At[m][k], acc[ai][bj][m][n], 0, 0, 0); __builtin_amdgcn_s_setprio(0); } while (0)
#define PG8_WAIT_V(n) asm volatile("s_waitcnt vmcnt(" #n ")" ::: "memory")
#define PG8_WAIT_L(n) asm volatile("s_waitcnt lgkmcnt(" #n ")" ::: "memory")
#define PG8_BAR __builtin_amdgcn_s_barrier()
#define PG8_SCHED __builtin_amdgcn_sched_barrier(0)
    Unit cur, nxt; int ui = 0;
    if (!S.next(0, cur)) return;
    f32x4 acc[2][2][4][2];
#pragma unroll
    for (int a = 0; a < 2; ++a)
#pragma unroll
        for (int b = 0; b < 2; ++b)
#pragma unroll
            for (int m = 0; m < 4; ++m)
#pragma unroll
                for (int n = 0; n < 2; ++n) acc[a][b][m][n] = (f32x4){0.f, 0.f, 0.f, 0.f};
    bf16x8 At[4][2], B0[2][2], B1[2][2];
    const char* cA = (const char*)g.A + (size_t)cur.pm * tstep; const char* cB = (const char*)g.Bt + (size_t)cur.pb * tstep;
    PG8_STAGE(PG8_SB(0, 0), cB, voffB); PG8_STAGE(PG8_SA(0, 0), cA, voffA); PG8_STAGE(PG8_SB(0, 1), cB + hstep, voffB); PG8_STAGE(PG8_SA(0, 1), cA + hstep, voffA);
    if (wr == 1) PG8_BAR;
    PG8_WAIT_V(4); PG8_BAR;
    PG8_STAGE(PG8_SB(1, 0), cB + kstep, voffB); PG8_STAGE(PG8_SA(1, 0), cA + kstep, voffA); PG8_STAGE(PG8_SB(1, 1), cB + hstep + kstep, voffB);
    PG8_WAIT_V(6); PG8_BAR;
    for (;;) {
        const bool has_next = S.next(ui + 1, nxt);
        const char* nA = has_next ? (const char*)g.A + (size_t)nxt.pm * tstep : cA; const char* nB = has_next ? (const char*)g.Bt + (size_t)nxt.pb * tstep : cB;
        for (int t = 0; t < nt; t += 2) {
            const bool last = (t == nt - 2);
            const char* a1 = cA + (size_t)(t + 1) * kstep;
            const char* a2 = last ? nA : cA + (size_t)(t + 2) * kstep; const char* b2 = last ? nB : cB + (size_t)(t + 2) * kstep;
            const char* a3 = a2 + kstep; const char* b3 = b2 + kstep;
            PG8_LDB(B0, 0, 0); PG8_SCHED; PG8_LDA(At, 0, 0); PG8_STAGE(PG8_SA(1, 1), a1 + hstep, voffA);
            PG8_WAIT_L(8); PG8_BAR; PG8_WAIT_L(0); PG8_MMA(0, 0, At, B0); PG8_BAR; PG8_SCHED;
            PG8_LDB(B1, 0, 1); PG8_STAGE(PG8_SB(0, 0), b2, voffB);
            PG8_BAR; PG8_WAIT_L(0); PG8_MMA(0, 1, At, B1); PG8_BAR;
            PG8_LDA(At, 0, 1); PG8_STAGE(PG8_SA(0, 0), a2, voffA);
            PG8_BAR; PG8_WAIT_L(0); PG8_MMA(1, 0, At, B0); PG8_BAR; PG8_SCHED;
            PG8_STAGE(PG8_SB(0, 1), b2 + hstep, voffB);
            PG8_WAIT_V(6); PG8_BAR; PG8_MMA(1, 1, At, B1); PG8_BAR;
            PG8_LDB(B0, 1, 0); PG8_SCHED; PG8_LDA(At, 1, 0); PG8_STAGE(PG8_SA(0, 1), a2 + hstep, voffA);
            PG8_WAIT_L(8); PG8_BAR; PG8_WAIT_L(0); PG8_MMA(0, 0, At, B0); PG8_BAR; PG8_SCHED;
            PG8_LDB(B1, 1, 1); PG8_STAGE(PG8_SB(1, 0), b3, voffB);
            PG8_BAR; PG8_WAIT_L(0); PG8_MMA(0, 1, At, B1); PG8_BAR;
            PG8_LDA(At, 1, 1); PG8_STAGE(PG8_SA(1, 0), a3, voffA);
            PG8_BAR; PG8_WAIT_L(0); PG8_MMA(1, 0, At, B0); PG8_BAR; PG8_SCHED;
            PG8_STAGE(PG8_SB(1, 1), b3 + hstep, voffB);
            PG8_WAIT_V(6); PG8_BAR; PG8_MMA(1, 1, At, B1); PG8_BAR;
        }
        E(acc, cur, wr, wc, fr, fq);
        if (!has_next) break;
#pragma unroll
        for (int a = 0; a < 2; ++a)
#pragma unroll
            for (int b = 0; b < 2; ++b)
#pragma unroll
                for (int m = 0; m < 4; ++m)
#pragma unroll
                    for (int n = 0; n < 2; ++n) acc[a][b][m][n] = (f32x4){0.f, 0.f, 0.f, 0.f};
        cur = nxt; cA = nA; cB = nB; ++ui;
    }
    PG8_WAIT_V(0);
    if (wr == 0) PG8_BAR;
    PG8_BAR;
#undef PG8_SA
#undef PG8_SB
#undef PG8_STAGE
#undef PG8_LDA
#undef PG8_LDB
#undef PG8_MMA
#undef PG8_WAIT_V
#undef PG8_WAIT_L
#undef PG8_BAR
#undef PG8_SCHED
}
template <class Epi, class Sched>
__device__ __forceinline__ void gemm_phase_gather(LAS unsigned char* lds, const Gemm g, const Sched& S, const Epi& E, const LAS int* rowtok) {
    const int tid = threadIdx.x, wid = __builtin_amdgcn_readfirstlane(tid >> 6), lane = tid & 63, wr = wid >> 2, wc = wid & 3, fr = lane & 15, fq = lane >> 4;
    const int K = g.K, nt = K / BK;
    unsigned voffB[2]; unsigned cofA[2]; int rofA[2];
#pragma unroll
    for (int i = 0; i < 2; ++i) { int R, C; stage_rc(tid * 16 + i * 8192, R, C); const int Rb = Epi::PERM ? ((R & ~31) + perm32(R & 31)) : R;
        cofA[i] = (unsigned)C * 2u; rofA[i] = R; voffB[i] = (unsigned)(Rb * K + C) * 2u; }
    unsigned ga[2][2], gn[2][2];
#define PG8_ROWS(dst, u_) do { _Pragma("unroll") for (int h_ = 0; h_ < 2; ++h_) _Pragma("unroll") for (int i_ = 0; i_ < 2; ++i_) \
        dst[h_][i_] = (unsigned)rowtok[(u_) * 256 + h_ * HALF + rofA[i_]] * (unsigned)(K * 2) + cofA[i_]; } while (0)
    const size_t kstep = (size_t)(BK * 2);
    const size_t hstep = (size_t)HALF * K * 2;
    const size_t tstep = 2 * hstep;
    const unsigned ldsw = (unsigned)wid * 1024u;
    const int aoff = lds_byte(wr * 64 + fr, fq * 8), boff = lds_byte(wc * 32 + fr, fq * 8);
#define PG8_SA(b, h) (((b) * 2 + (h)) * HTB)
#define PG8_SB(b, h) ((4 + (b) * 2 + (h)) * HTB)
#define PG8_STAGE(bufoff, gbase, voff) do { _Pragma("unroll") for (int _i = 0; _i < 2; ++_i) \
        __builtin_amdgcn_global_load_lds((const unsigned*)((const char*)(gbase) + (voff)[_i]), (LAS unsigned*)(lds + (bufoff) + ldsw + _i * 8192), 16, 0, 0); } while (0)
#define PG8_LDA(dst, b, h) do { _Pragma("unroll") for (int m = 0; m < 4; ++m) _Pragma("unroll") for (int k = 0; k < 2; ++k) dst[m][k] = *(const LAS bf16x8*)(lds + PG8_SA(b, h) + aoff + m * 2048 + k * 1024); } while (0)
#define PG8_LDB(dst, b, h) do { _Pragma("unroll") for (int n = 0; n < 2; ++n) _Pragma("unroll") for (int k = 0; k < 2; ++k) dst[n][k] = *(const LAS bf16x8*)(lds + PG8_SB(b, h) + boff + n * 2048 + k * 1024); } while (0)
#define PG8_MMA(ai, bj, At, Bt) do { __builtin_amdgcn_s_setprio(1); _Pragma("unroll") for (int m = 0; m < 4; ++m) _Pragma("unroll") for (int n = 0; n < 2; ++n) _Pragma("unroll") for (int k = 0; k < 2; ++k) \
        acc[ai][bj][m][n] = __builtin_amdgcn_mfma_f32_16x16x32_bf16(Bt[n][k], At[m][k], acc[ai][bj][m][n], 0, 0, 0); __builtin_amdgcn_s_setprio(0); } while (0)
#define PG8_WAIT_V(n) asm volatile("s_waitcnt vmcnt(" #n ")" ::: "memory")
#define PG8_WAIT_L(n) asm volatile("s_waitcnt lgkmcnt(" #n ")" ::: "memory")
#define PG8_BAR __builtin_amdgcn_s_barrier()
#define PG8_SCHED __builtin_amdgcn_sched_barrier(0)
    Unit cur, nxt; int ui = 0;
    if (!S.next(0, cur)) return;
    f32x4 acc[2][2][4][2];
#pragma unroll
    for (int a = 0; a < 2; ++a)
#pragma unroll
        for (int b = 0; b < 2; ++b)
#pragma unroll
            for (int m = 0; m < 4; ++m)
#pragma unroll
                for (int n = 0; n < 2; ++n) acc[a][b][m][n] = (f32x4){0.f, 0.f, 0.f, 0.f};
    bf16x8 At[4][2], B0[2][2], B1[2][2];
    const char* cA = (const char*)g.A; const char* cB = (const char*)g.Bt + (size_t)cur.pb * tstep;
    PG8_ROWS(ga, 0);
    PG8_STAGE(PG8_SB(0, 0), cB, voffB); PG8_STAGE(PG8_SA(0, 0), cA, ga[0]); PG8_STAGE(PG8_SB(0, 1), cB + hstep, voffB); PG8_STAGE(PG8_SA(0, 1), cA, ga[1]);
    if (wr == 1) PG8_BAR;
    PG8_WAIT_V(4); PG8_BAR;
    PG8_STAGE(PG8_SB(1, 0), cB + kstep, voffB); PG8_STAGE(PG8_SA(1, 0), cA + kstep, ga[0]); PG8_STAGE(PG8_SB(1, 1), cB + hstep + kstep, voffB);
    PG8_WAIT_V(6); PG8_BAR;
    for (;;) {
        const bool has_next = S.next(ui + 1, nxt);
        const char* nB = has_next ? (const char*)g.Bt + (size_t)nxt.pb * tstep : cB;
        if (has_next) PG8_ROWS(gn, ui + 1); else { gn[0][0] = ga[0][0]; gn[0][1] = ga[0][1]; gn[1][0] = ga[1][0]; gn[1][1] = ga[1][1]; }
        for (int t = 0; t < nt; t += 2) {
            const bool last = (t == nt - 2);
            const char* a1 = cA + (size_t)(t + 1) * kstep;
            const char* a2 = last ? cA : cA + (size_t)(t + 2) * kstep; const char* b2 = last ? nB : cB + (size_t)(t + 2) * kstep;
            unsigned o2[2][2];
            _Pragma("unroll") for (int h_ = 0; h_ < 2; ++h_) _Pragma("unroll") for (int i_ = 0; i_ < 2; ++i_) o2[h_][i_] = last ? gn[h_][i_] : ga[h_][i_];
            const char* a3 = a2 + kstep; const char* b3 = b2 + kstep;
            PG8_LDB(B0, 0, 0); PG8_SCHED; PG8_LDA(At, 0, 0); PG8_STAGE(PG8_SA(1, 1), a1, ga[1]);
            PG8_WAIT_L(8); PG8_BAR; PG8_WAIT_L(0); PG8_MMA(0, 0, At, B0); PG8_BAR; PG8_SCHED;
            PG8_LDB(B1, 0, 1); PG8_STAGE(PG8_SB(0, 0), b2, voffB);
            PG8_BAR; PG8_WAIT_L(0); PG8_MMA(0, 1, At, B1); PG8_BAR;
            PG8_LDA(At, 0, 1); PG8_STAGE(PG8_SA(0, 0), a2, o2[0]);
            PG8_BAR; PG8_WAIT_L(0); PG8_MMA(1, 0, At, B0); PG8_BAR; PG8_SCHED;
            PG8_STAGE(PG8_SB(0, 1), b2 + hstep, voffB);
            PG8_WAIT_V(6); PG8_BAR; PG8_MMA(1, 1, At, B1); PG8_BAR;
            PG8_LDB(B0, 1, 0); PG8_SCHED; PG8_LDA(At, 1, 0); PG8_STAGE(PG8_SA(0, 1), a2, o2[1]);
            PG8_WAIT_L(8); PG8_BAR; PG8_WAIT_L(0); PG8_MMA(0, 0, At, B0); PG8_BAR; PG8_SCHED;
            PG8_LDB(B1, 1, 1); PG8_STAGE(PG8_SB(1, 0), b3, voffB);
            PG8_BAR; PG8_WAIT_L(0); PG8_MMA(0, 1, At, B1); PG8_BAR;
            PG8_LDA(At, 1, 1); PG8_STAGE(PG8_SA(1, 0), a3, o2[0]);
            PG8_BAR; PG8_WAIT_L(0); PG8_MMA(1, 0, At, B0); PG8_BAR; PG8_SCHED;
            PG8_STAGE(PG8_SB(1, 1), b3 + hstep, voffB);
            PG8_WAIT_V(6); PG8_BAR; PG8_MMA(1, 1, At, B1); PG8_BAR;
        }
        E(acc, cur, wr, wc, fr, fq);
        if (!has_next) break;
#pragma unroll
        for (int a = 0; a < 2; ++a)
#pragma unroll
            for (int b = 0; b < 2; ++b)
#pragma unroll
                for (int m = 0; m < 4; ++m)
#pragma unroll
                    for (int n = 0; n < 2; ++n) acc[a][b][m][n] = (f32x4){0.f, 0.f, 0.f, 0.f};
        cur = nxt; cB = nB; ++ui; ga[0][0] = gn[0][0]; ga[0][1] = gn[0][1]; ga[1][0] = gn[1][0]; ga[1][1] = gn[1][1];
    }
    PG8_WAIT_V(0);
    if (wr == 0) PG8_BAR;
    PG8_BAR;
#undef PG8_SA
#undef PG8_SB
#undef PG8_STAGE
#undef PG8_ROWS
#undef PG8_LDA
#undef PG8_LDB
#undef PG8_MMA
#undef PG8_WAIT_V
#undef PG8_WAIT_L
#undef PG8_BAR
#undef PG8_SCHED
}
}

struct Ctx {
    LAS unsigned char* lds;
    int tid, lane, wave, G, bid;
};

struct TrItem { const float* W; int N, k0, n0; bf16_t* WT; int ldk, drow0; const float* gain; };
template <bool NT>
__device__ __forceinline__ void tr_load(const TrItem& d, f32x4 (&v)[8], int lane) {
#pragma unroll
    for (int i = 0; i < 8; ++i) { const int kk = 8 * i + (lane >> 3); const f32x4* p = (const f32x4*)&d.W[(size_t)(d.k0 + kk) * d.N + d.n0 + 4 * (lane & 7)]; v[i] = NT ? __builtin_nontemporal_load(p) : *p; }
}
template <bool NT>
__device__ __forceinline__ void tr_finish(const TrItem& d, f32x4 (&v)[8], LAS float* scr, int lane) {
    if (d.gain) {
#pragma unroll
        for (int i = 0; i < 8; ++i) v[i] *= d.gain[d.k0 + 8 * i + (lane >> 3)];
    }
#pragma unroll
    for (int i = 0; i < 8; ++i) { LAS float* s = scr + (8 * i + (lane >> 3)) * 33 + 4 * (lane & 7); s[0] = v[i].x; s[1] = v[i].y; s[2] = v[i].z; s[3] = v[i].w; }
    LDS_WAIT(); asm volatile("" ::: "memory");
    const int c = lane & 7;
#pragma unroll
    for (int j = 0; j < 4; ++j) { const int n = (lane >> 3) + 8 * j; const LAS float* s = scr + (8 * c) * 33 + n;
        u32x4 o; o.x = pk2(s[0 * 33], s[1 * 33]); o.y = pk2(s[2 * 33], s[3 * 33]); o.z = pk2(s[4 * 33], s[5 * 33]); o.w = pk2(s[6 * 33], s[7 * 33]);
        u32x4* dp = (u32x4*)(d.WT + (size_t)(d.drow0 + n) * d.ldk + d.k0 + 8 * c); if (NT) __builtin_nontemporal_store(o, dp); else *dp = o; }
    LDS_WAIT(); asm volatile("" ::: "memory");
}
__device__ __forceinline__ void rms_row_to_bf16(const float* xrow, const f32x4 (&gv)[8], bf16_t* orow, int lane) {
    const f32x4* xr = (const f32x4*)xrow + 2 * lane;
    f32x4 v[8]; float s = 0.f;
#pragma unroll
    for (int j = 0; j < 8; ++j) { v[j] = xr[128 * (j >> 1) + (j & 1)]; s += (v[j].x * v[j].x + v[j].y * v[j].y) + (v[j].z * v[j].z + v[j].w * v[j].w); }
    const float r = 1.0f / sqrtf(wave_sum(s) * (1.f / D) + EPS);
    u32x4* o16 = (u32x4*)orow + lane;
#pragma unroll
    for (int j = 0; j < 4; ++j) {
        const f32x4 a = v[2 * j] * r * gv[2 * j], b = v[2 * j + 1] * r * gv[2 * j + 1];
        o16[64 * j] = (u32x4){pk2(a.x, a.y), pk2(a.z, a.w), pk2(b.x, b.y), pk2(b.z, b.w)}; }
}

struct P0Args { const float *x, *norm_a, *w_in, *w_out_a, *norm_kv, *w_kv, *norm_b, *w_q, *w_out_b, *w_gate, *w_up, *w_down, *w_rg, *w_re; float* WR;
                bf16_t *Win_t, *Wouta_t, *Wkvq_t, *Woutb_t, *Wgu_t, *Wd_t, *XN; };
constexpr int I_IN = 32 * (GIN / 32), I_OA = 64 * 64, I_KV = 32 * 128, I_Q = 32 * 64, I_OB = 32 * 64, I_G1 = 32 * 24, I_D1 = 12 * 64;
constexpr int I_G = 64 * I_G1, I_DN = 64 * I_D1;
constexpr int NITEMS = I_IN + I_OA + I_KV + I_Q + I_OB + 2 * I_G + I_DN;
__device__ __forceinline__ TrItem p0_desc(const P0Args& a, int it) {
    int r = it;
    if (r < I_IN) { const int nnb = GIN / 32, kb = r / nnb, nb = r % nnb; return TrItem{a.w_in, GIN, 64 * kb, 32 * nb, a.Win_t, D, 32 * nb, nullptr}; } r -= I_IN;
    if (r < I_OA) { const int kb = r / 64, nb = r % 64; return TrItem{a.w_out_a, D, 64 * kb, 32 * nb, a.Wouta_t, GVDIM, 32 * nb, nullptr}; } r -= I_OA;
    if (r < I_KV) { const int kb = r / 128, nb = r % 128; return TrItem{a.w_kv, 2 * SBDIM, 64 * kb, 32 * nb, a.Wkvq_t, D, 32 * nb, a.norm_kv}; } r -= I_KV;
    if (r < I_Q) { const int kb = r / 64, nb = r % 64; return TrItem{a.w_q, SBDIM, 64 * kb, 32 * nb, a.Wkvq_t, D, 2 * SBDIM + 32 * nb, a.norm_b}; } r -= I_Q;
    if (r < I_OB) { const int kb = r / 64, nb = r % 64; return TrItem{a.w_out_b, D, 64 * kb, 32 * nb, a.Woutb_t, SBDIM, 32 * nb, nullptr}; } r -= I_OB;
    if (r < I_G) { const int mi = r / I_G1, q = r % I_G1, kb = q / 24, nb = q % 24, n0 = 32 * nb;
        return TrItem{a.w_gate + (size_t)mi * D * HID, HID, 64 * kb, n0, a.Wgu_t + (size_t)mi * 2 * HID * D, D, 256 * (n0 / 128) + (n0 % 128), nullptr}; } r -= I_G;
    if (r < I_G) { const int mi = r / I_G1, q = r % I_G1, kb = q / 24, nb = q % 24, n0 = 32 * nb;
        return TrItem{a.w_up + (size_t)mi * D * HID, HID, 64 * kb, n0, a.Wgu_t + (size_t)mi * 2 * HID * D, D, 256 * (n0 / 128) + 128 + (n0 % 128), nullptr}; } r -= I_G;
    { const int mi = r / I_D1, q = r % I_D1, kb = q / 64, nb = q % 64;
        return TrItem{a.w_down + (size_t)mi * HID * D, D, 64 * kb, 32 * nb, a.Wd_t + (size_t)mi * D * HID, HID, 32 * nb, nullptr}; }
}
__device__ __forceinline__ void p0_prologue(const Ctx& F, const P0Args& a) {
    LAS float* scr = (LAS float*)(F.lds + F.wave * 16384);
    const int gw = F.bid * 8 + F.wave, NGW = F.G * 8;
    for (int it = gw; it < I_IN; it += NGW) { const TrItem d = p0_desc(a, it); f32x4 v[8]; tr_load<false>(d, v, F.lane); tr_finish<false>(d, v, scr, F.lane); }
    f32x4 gv[8];
#pragma unroll
    for (int j = 0; j < 8; ++j) gv[j] = ((const f32x4*)a.norm_a)[128 * (j >> 1) + 2 * F.lane + (j & 1)];
    for (int m = gw; m < T; m += NGW) rms_row_to_bf16(a.x + (size_t)m * D, gv, a.XN + (size_t)m * D, F.lane);
    for (int i = F.bid * 512 + F.tid; i < 2 * D * WRN; i += F.G * 512) { const int l = i / (D * WRN), q = i % (D * WRN), k = 4 * (q / (4 * WRN)) + (q & 3), n = (q / 4) % WRN;
        a.WR[i] = n < NGRP ? a.w_rg[(size_t)(l * D + k) * NGRP + n] : n < NGRP + NE ? a.w_re[(size_t)(l * D + k) * NE + (n - NGRP)] : 0.f; }
}
constexpr int P0_TK = 8;
__device__ __forceinline__ void p0_queue(const Ctx& F, const P0Args& a, unsigned* ticket) {
    LAS float* scr = (LAS float*)(F.lds + F.wave * 16384);
    constexpr int NREST = NITEMS - I_IN;
    for (;;) {
        unsigned t = 0;
        if (F.lane == 0) t = __hip_atomic_fetch_add(ticket, 1u, __ATOMIC_RELAXED, __HIP_MEMORY_SCOPE_AGENT);
        t = __builtin_amdgcn_readfirstlane(t);
        if ((long)t * P0_TK >= NREST) break;
        const int i0 = (int)t * P0_TK, i1 = i0 + P0_TK < NREST ? i0 + P0_TK : NREST;
        f32x4 va[8], vb[8];
        tr_load<true>(p0_desc(a, I_IN + i0), va, F.lane);
        for (int it = i0; it < i1; it += 2) {
            if (it + 1 < i1) tr_load<true>(p0_desc(a, I_IN + it + 1), vb, F.lane);
            { const TrItem d = p0_desc(a, I_IN + it); tr_finish<true>(d, va, scr, F.lane); }
            if (it + 2 < i1) tr_load<true>(p0_desc(a, I_IN + it + 2), va, F.lane);
            if (it + 1 < i1) { const TrItem d = p0_desc(a, I_IN + it + 1); tr_finish<true>(d, vb, scr, F.lane); }
        }
    }
}

constexpr int GCH = 32;
__device__ __forceinline__ void p2_gdn_ref(const Ctx& F, const bf16_t* proj, const float* conv_w, const float* a_log, const float* dt_bias, const float* out_gain, bf16_t* og) {
    LAS float* qs = (LAS float*)F.lds;
    LAS float* ks = qs + GCH * HD;
    LAS float* vs = ks + GCH * HD;
    LAS float* ob = vs + GCH * HD;
    LAS float* bet = ob + GCH * HD;
    LAS float* egs = bet + GCH;
    const int cl = F.lane & 15, qd = F.lane >> 4, c = F.wave * 16 + cl;
    for (int unit = F.bid; unit < BATCH * GVH; unit += F.G) {
        const int b = unit / GVH, hv = unit % GVH, hk = hv / 2;
        const float A = __expf(a_log[hv]), dtb = dt_bias[hv];
        float S[32];
#pragma unroll
        for (int i = 0; i < 32; ++i) S[i] = 0.f;
        for (int ch = 0; ch < SEQ / GCH; ++ch) {
            const int t0 = ch * GCH;
            for (int idx = F.tid; idx < 3 * GCH * HD; idx += 512) {
                const int which = idx / (GCH * HD), tl = (idx / HD) % GCH, cc = idx % HD;
                const int col = which == 0 ? hk * HD + cc : which == 1 ? GKDIM + hk * HD + cc : 2 * GKDIM + hv * HD + cc;
                float acc = 0.f;
#pragma unroll
                for (int j = 0; j < 4; ++j) { const int tt = t0 + tl - 3 + j; if (tt >= 0) acc += conv_w[j * GCONV + col] * bf2f(proj[(size_t)(b * SEQ + tt) * GIN_PAD + col]); }
                qs[which * GCH * HD + tl * HD + cc] = silu_f(acc);
            }
            if (F.tid < GCH) { const size_t row = (size_t)(b * SEQ + t0 + F.tid) * GIN_PAD;
                bet[F.tid] = sigmoid_f(bf2f(proj[row + GCONV + GVDIM + hv]));
                const float av = bf2f(proj[row + GCONV + GVDIM + GVH + hv]);
                egs[F.tid] = __expf(-A * softplus_f(av + dtb)); }
            __syncthreads();
            for (int tl = F.wave; tl < GCH; tl += 8) {
                const float q0 = qs[tl * HD + 2 * F.lane], q1 = qs[tl * HD + 2 * F.lane + 1], k0 = ks[tl * HD + 2 * F.lane], k1 = ks[tl * HD + 2 * F.lane + 1];
                const float rq = 1.0f / sqrtf(wave_sum(q0 * q0 + q1 * q1) + EPS) * 0.08838834764831845f, rk = 1.0f / sqrtf(wave_sum(k0 * k0 + k1 * k1) + EPS);
                qs[tl * HD + 2 * F.lane] = q0 * rq; qs[tl * HD + 2 * F.lane + 1] = q1 * rq; ks[tl * HD + 2 * F.lane] = k0 * rk; ks[tl * HD + 2 * F.lane + 1] = k1 * rk;
            }
            __syncthreads();
            for (int tl = 0; tl < GCH; ++tl) {
                const float e = egs[tl], bt = bet[tl];
                float dk = 0.f, dq = 0.f, kq = 0.f;
                const LAS f32x4* kp = (const LAS f32x4*)(ks + tl * HD + 32 * qd); const LAS f32x4* qp = (const LAS f32x4*)(qs + tl * HD + 32 * qd);
                f32x4 kv[8];
#pragma unroll
                for (int i = 0; i < 8; ++i) { kv[i] = kp[i]; const f32x4 qv = qp[i];
#pragma unroll
                    for (int j = 0; j < 4; ++j) { S[4 * i + j] *= e; dk += kv[i][j] * S[4 * i + j]; dq += qv[j] * S[4 * i + j]; kq += kv[i][j] * qv[j]; } }
                dk += __shfl_xor(dk, 16); dk += __shfl_xor(dk, 32);
                dq += __shfl_xor(dq, 16); dq += __shfl_xor(dq, 32);
                kq += __shfl_xor(kq, 16); kq += __shfl_xor(kq, 32);
                const float vn = bt * (vs[tl * HD + c] - dk);
#pragma unroll
                for (int i = 0; i < 8; ++i)
#pragma unroll
                    for (int j = 0; j < 4; ++j) S[4 * i + j] += kv[i][j] * vn;
                if (qd == 0) ob[tl * HD + c] = dq + kq * vn;
            }
            __syncthreads();
            for (int tl = F.wave; tl < GCH; tl += 8) {
                const float o0 = ob[tl * HD + 2 * F.lane], o1 = ob[tl * HD + 2 * F.lane + 1];
                const float r = 1.0f / sqrtf(wave_sum(o0 * o0 + o1 * o1) * (1.f / HD) + EPS);
                const size_t row = (size_t)(b * SEQ + t0 + tl);
                const unsigned zz = *(const unsigned*)(proj + row * GIN_PAD + GCONV + hv * HD + 2 * F.lane);
                const float z0 = bf2f(zz & 0xffffu), z1 = bf2f(zz >> 16);
                *(unsigned*)(og + row * GVDIM + hv * HD + 2 * F.lane) = pk2(o0 * r * out_gain[2 * F.lane] * silu_f(z0), o1 * r * out_gain[2 * F.lane + 1] * silu_f(z1));
            }
            __syncthreads();
        }
    }
}


namespace gdn {
typedef float f32x16 __attribute__((ext_vector_type(16)));
typedef short s16x4 __attribute__((ext_vector_type(4)));
__device__ __forceinline__ unsigned off_b(unsigned row, unsigned ch) { return 256u * row + 16u * (ch ^ (((row & 3) << 2) | ((row >> 2) & 3))); }
__device__ __forceinline__ unsigned off64(unsigned row, unsigned ch) { return 128u * row + 16u * (ch ^ (row & 7)); }
constexpr int L_KU = 0, L_QU = 16384, L_VNT = 16384, L_VV = 32768, L_ST = 49152, L_LP = 81920, L_RT = 81920, L_OB = 81920, L_TM = 98304, L_SSQ = 98304, L_AQ = 106496, L_VNTE = 114688;
constexpr int L_CW = RING_BYTES, L_SC = L_CW + 6144;
constexpr int L_TR = L_SC + 2560, L_TT = L_TR + 4096;
constexpr int SC_BETA = 0, SC_RK = 64, SC_RQ = 128, SC_G2 = 192, SC_AK = 256, SC_BQ = 320, SC_EV = 384, SC_DL = 448, SC_GAIN = 512;
static_assert(L_TT + 4096 <= LDSCTL_OFF, "gdn lds");
__device__ __forceinline__ int crow(int r, int hi) { return (r & 3) + 8 * (r >> 2) + 4 * hi; }
__device__ __forceinline__ unsigned cvtpk(float lo, float hi) { return pk2(lo, hi); }
__device__ __forceinline__ float dpp_add8(float v) {
    v += __int_as_float(__builtin_amdgcn_mov_dpp(__float_as_int(v), 0xB1, 0xF, 0xF, true));
    v += __int_as_float(__builtin_amdgcn_mov_dpp(__float_as_int(v), 0x4E, 0xF, 0xF, true));
    v += __int_as_float(__builtin_amdgcn_mov_dpp(__float_as_int(v), 0x141, 0xF, 0xF, true));
    return v;
}
__device__ __forceinline__ s16x4 gdn_bf4(f32x4 v) { u32x2 w = {pk2(v[0], v[1]), pk2(v[2], v[3])}; return *reinterpret_cast<s16x4*>(&w); }
__device__ __forceinline__ s16x4 tr_read(unsigned addr) { s16x4 r; asm volatile("ds_read_b64_tr_b16 %0, %1" : "=&v"(r) : "v"(addr) : "memory"); return r; }
}

__device__ __forceinline__ void p2_gdn(const Ctx& F, const bf16_t* proj, const float* conv_w, const float* a_log, const float* dt_bias, const float* out_gain, bf16_t* og) {
    using namespace gdn;
    LAS unsigned char* L = F.lds;
    const unsigned lbase = (unsigned)(size_t)L;
    LAS float* cw = (LAS float*)(L + L_CW);
    LAS float* sc = (LAS float*)(L + L_SC);
    LAS float* ssq = (LAS float*)(L + L_SSQ);
    int tid = F.tid, lane = F.lane, r32 = lane & 31, hi = lane >> 5;
    const int w = F.wave;
#define GDN_FRESH() do { asm volatile("" : "+v"(tid)); lane = tid & 63; r32 = lane & 31; hi = lane >> 5; } while (0)
    const int tb = w >> 2, vb = w & 3;
    const int kb = w >> 1, vbase = 2 * (w & 1);
    for (int unit = F.bid; unit < BATCH * GVH; unit += F.G) {
        const int b = unit / GVH, hv = unit % GVH, hk = hv / 2;
        const float Aexp = __expf(a_log[hv]), dtb = dt_bias[hv];
        __syncthreads();
        for (int idx = tid; idx < 4 * 384; idx += 512) { const int j = idx / 384, cl = idx % 384;
            const int col = cl < 128 ? hk * HD + cl : cl < 256 ? GKDIM + hk * HD + (cl - 128) : 2 * GKDIM + hv * HD + (cl - 256);
            cw[idx] = conv_w[j * GCONV + col]; }
        for (int idx = tid; idx < 32768 / 16; idx += 512) *(LAS u32x4*)(L + L_ST + idx * 16) = (u32x4){0u, 0u, 0u, 0u};
        f32x16 Sacc[2] = {};
        u32x4 pre[3][5];
#define GDN_LOADPRE(CH) do { _Pragma("unroll") for (int k_ = 0; k_ < 3; ++k_) { const int item_ = tid + 512 * k_, cc_ = item_ % 48, tok0_ = 2 * (item_ / 48); \
        const int col_ = cc_ < 16 ? hk * HD + cc_ * 8 : cc_ < 32 ? GKDIM + hk * HD + (cc_ - 16) * 8 : 2 * GKDIM + hv * HD + (cc_ - 32) * 8; \
        _Pragma("unroll") for (int rr_ = 0; rr_ < 5; ++rr_) { int tt_ = (CH) * 64 + tok0_ - 3 + rr_; tt_ = tt_ < 0 ? 0 : tt_; \
            pre[k_][rr_] = *(const u32x4*)(proj + (size_t)(b * SEQ + tt_) * GIN_PAD + col_); } } } while (0)
        GDN_LOADPRE(0);
        int pbase[3];
#pragma unroll
        for (int k_ = 0; k_ < 3; ++k_) { const int item_ = F.tid + 512 * k_, cc_ = item_ % 48, tok0_ = 2 * (item_ / 48);
            const int col_ = cc_ < 16 ? hk * HD + cc_ * 8 : cc_ < 32 ? GKDIM + hk * HD + (cc_ - 16) * 8 : 2 * GKDIM + hv * HD + (cc_ - 32) * 8;
            pbase[k_] = ((tok0_ - 3) * GIN_PAD + col_) * 2; }
#define GDN_LOADPRE_FAST(CH) do { const char* cb_ = (const char*)proj + (size_t)(b * SEQ + (CH) * 64) * GIN_PAD * 2; \
        _Pragma("unroll") for (int k_ = 0; k_ < 3; ++k_) { const char* p_ = cb_ + (long)pbase[k_]; \
            _Pragma("unroll") for (int rr_ = 0; rr_ < 5; ++rr_) pre[k_][rr_] = *(const u32x4*)(p_ + (size_t)rr_ * GIN_PAD * 2); } } while (0)
        unsigned short braw = 0, araw = 0;
        if (w == 6) { const bf16_t* pr = proj + ((size_t)(b * SEQ) + lane) * GIN_PAD + GCONV + GVDIM; braw = pr[hv]; araw = pr[GVH + hv]; }
        for (int idx = tid; idx < HD; idx += 512) sc[SC_GAIN + idx] = out_gain[idx];
        __syncthreads();
        for (int ch = 0; ch < SEQ / 64; ++ch) {
            const int t0 = ch * 64;
            const size_t rowbase = (size_t)(b * SEQ + t0);
            GDN_FRESH();
            u32x4 zreg[2];
#pragma unroll
            for (int k = 0; k < 3; ++k) {
                const int item = tid + 512 * k, cc = item % 48, tok0 = 2 * (item / 48);
                float x[5][8];
#pragma unroll
                for (int rr = 0; rr < 5; ++rr) {
                    u32x4 u = pre[k][rr];
                    if (ch == 0 && rr < 3 && tok0 - 3 + rr < 0) u = (u32x4){0u, 0u, 0u, 0u};
                    x[rr][0] = bf2f(u.x & 0xffffu); x[rr][1] = bf2f(u.x >> 16); x[rr][2] = bf2f(u.y & 0xffffu); x[rr][3] = bf2f(u.y >> 16);
                    x[rr][4] = bf2f(u.z & 0xffffu); x[rr][5] = bf2f(u.z >> 16); x[rr][6] = bf2f(u.w & 0xffffu); x[rr][7] = bf2f(u.w >> 16);
                }
                float y[2][8];
#pragma unroll
                for (int e = 0; e < 8; ++e) { y[0][e] = 0.f; y[1][e] = 0.f; }
#pragma unroll
                for (int j = 0; j < 4; ++j) {
                    const f32x4 w0 = *(const LAS f32x4*)(cw + j * 384 + cc * 8), w1 = *(const LAS f32x4*)(cw + j * 384 + cc * 8 + 4);
#pragma unroll
                    for (int d = 0; d < 2; ++d) {
                        y[d][0] += w0.x * x[d + j][0]; y[d][1] += w0.y * x[d + j][1]; y[d][2] += w0.z * x[d + j][2]; y[d][3] += w0.w * x[d + j][3];
                        y[d][4] += w1.x * x[d + j][4]; y[d][5] += w1.y * x[d + j][5]; y[d][6] += w1.z * x[d + j][6]; y[d][7] += w1.w * x[d + j][7];
                    }
                }
                float s2[2];
#pragma unroll
                for (int d = 0; d < 2; ++d) {
                    s2[d] = 0.f;
#pragma unroll
                    for (int e = 0; e < 8; ++e) { y[d][e] = silu_f(y[d][e]); s2[d] += y[d][e] * y[d][e]; }
                    u32x4 o; o.x = cvtpk(y[d][0], y[d][1]); o.y = cvtpk(y[d][2], y[d][3]); o.z = cvtpk(y[d][4], y[d][5]); o.w = cvtpk(y[d][6], y[d][7]);
                    const int tile = cc < 16 ? L_QU : cc < 32 ? L_KU : L_VV;
                    *(LAS u32x4*)(L + tile + off_b(tok0 + d, cc & 15)) = o;
                }
                if (cc < 32) *(LAS f32x2*)(ssq + cc * 64 + tok0) = (f32x2){s2[0], s2[1]};
            }
            __syncthreads();
            GDN_FRESH();
            f32x16 accB = {};
            const int bblk = w % 3, bib = bblk == 0 ? 0 : 1, bjb = bblk == 2 ? 1 : 0;
            if (w < 6) {
                const int btile = w >= 3 ? L_QU : L_KU;
#pragma unroll
                for (int s = 0; s < 8; ++s) {
                    const bf16x8 a = *(const LAS bf16x8*)(L + L_KU + off_b(32 * bjb + r32, 2 * s + hi));
                    const bf16x8 bq = *(const LAS bf16x8*)(L + btile + off_b(32 * bib + r32, 2 * s + hi));
                    accB = __builtin_amdgcn_mfma_f32_32x32x16_bf16(a, bq, accB, 0, 0, 0);
                }
            } else if (w == 6) {
                float sq = 0.f, sk = 0.f;
#pragma unroll
                for (int c = 0; c < 16; ++c) { sq += ssq[c * 64 + lane]; sk += ssq[(16 + c) * 64 + lane]; }
                const float rq = 0.08838834764831845f / sqrtf(sq + EPS), rk = 1.0f / sqrtf(sk + EPS);
                const float blog = bf2f(braw), alog = bf2f(araw);
                if (ch + 1 < SEQ / 64) { const bf16_t* pr = proj + (rowbase + 64 + lane) * GIN_PAD + GCONV + GVDIM; braw = pr[hv]; araw = pr[GVH + hv]; }
                const float bet = sigmoid_f(blog);
                float g2 = -Aexp * softplus_f(alog + dtb) * 1.4426950408889634f;
#define GDN_SCAN_STEP(CTRL, RMASK) g2 += __int_as_float(__builtin_amdgcn_update_dpp(0, __float_as_int(g2), CTRL, RMASK, 0xF, false))
                GDN_SCAN_STEP(0x111, 0xF); GDN_SCAN_STEP(0x112, 0xF); GDN_SCAN_STEP(0x114, 0xF); GDN_SCAN_STEP(0x118, 0xF); GDN_SCAN_STEP(0x142, 0xA); GDN_SCAN_STEP(0x143, 0xC);
#undef GDN_SCAN_STEP
                const float g2last = __shfl(g2, 63);
                const float eg = __builtin_amdgcn_exp2f(g2);
                sc[SC_BETA + lane] = bet; sc[SC_RK + lane] = rk; sc[SC_RQ + lane] = rq; sc[SC_G2 + lane] = g2;
                sc[SC_AK + lane] = rk * eg; sc[SC_BQ + lane] = rq * eg; sc[SC_EV + lane] = rk * __builtin_amdgcn_exp2f(g2last - g2);
                if (lane == 0) sc[SC_DL] = __builtin_amdgcn_exp2f(g2last);
            }
            __syncthreads();
            GDN_FRESH();
            if (w < 6) {
                const int i = 32 * bib + r32;
                const float g2i = sc[SC_G2 + i];
                const float fi = w < 3 ? sc[SC_BETA + i] * sc[SC_RK + i] : sc[SC_RQ + i];
                float val[16];
                const int thr = w < 3 ? i - 1 : i;
                f32x4 g2v[4], rkv[4];
#pragma unroll
                for (int g = 0; g < 4; ++g) { g2v[g] = *(const LAS f32x4*)(sc + SC_G2 + 32 * bjb + 8 * g + 4 * hi); rkv[g] = *(const LAS f32x4*)(sc + SC_RK + 32 * bjb + 8 * g + 4 * hi); }
#pragma unroll
                for (int r = 0; r < 16; ++r) {
                    const int j = 32 * bjb + crow(r, hi);
                    const float dec = __builtin_amdgcn_exp2f(g2i - g2v[r >> 2][r & 3]);
                    const float vfull = fi * rkv[r >> 2][r & 3] * accB[r] * dec;
                    val[r] = (j <= thr) ? vfull : 0.f;
                }
                if (w < 3) {
#pragma unroll
                    for (int g = 0; g < 4; ++g) *(LAS f32x4*)(L + L_LP + (i * 64 + 32 * bjb + 8 * g + 4 * hi) * 4) = (f32x4){val[4 * g], val[4 * g + 1], val[4 * g + 2], val[4 * g + 3]};
                } else {
#pragma unroll
                    for (int g = 0; g < 4; ++g) *(LAS u32x2*)(L + L_AQ + off64(i, 4 * bjb + g) + 8 * hi) = (u32x2){cvtpk(val[4 * g], val[4 * g + 1]), cvtpk(val[4 * g + 2], val[4 * g + 3])};
                }
            }
            { const u32x4* zp = (const u32x4*)(proj + (rowbase + (tid >> 3)) * GIN_PAD + GCONV + hv * HD + (tid & 7) * 16); zreg[0] = zp[0]; zreg[1] = zp[1]; }
            __syncthreads();
            GDN_FRESH();
            if (w >= 4 && ch + 1 < SEQ / 64) GDN_LOADPRE_FAST(ch + 1);
            f32x16 ksacc = {}, qsacc = {};
#define GDN_E() do { bf16x8 ak[2], aq[2], bs[2]; \
                ak[0] = *(const LAS bf16x8*)(L + L_KU + off_b(32 * tb + r32, hi)); aq[0] = *(const LAS bf16x8*)(L + L_QU + off_b(32 * tb + r32, hi)); bs[0] = *(const LAS bf16x8*)(L + L_ST + off_b(32 * vb + r32, hi)); \
                _Pragma("unroll") for (int s = 0; s < 8; ++s) { \
                    if (s < 7) { ak[(s + 1) & 1] = *(const LAS bf16x8*)(L + L_KU + off_b(32 * tb + r32, 2 * s + 2 + hi)); aq[(s + 1) & 1] = *(const LAS bf16x8*)(L + L_QU + off_b(32 * tb + r32, 2 * s + 2 + hi)); \
                                 bs[(s + 1) & 1] = *(const LAS bf16x8*)(L + L_ST + off_b(32 * vb + r32, 2 * s + 2 + hi)); } \
                    __builtin_amdgcn_sched_barrier(0); \
                    ksacc = __builtin_amdgcn_mfma_f32_32x32x16_bf16(ak[s & 1], bs[s & 1], ksacc, 0, 0, 0); \
                    qsacc = __builtin_amdgcn_mfma_f32_32x32x16_bf16(aq[s & 1], bs[s & 1], qsacc, 0, 0, 0); \
                    __builtin_amdgcn_sched_barrier(0); } } while (0)
            if (w >= 4) GDN_E();
            GDN_FRESH();
            {
                LAS float* TRm = (LAS float*)(L + L_TR); LAS float* TTm = (LAS float*)(L + L_TT);
                const LAS float* Lm = (const LAS float*)(L + L_LP);
                const int c16 = lane & 15, q4 = lane >> 4;
                if (w < 4) {
                    const int bb = w;
                    float Tc[16];
#pragma unroll
                    for (int rb2 = 0; rb2 < 8; ++rb2) {
                        const int rb = rb2 >> 1;
                        f32x4 lr[2][4];
#pragma unroll
                        for (int r = 0; r < 2; ++r)
#pragma unroll
                            for (int ch4 = 0; ch4 < 4; ++ch4) if (ch4 <= rb) lr[r][ch4] = *(const LAS f32x4*)(Lm + (16 * bb + 2 * rb2 + r) * 64 + 16 * bb + 4 * ch4);
#pragma unroll
                        for (int r = 0; r < 2; ++r) {
                            const int row = 2 * rb2 + r;
                            float s0 = 0.f, s1 = 0.f;
#pragma unroll
                            for (int rp = 0; rp < 16; ++rp) if (rp < row) { const float lv = lr[r][rp >> 2][rp & 3]; if (rp & 1) s1 += lv * Tc[rp]; else s0 += lv * Tc[rp]; }
                            Tc[row] = (c16 == row ? 1.f : 0.f) - (s0 + s1);
                        }
                    }
#pragma unroll
                    for (int e = 0; e < 4; ++e) {
                        const float tv = q4 == 0 ? Tc[e] : q4 == 1 ? Tc[4 + e] : q4 == 2 ? Tc[8 + e] : Tc[12 + e];
                        const int row = 4 * q4 + e;
                        TRm[(bb * 16 + row) * 16 + c16] = tv;
                        TTm[(bb * 16 + c16) * 16 + row] = tv;
                        const int gi = 16 * bb + row, gj = 16 * bb + c16;
                        *(LAS bf16_t*)(L + L_TM + off64(gi, gj >> 3) + (gj & 7) * 2) = (bf16_t)f2bf(tv);
                    }
                } else if (w == 4) {
                    const int blk = lane >> 5, row = (lane >> 1) & 15, chh = lane & 1;
                    *(LAS u32x4*)(L + L_TM + off64(32 * blk + row, 4 * blk + 2 + chh)) = (u32x4){0u, 0u, 0u, 0u};
                }
                __syncthreads();
                GDN_FRESH();
                if (w < 4) { if (ch + 1 < SEQ / 64) GDN_LOADPRE_FAST(ch + 1); GDN_E(); }
                if (w >= 4 && w < 7) {
                    const int c16b = lane & 15, q4b = lane >> 4;
#define GDN_BF4(v) gdn_bf4(v)
#define GDN_D2(JB) do { \
                    s16x4 La[4][3], Td[4], Tk[4]; \
                    _Pragma("unroll") for (int ib = JB + 1; ib < 4; ++ib) { \
                        _Pragma("unroll") for (int kb2 = JB; kb2 < ib; ++kb2) { const f32x4 a4 = *(const LAS f32x4*)(Lm + (16 * ib + c16b) * 64 + 16 * kb2 + 4 * q4b); La[ib][kb2] = GDN_BF4(a4); } \
                        const f32x4 t4 = *(const LAS f32x4*)(TRm + (ib * 16 + c16b) * 16 + 4 * q4b); Td[ib] = GDN_BF4(t4); } \
                    { const f32x4 t0 = *(const LAS f32x4*)(TTm + (JB * 16 + c16b) * 16 + 4 * q4b); Tk[JB] = GDN_BF4(t0); } \
                    _Pragma("unroll") for (int ib = JB + 1; ib < 4; ++ib) { \
                        f32x4 S = {0.f, 0.f, 0.f, 0.f}; \
                        _Pragma("unroll") for (int kb2 = JB; kb2 < ib; ++kb2) S = __builtin_amdgcn_mfma_f32_16x16x16bf16_1k(La[ib][kb2], Tk[kb2], S, 0, 0, 0); \
                        f32x4 Tn = {0.f, 0.f, 0.f, 0.f}; \
                        Tn = __builtin_amdgcn_mfma_f32_16x16x16bf16_1k(Td[ib], GDN_BF4(S), Tn, 0, 0, 0); \
                        Tn = -Tn; Tk[ib] = GDN_BF4(Tn); \
                        _Pragma("unroll") for (int e = 0; e < 4; ++e) { const int gi = 16 * ib + 4 * q4b + e, gj = 16 * JB + c16b; \
                            *(LAS bf16_t*)(L + L_TM + off64(gi, gj >> 3) + (gj & 7) * 2) = (bf16_t)f2bf(Tn[e]); } } } while (0)
                    if (w == 4) GDN_D2(0); else if (w == 5) GDN_D2(1); else GDN_D2(2);
#undef GDN_D2
                }
            }
#undef GDN_E
#undef GDN_BF4
            __syncthreads();
            GDN_FRESH();
            f32x16 oacc;
            {
                const int dv = 32 * vb + r32;
                float val[16];
                f32x4 btv[4], akv[4], bqv[4];
#pragma unroll
                for (int g = 0; g < 4; ++g) { const int t4 = 32 * tb + 8 * g + 4 * hi; btv[g] = *(const LAS f32x4*)(sc + SC_BETA + t4); akv[g] = *(const LAS f32x4*)(sc + SC_AK + t4); bqv[g] = *(const LAS f32x4*)(sc + SC_BQ + t4); }
                s16x4 vt[4];
                { const unsigned blkv = (lane >> 4) & 1, qv = (lane & 15) >> 2, pv = lane & 3;
#pragma unroll
                  for (int g = 0; g < 4; ++g) vt[g] = tr_read(lbase + L_VV + off_b(32 * tb + 8 * g + 4 * hi + qv, 4 * vb + 2 * blkv + (pv >> 1)) + 8 * (pv & 1)); }
                asm volatile("s_waitcnt lgkmcnt(0)" ::: "memory"); __builtin_amdgcn_sched_barrier(0);
#pragma unroll
                for (int r = 0; r < 16; ++r) {
                    const float vv = bf2f((unsigned)(unsigned short)vt[r >> 2][r & 3]);
                    val[r] = btv[r >> 2][r & 3] * (vv - akv[r >> 2][r & 3] * ksacc[r]);
                    oacc[r] = bqv[r >> 2][r & 3] * qsacc[r];
                }
#pragma unroll
                for (int g = 0; g < 4; ++g) *(LAS u32x2*)(L + L_RT + off64(dv, 4 * tb + g) + 8 * hi) = (u32x2){cvtpk(val[4 * g], val[4 * g + 1]), cvtpk(val[4 * g + 2], val[4 * g + 3])};
            }
            __syncthreads();
            GDN_FRESH();
            {
                f32x16 vn = {};
                f32x4 evv[4];
#pragma unroll
                for (int sp = 0; sp < 2; ++sp) if (sp == 0 || tb) {
                    bf16x8 ga[2], gb[2];
#pragma unroll
                    for (int s2 = 0; s2 < 2; ++s2) { ga[s2] = *(const LAS bf16x8*)(L + L_TM + off64(32 * tb + r32, 2 * (2 * sp + s2) + hi)); gb[s2] = *(const LAS bf16x8*)(L + L_RT + off64(32 * vb + r32, 2 * (2 * sp + s2) + hi)); }
                    __builtin_amdgcn_sched_barrier(0);
#pragma unroll
                    for (int s2 = 0; s2 < 2; ++s2) vn = __builtin_amdgcn_mfma_f32_32x32x16_bf16(ga[s2], gb[s2], vn, 0, 0, 0);
                }
#pragma unroll
                for (int g = 0; g < 4; ++g) evv[g] = *(const LAS f32x4*)(sc + SC_EV + 32 * tb + 8 * g + 4 * hi);
                const int dv = 32 * vb + r32;
#pragma unroll
                for (int g = 0; g < 4; ++g) {
                    float e[4];
#pragma unroll
                    for (int c = 0; c < 4; ++c) e[c] = vn[4 * g + c] * evv[g][c];
                    *(LAS u32x2*)(L + L_VNT + off64(dv, 4 * tb + g) + 8 * hi) = (u32x2){cvtpk(vn[4 * g], vn[4 * g + 1]), cvtpk(vn[4 * g + 2], vn[4 * g + 3])};
                    *(LAS u32x2*)(L + L_VNTE + off64(dv, 4 * tb + g) + 8 * hi) = (u32x2){cvtpk(e[0], e[1]), cvtpk(e[2], e[3])};
                }
            }
            __syncthreads();
            GDN_FRESH();
            {
#pragma unroll
                for (int sp = 0; sp < 2; ++sp) if (sp == 0 || tb) {
                    bf16x8 ha[2], hb[2];
#pragma unroll
                    for (int s2 = 0; s2 < 2; ++s2) { ha[s2] = *(const LAS bf16x8*)(L + L_AQ + off64(32 * tb + r32, 2 * (2 * sp + s2) + hi)); hb[s2] = *(const LAS bf16x8*)(L + L_VNT + off64(32 * vb + r32, 2 * (2 * sp + s2) + hi)); }
                    __builtin_amdgcn_sched_barrier(0);
#pragma unroll
                    for (int s2 = 0; s2 < 2; ++s2) oacc = __builtin_amdgcn_mfma_f32_32x32x16_bf16(ha[s2], hb[s2], oacc, 0, 0, 0);
                }
                const int dv = 32 * vb + r32;
#pragma unroll
                for (int r = 0; r < 16; ++r) *(LAS bf16_t*)(L + L_OB + (32 * tb + crow(r, hi)) * 256 + dv * 2) = (bf16_t)f2bf(oacc[r]);
            }
            GDN_FRESH();
            {
                const float dl = sc[SC_DL];
                Sacc[0] *= dl; Sacc[1] *= dl;
                const unsigned blk = (lane >> 4) & 1, q = (lane & 15) >> 2, p = lane & 3;
#pragma unroll
                for (int ks = 0; ks < 4; ++ks) {
                    const s16x4 t0v = tr_read(lbase + L_KU + off_b(16 * ks + 8 * hi + q, 4 * kb + 2 * blk + (p >> 1)) + 8 * (p & 1));
                    const s16x4 t1v = tr_read(lbase + L_KU + off_b(16 * ks + 8 * hi + 4 + q, 4 * kb + 2 * blk + (p >> 1)) + 8 * (p & 1));
                    const bf16x8 b0 = *(const LAS bf16x8*)(L + L_VNTE + off64(32 * vbase + r32, 2 * ks + hi));
                    const bf16x8 b1 = *(const LAS bf16x8*)(L + L_VNTE + off64(32 * (vbase + 1) + r32, 2 * ks + hi));
                    asm volatile("s_waitcnt lgkmcnt(0)" ::: "memory"); __builtin_amdgcn_sched_barrier(0);
                    const bf16x8 a = (bf16x8){t0v[0], t0v[1], t0v[2], t0v[3], t1v[0], t1v[1], t1v[2], t1v[3]};
                    Sacc[0] = __builtin_amdgcn_mfma_f32_32x32x16_bf16(a, b0, Sacc[0], 0, 0, 0);
                    Sacc[1] = __builtin_amdgcn_mfma_f32_32x32x16_bf16(a, b1, Sacc[1], 0, 0, 0);
                }
#pragma unroll
                for (int v2 = 0; v2 < 2; ++v2)
#pragma unroll
                    for (int g = 0; g < 4; ++g)
                        *(LAS u32x2*)(L + L_ST + off_b(32 * (vbase + v2) + r32, 4 * kb + g) + 8 * hi) = (u32x2){cvtpk(Sacc[v2][4 * g], Sacc[v2][4 * g + 1]), cvtpk(Sacc[v2][4 * g + 2], Sacc[v2][4 * g + 3])};
            }
            __syncthreads();
            GDN_FRESH();
            {
                const int tok = tid >> 3, seg = tid & 7;
                const u32x4 oa = *(const LAS u32x4*)(L + L_OB + tok * 256 + seg * 32), ob2 = *(const LAS u32x4*)(L + L_OB + tok * 256 + seg * 32 + 16);
                float o[16], z[16];
                const unsigned ow[8] = {oa.x, oa.y, oa.z, oa.w, ob2.x, ob2.y, ob2.z, ob2.w};
                const unsigned zw[8] = {zreg[0].x, zreg[0].y, zreg[0].z, zreg[0].w, zreg[1].x, zreg[1].y, zreg[1].z, zreg[1].w};
                float ss = 0.f;
#pragma unroll
                for (int e = 0; e < 8; ++e) { o[2 * e] = bf2f(ow[e] & 0xffffu); o[2 * e + 1] = bf2f(ow[e] >> 16); z[2 * e] = bf2f(zw[e] & 0xffffu); z[2 * e + 1] = bf2f(zw[e] >> 16);
                    ss += o[2 * e] * o[2 * e] + o[2 * e + 1] * o[2 * e + 1]; }
                const float r = 1.0f / sqrtf(dpp_add8(ss) * (1.f / HD) + EPS);
                unsigned res[8];
#pragma unroll
                for (int e = 0; e < 8; ++e) { const f32x2 gg = *(const LAS f32x2*)(sc + SC_GAIN + seg * 16 + 2 * e);
                    res[e] = pk2(o[2 * e] * r * gg.x * silu_f(z[2 * e]), o[2 * e + 1] * r * gg.y * silu_f(z[2 * e + 1])); }
                u32x4* op = (u32x4*)(og + (rowbase + tok) * GVDIM + hv * HD + seg * 16);
                op[0] = (u32x4){res[0], res[1], res[2], res[3]}; op[1] = (u32x4){res[4], res[5], res[6], res[7]};
            }
        }
#undef GDN_LOADPRE
#undef GDN_LOADPRE_FAST
    }
}
#undef GDN_FRESH

struct MoeBufs { int* blk_cnt; int* pad_start; int* tok_e; float* tok_w; int* tok_slot; };
__device__ __forceinline__ void p_moe_route(const Ctx& F, const float* h, const float* gain, const float* WR, const float* b_rg, const float* b_re, bf16_t* XN, const MoeBufs& mb) {
    constexpr int YS = D + 4;
    LAS float* y = (LAS float*)F.lds;
    LAS float* part = y + 16 * YS;
    LAS float* lgt = part + 8 * 16 * WRN;
    LAS int* lcnt = (LAS int*)(lgt + 16 * 40);
    static_assert((16 * YS + 8 * 16 * WRN + 16 * 40 + 32) * 4 <= LDSCTL_OFF, "route lds");
    constexpr int TPB = 64;
    const int lane = F.lane, w = F.wave;
    f32x4 gv[8];
#pragma unroll
    for (int j = 0; j < 8; ++j) gv[j] = ((const f32x4*)gain)[128 * (j >> 1) + 2 * lane + (j & 1)];
    for (int blk = F.bid; blk < T / TPB; blk += F.G) {
        if (F.tid < NE) lcnt[F.tid] = 0;
        __syncthreads();
        for (int rd = 0; rd < 4; ++rd) {
            const float* wb = WR + ((size_t)(64 * w + (lane >> 4)) * WRN + (lane & 15)) * 4;
            f32x4 B0[12], B1[12];
            f32x4 vv[2][8];
#pragma unroll
            for (int q = 0; q < 2; ++q) { const f32x4* xr = (const f32x4*)(h + (size_t)(blk * TPB + rd * 16 + 2 * w + q) * D) + 2 * lane;
#pragma unroll
                for (int j = 0; j < 8; ++j) vv[q][j] = xr[128 * (j >> 1) + (j & 1)]; }
#pragma unroll
            for (int i = 0; i < 6; ++i) B0[i] = *(const f32x4*)(wb + (size_t)(4 * (i / 3)) * WRN * 4 + 64 * (i % 3));
            asm volatile("" ::: "memory");
#pragma unroll
            for (int q = 0; q < 2; ++q) {
                const int tl = 2 * w + q, t = blk * TPB + rd * 16 + tl;
                f32x4 (&v)[8] = vv[q]; float s = 0.f;
#pragma unroll
                for (int j = 0; j < 8; ++j) s += (v[j].x * v[j].x + v[j].y * v[j].y) + (v[j].z * v[j].z + v[j].w * v[j].w);
                const float r = 1.0f / sqrtf(wave_sum(s) * (1.f / D) + EPS);
                u32x4* o16 = (u32x4*)(XN + (size_t)t * D) + lane;
#pragma unroll
                for (int j = 0; j < 4; ++j) {
                    const f32x4 a = v[2 * j] * r * gv[2 * j], b = v[2 * j + 1] * r * gv[2 * j + 1];
                    o16[64 * j] = (u32x4){pk2(a.x, a.y), pk2(a.z, a.w), pk2(b.x, b.y), pk2(b.z, b.w)};
                    LAS f32x4* yp = (LAS f32x4*)(y + tl * YS + 8 * (64 * j + lane)); yp[0] = a; yp[1] = b; }
            }
            __syncthreads();
            {
                f32x4 acc0 = {0.f, 0.f, 0.f, 0.f}, acc1 = acc0, acc2 = acc0;
                const LAS float* ya = y + (lane & 15) * YS + 256 * w + 4 * (lane >> 4);
#define RT_BLOCK(BB, jb) _Pragma("unroll") for (int jj = 0; jj < 4; ++jj) { const f32x4 a4 = *(const LAS f32x4*)(ya + 16 * ((jb) + jj)); \
                    _Pragma("unroll") for (int e = 0; e < 4; ++e) { \
                        acc0 = __builtin_amdgcn_mfma_f32_16x16x4f32(a4[e], BB[3 * jj][e], acc0, 0, 0, 0); \
                        acc1 = __builtin_amdgcn_mfma_f32_16x16x4f32(a4[e], BB[3 * jj + 1][e], acc1, 0, 0, 0); \
                        acc2 = __builtin_amdgcn_mfma_f32_16x16x4f32(a4[e], BB[3 * jj + 2][e], acc2, 0, 0, 0); } }
#define RT_LOAD(BB, jb) _Pragma("unroll") for (int i = 0; i < 12; ++i) BB[i] = *(const f32x4*)(wb + (size_t)(4 * ((jb) + i / 3)) * WRN * 4 + 64 * (i % 3));
                _Pragma("unroll") for (int i = 6; i < 12; ++i) B0[i] = *(const f32x4*)(wb + (size_t)(4 * (i / 3)) * WRN * 4 + 64 * (i % 3));
                RT_LOAD(B1, 4)
                asm volatile("" ::: "memory");
                RT_BLOCK(B0, 0)
                asm volatile("" ::: "memory");
                RT_LOAD(B0, 8)
                asm volatile("" ::: "memory");
                RT_BLOCK(B1, 4)
                asm volatile("" ::: "memory");
                RT_LOAD(B1, 12)
                asm volatile("" ::: "memory");
                RT_BLOCK(B0, 8)
                RT_BLOCK(B1, 12)
#undef RT_BLOCK
#undef RT_LOAD
#pragma unroll
                for (int r = 0; r < 4; ++r) { LAS float* pp = part + (w * 16 + 4 * (lane >> 4) + r) * WRN + (lane & 15);
                    pp[0] = acc0[r]; pp[16] = acc1[r]; pp[32] = acc2[r]; }
            }
            __syncthreads();
            for (int idx = F.tid; idx < 16 * 36; idx += 512) {
                const int tok = idx / 36, n = idx % 36;
                float s = 0.f;
#pragma unroll
                for (int ww = 0; ww < 8; ++ww) s += part[(ww * 16 + tok) * WRN + n];
                lgt[tok * 40 + n] = s + (n < NGRP ? b_rg[n] : b_re[n - NGRP]);
            }
            __syncthreads();
#pragma unroll
            for (int q = 0; q < 2; ++q) {
                const int tl = 2 * w + q, t = blk * TPB + rd * 16 + tl;
                const LAS float* lg = lgt + tl * 40;
                int gi = 0; float gm = lg[0];
#pragma unroll
                for (int i = 1; i < NGRP; ++i) { const float v = lg[i]; if (v > gm) { gm = v; gi = i; } }
                float den = 0.f;
#pragma unroll
                for (int i = 0; i < NGRP; ++i) den += __expf(lg[i] - gm);
                const float gval = 1.0f / den;
                const LAS float* le = lg + NGRP + gi * EPG;
                int i1 = 0; float l1 = le[0];
#pragma unroll
                for (int i = 1; i < EPG; ++i) { const float v = le[i]; if (v > l1) { l1 = v; i1 = i; } }
                int i2 = -1; float l2 = -3.0e38f;
#pragma unroll
                for (int i = 0; i < EPG; ++i) { const float v = le[i]; if (i != i1 && v > l2) { l2 = v; i2 = i; } }
                const float ex = __expf(l2 - l1), w1 = 1.0f / (1.0f + ex), w2 = ex / (1.0f + ex);
                if (lane == 0) {
                    const int e1 = gi * EPG + i1, e2 = gi * EPG + i2;
                    const int p1 = atomicAdd((int*)&lcnt[e1], 1), p2 = atomicAdd((int*)&lcnt[e2], 1);
                    mb.tok_e[2 * t] = e1 | (p1 << 8); mb.tok_e[2 * t + 1] = e2 | (p2 << 8);
                    mb.tok_w[2 * t] = gval * w1; mb.tok_w[2 * t + 1] = gval * w2;
                }
            }
        }
        __syncthreads();
        if (F.tid < NE) mb.blk_cnt[blk * NE + F.tid] = lcnt[F.tid];
        __syncthreads();
    }
}
__device__ __forceinline__ void p_moe_scatter(const Ctx& F, const bf16_t* XN, bf16_t* XS, const MoeBufs& mb) {
    LAS int* tot = (LAS int*)F.lds;
    LAS int* base = tot + 32;
    LAS int* pst = base + 32;
    constexpr int TPB = 64, NBLK = T / TPB;
    for (int blk = F.bid; blk < NBLK; blk += F.G) {
        if (F.tid < NE) { int s = 0, bs = 0; for (int j = 0; j < NBLK; ++j) { const int c = mb.blk_cnt[j * NE + F.tid]; s += c; bs += (j < blk) ? c : 0; } tot[F.tid] = s; base[F.tid] = bs; }
        __syncthreads();
        if (F.tid == 0) { int s = 0; for (int e = 0; e < NE; ++e) { pst[e] = s; s += (tot[e] + 255) & ~255; } pst[NE] = s;
            if (blk == 0) for (int e = 0; e <= NE; ++e) mb.pad_start[e] = pst[e]; }
        __syncthreads();
        for (int a = F.wave; a < 2 * TPB; a += 8) {
            const int ai = blk * 2 * TPB + a, t = ai >> 1;
            const int ep = mb.tok_e[ai], e = ep & 0xff, lp = ep >> 8;
            const int slot = pst[e] + base[e] + lp;
            const u32x4* src = (const u32x4*)(XN + (size_t)t * D) + F.lane; u32x4* dst = (u32x4*)(XS + (size_t)slot * D) + F.lane;
#pragma unroll
            for (int j = 0; j < 4; ++j) dst[64 * j] = src[64 * j];
            if (F.lane == 0) mb.tok_slot[ai] = slot;
        }
        __syncthreads();
    }
}
__device__ __forceinline__ void moe_units(const Ctx& F, const MoeBufs& mb, int nN, pg8::ListOrder& S) {
    LAS int* pst = (LAS int*)(F.lds + LDSCTL_OFF + 256);
    if (F.tid <= NE) pst[F.tid] = mb.pad_start[F.tid];
    __syncthreads();
    const int nmt = pst[NE] / 256, n = nmt * nN;
    int d[8]; int cnt = 0;
#pragma unroll
    for (int i = 0; i < 8; ++i) {
        const int L = i * F.G + F.bid; d[i] = 0;
        if (L < n) {
            int wgid = L; { const int q = n / 8, r = n % 8, xcd = wgid % 8, off = wgid / 8; wgid = (xcd < r ? xcd * (q + 1) : r * (q + 1) + (xcd - r) * q) + off; }
            const int mt = wgid / nN, pn = wgid % nN;
            int e = 0; for (int j = 1; j <= NE - 1; ++j) e += (pst[j] <= mt * 256) ? 1 : 0;
            d[i] = __builtin_amdgcn_readfirstlane(mt | (pn << 12) | ((e * nN + pn) << 16)); cnt = i + 1;
        }
    }
    S.n = __builtin_amdgcn_readfirstlane(cnt); S.d0 = d[0]; S.d1 = d[1]; S.d2 = d[2]; S.d3 = d[3]; S.d4 = d[4]; S.d5 = d[5]; S.d6 = d[6]; S.d7 = d[7];
    __syncthreads();
}
__device__ __forceinline__ void moe_gather_prep(const Ctx& F, const MoeBufs& mb, int nN, pg8::ListOrder& S, LAS int* rowtok) {
    constexpr int TPB = 64, NBLK = T / TPB;
    LAS int* base = (LAS int*)F.lds;
    LAS int* segsum = base + NBLK * NE;
    LAS int* segoff = segsum + 16 * NE;
    LAS int* pst = segoff + 16 * NE;
    LAS int* umt = pst + 64;
    {   const int e = F.tid & 31, seg = F.tid >> 5; int s = 0;
        for (int j = seg * 16; j < seg * 16 + 16; ++j) { base[j * NE + e] = s; s += mb.blk_cnt[j * NE + e]; }
        segsum[seg * NE + e] = s; }
    __syncthreads();
    if (F.tid < NE) { int run = 0; for (int sg = 0; sg < 16; ++sg) { segoff[sg * NE + F.tid] = run; run += segsum[sg * NE + F.tid]; } segsum[F.tid] = run; }
    __syncthreads();
    if (F.tid == 0) { int s = 0; for (int e = 0; e < NE; ++e) { pst[e] = s; s += (segsum[e] + 255) & ~255; } pst[NE] = s;
        if (F.bid == 0) for (int e = 0; e <= NE; ++e) mb.pad_start[e] = pst[e]; }
    for (int i = F.tid; i < 8 * 256; i += 512) rowtok[i] = 0;
    __syncthreads();
    const int nmt = pst[NE] / 256, n = nmt * nN;
    int d[8]; int cnt = 0;
#pragma unroll
    for (int i = 0; i < 8; ++i) {
        const int Lq = i * F.G + F.bid; d[i] = 0;
        if (Lq < n) {
            int wgid = Lq; { const int q = n / 8, r = n % 8, xcd = wgid % 8, off = wgid / 8; wgid = (xcd < r ? xcd * (q + 1) : r * (q + 1) + (xcd - r) * q) + off; }
            const int mt = wgid / nN, pn = wgid % nN;
            int e = 0; for (int j = 1; j <= NE - 1; ++j) e += (pst[j] <= mt * 256) ? 1 : 0;
            d[i] = __builtin_amdgcn_readfirstlane(mt | (pn << 12) | ((e * nN + pn) << 16)); cnt = i + 1;
            if (F.tid == 0) umt[i] = mt;
        } else if (F.tid == 0) umt[i] = -1;
    }
    S.n = __builtin_amdgcn_readfirstlane(cnt); S.d0 = d[0]; S.d1 = d[1]; S.d2 = d[2]; S.d3 = d[3]; S.d4 = d[4]; S.d5 = d[5]; S.d6 = d[6]; S.d7 = d[7];
    __syncthreads();
    int um[8];
#pragma unroll
    for (int i = 0; i < 8; ++i) um[i] = umt[i];
    for (int a = F.tid; a < 2 * T; a += 512) {
        const int ep = mb.tok_e[a], e = ep & 0xff, lp = ep >> 8, blk = a >> 7;
        const int slot = pst[e] + segoff[(blk >> 4) * NE + e] + base[blk * NE + e] + lp;
        if (blk % F.G == F.bid) mb.tok_slot[a] = slot;
        const int mt = slot >> 8;
#pragma unroll
        for (int i = 0; i < 8; ++i) if (mt == um[i]) rowtok[i * 256 + (slot & 255)] = a >> 1;
    }
    __syncthreads();
}

__device__ __forceinline__ void p_moe_combine(const Ctx& F, float* h, const bf16_t* YS, const MoeBufs& mb, bf16_t* XN) {
    const int gw = F.bid * 8 + F.wave, NGW = F.G * 8;
    int tid_ = threadIdx.x; asm volatile("" : "+v"(tid_)); const int lane_ = tid_ & 63;
    for (int t = gw; t < T; t += NGW) {
        const int s0 = mb.tok_slot[2 * t], s1 = mb.tok_slot[2 * t + 1]; const float w0 = mb.tok_w[2 * t], w1 = mb.tok_w[2 * t + 1];
        f32x4* hr = (f32x4*)(h + (size_t)t * D) + 2 * lane_;
        const u32x4* y0 = (const u32x4*)(YS + (size_t)s0 * D) + lane_; const u32x4* y1 = (const u32x4*)(YS + (size_t)s1 * D) + lane_;
        f32x4 v[8]; float s = 0.f;
#pragma unroll
        for (int j = 0; j < 4; ++j) { const u32x4 a = y0[64 * j], b = y1[64 * j];
            f32x4 lo = hr[128 * j], hi4 = hr[128 * j + 1];
            lo.x += w0 * bf2f(a.x & 0xffffu) + w1 * bf2f(b.x & 0xffffu); lo.y += w0 * bf2f(a.x >> 16) + w1 * bf2f(b.x >> 16);
            lo.z += w0 * bf2f(a.y & 0xffffu) + w1 * bf2f(b.y & 0xffffu); lo.w += w0 * bf2f(a.y >> 16) + w1 * bf2f(b.y >> 16);
            hi4.x += w0 * bf2f(a.z & 0xffffu) + w1 * bf2f(b.z & 0xffffu); hi4.y += w0 * bf2f(a.z >> 16) + w1 * bf2f(b.z >> 16);
            hi4.z += w0 * bf2f(a.w & 0xffffu) + w1 * bf2f(b.w & 0xffffu); hi4.w += w0 * bf2f(a.w >> 16) + w1 * bf2f(b.w >> 16);
            hr[128 * j] = lo; hr[128 * j + 1] = hi4; v[2 * j] = lo; v[2 * j + 1] = hi4;
            s += (lo.x * lo.x + lo.y * lo.y) + (lo.z * lo.z + lo.w * lo.w) + (hi4.x * hi4.x + hi4.y * hi4.y) + (hi4.z * hi4.z + hi4.w * hi4.w); }
        if (XN) { const float r = 1.0f / sqrtf(wave_sum(s) * (1.f / D) + EPS); u32x4* o16 = (u32x4*)(XN + (size_t)t * D) + lane_;
#pragma unroll
            for (int j = 0; j < 4; ++j) o16[64 * j] = (u32x4){pk2(v[2 * j].x * r, v[2 * j].y * r), pk2(v[2 * j].z * r, v[2 * j].w * r), pk2(v[2 * j + 1].x * r, v[2 * j + 1].y * r), pk2(v[2 * j + 1].z * r, v[2 * j + 1].w * r)}; }
    }
}
__device__ __forceinline__ void p_qk_norm(const Ctx& F, bf16_t* kvq, const float* k_gain, const float* q_gain) {
    const int gw = F.bid * 8 + F.wave, NGW = F.G * 8;
    for (int r = gw; r < T * 2 * SBH; r += NGW) {
        const int t = r / (2 * SBH), hh = r % (2 * SBH); const bool isq = hh >= SBH;
        unsigned* p = (unsigned*)(kvq + (size_t)t * KVQ + (isq ? 2 * SBDIM + (hh - SBH) * HD : hh * HD)) + F.lane;
        const unsigned u = *p; const float a = bf2f(u & 0xffffu), b = bf2f(u >> 16);
        const float rr = 1.0f / sqrtf(wave_sum(a * a + b * b) * (1.f / HD) + EPS);
        const float* g = isq ? q_gain : k_gain;
        const float qs = isq ? 0.12751743082459868f : 1.0f;
        *p = pk2(a * rr * g[2 * F.lane] * qs, b * rr * g[2 * F.lane + 1] * qs);
    }
}
__device__ __forceinline__ void p_sb_attn_ref(const Ctx& F, const bf16_t* kvq, bf16_t* ao) {
    LAS float* Kt = (LAS float*)F.lds;
    LAS float* Vt = Kt + 64 * HD;
    const int il = F.tid >> 1, half = F.tid & 1;
    for (int unit = F.bid; unit < BATCH * SBH * 4; unit += F.G) {
        const int p = unit & 3, bh = unit >> 2, b = bh / SBH, hh = bh % SBH;
        for (int side = 0; side < 2; ++side) {
            const int qb = side == 0 ? 7 - p : p;
            const int i = qb * 256 + il;
            float q[64], o[64];
            { const u32x4* qp = (const u32x4*)(kvq + (size_t)(b * SEQ + i) * KVQ + 2 * SBDIM + hh * HD + half * 64);
#pragma unroll
              for (int j = 0; j < 8; ++j) { const u32x4 u = qp[j];
                  q[8 * j + 0] = bf2f(u.x & 0xffffu); q[8 * j + 1] = bf2f(u.x >> 16); q[8 * j + 2] = bf2f(u.y & 0xffffu); q[8 * j + 3] = bf2f(u.y >> 16);
                  q[8 * j + 4] = bf2f(u.z & 0xffffu); q[8 * j + 5] = bf2f(u.z >> 16); q[8 * j + 6] = bf2f(u.w & 0xffffu); q[8 * j + 7] = bf2f(u.w >> 16); } }
#pragma unroll
            for (int d = 0; d < 64; ++d) { q[d] *= 0.08838834764831845f; o[d] = 0.f; }
            float csum = 0.f;
            for (int kt = qb * 4 + 3; kt >= 0; --kt) {
                __syncthreads();
                for (int idx = F.tid; idx < 64 * 16 * 2; idx += 512) {
                    const int which = idx / 1024, r = (idx / 16) % 64, c8 = idx % 16;
                    const u32x4 u = *(const u32x4*)(kvq + (size_t)(b * SEQ + kt * 64 + r) * KVQ + which * SBDIM + hh * HD + c8 * 8);
                    LAS float* dst = (which ? Vt : Kt) + r * HD + c8 * 8;
                    dst[0] = bf2f(u.x & 0xffffu); dst[1] = bf2f(u.x >> 16); dst[2] = bf2f(u.y & 0xffffu); dst[3] = bf2f(u.y >> 16);
                    dst[4] = bf2f(u.z & 0xffffu); dst[5] = bf2f(u.z >> 16); dst[6] = bf2f(u.w & 0xffffu); dst[7] = bf2f(u.w >> 16);
                }
                __syncthreads();
                for (int jl = 63; jl >= 0; --jl) {
                    const int j = kt * 64 + jl;
                    if (j < i) {
                        const LAS f32x4* kp = (const LAS f32x4*)(Kt + jl * HD + half * 64);
                        float z = 0.f;
#pragma unroll
                        for (int d = 0; d < 16; ++d) { const f32x4 kk = kp[d]; z += q[4 * d] * kk.x + q[4 * d + 1] * kk.y + q[4 * d + 2] * kk.z + q[4 * d + 3] * kk.w; }
                        z += __shfl_xor(z, 1);
                        csum -= softplus_f(z);
                        const float w = __expf(z + csum);
                        const LAS f32x4* vp = (const LAS f32x4*)(Vt + jl * HD + half * 64);
#pragma unroll
                        for (int d = 0; d < 16; ++d) { const f32x4 vv = vp[d]; o[4 * d] += w * vv.x; o[4 * d + 1] += w * vv.y; o[4 * d + 2] += w * vv.z; o[4 * d + 3] += w * vv.w; }
                    }
                }
            }
            u32x4* op = (u32x4*)(ao + (size_t)(b * SEQ + i) * SBDIM + hh * HD + half * 64);
#pragma unroll
            for (int j = 0; j < 8; ++j) { u32x4 w; w.x = pk2(o[8 * j], o[8 * j + 1]); w.y = pk2(o[8 * j + 2], o[8 * j + 3]); w.z = pk2(o[8 * j + 4], o[8 * j + 5]); w.w = pk2(o[8 * j + 6], o[8 * j + 7]); op[j] = w; }
        }
    }
}


namespace sba {
typedef float f32x16 __attribute__((ext_vector_type(16)));
typedef short s16x4 __attribute__((ext_vector_type(4)));
constexpr int SHM_V = 64 * HD * 2, SHM_K = 64 * HD * 2;
#define SBA_KSWZ(row, colB) ((row) * 256 + ((colB) ^ (((row) & 7) << 4)))
__device__ __forceinline__ int crow(int r, int hi) { return (r & 3) + 8 * (r >> 2) + 4 * hi; }
__device__ __forceinline__ unsigned cvtpk(float lo, float hi) { return pk2(lo, hi); }
__device__ __forceinline__ void qkt(f32x16& p0, f32x16& p1, const LAS char* Ks, const bf16x8* qr, int r32, int hi) {
    p0 = f32x16{}; p1 = f32x16{};
#pragma unroll
    for (int d0 = 0; d0 < 8; ++d0) { const int cb = (d0 * 16 + hi * 8) * 2;
        const bf16x8 b0 = *(const LAS bf16x8*)(Ks + SBA_KSWZ(r32, cb));
        const bf16x8 b1 = *(const LAS bf16x8*)(Ks + SBA_KSWZ(32 + r32, cb));
        p0 = __builtin_amdgcn_mfma_f32_32x32x16_bf16(b0, qr[d0], p0, 0, 0, 0);
        p1 = __builtin_amdgcn_mfma_f32_32x32x16_bf16(b1, qr[d0], p1, 0, 0, 0); }
}
__device__ __forceinline__ int v_st(int k, int c) { const int kk = (k & ~0xC) | ((k & 4) << 1) | ((k & 8) >> 1); return ((kk >> 3) * 4 + (c >> 5)) * 512 + ((kk & 7) * 32 + (c & 31)) * 2; }
__device__ __forceinline__ int v_rd_base(int lane) { return ((lane & 3) << 3) | (((lane >> 2) & 3) << 6) | (((lane >> 4) & 1) << 5) | (((lane >> 5) & 1) << 8); }
constexpr int v_rd_off(int d0, int ks, int half) { return d0 * 512 + ks * 4096 + half * 2048; }
template <int OFF> __device__ __forceinline__ s16x4 tr_read(int vb) { s16x4 r; asm volatile("ds_read_b64_tr_b16 %0, %1 offset:%2" : "=&v"(r) : "v"(vb), "i"(OFF) : "memory"); return r; }
template <int D0> __device__ __forceinline__ void pv_one(f32x16& od, int vb, bf16x8 pa0, bf16x8 pa1, bf16x8 pa2, bf16x8 pa3) {
    const s16x4 l0 = tr_read<v_rd_off(D0, 0, 0)>(vb), h0 = tr_read<v_rd_off(D0, 0, 1)>(vb), l1 = tr_read<v_rd_off(D0, 1, 0)>(vb), h1 = tr_read<v_rd_off(D0, 1, 1)>(vb);
    const s16x4 l2 = tr_read<v_rd_off(D0, 2, 0)>(vb), h2 = tr_read<v_rd_off(D0, 2, 1)>(vb), l3 = tr_read<v_rd_off(D0, 3, 0)>(vb), h3 = tr_read<v_rd_off(D0, 3, 1)>(vb);
    asm volatile("s_waitcnt lgkmcnt(0)" ::: "memory"); __builtin_amdgcn_sched_barrier(0);
#define SBA_PK(L, H) (bf16x8){L[0], L[1], L[2], L[3], H[0], H[1], H[2], H[3]}
    od = __builtin_amdgcn_mfma_f32_32x32x16_bf16(pa0, SBA_PK(l0, h0), od, 0, 0, 0);
    od = __builtin_amdgcn_mfma_f32_32x32x16_bf16(pa1, SBA_PK(l1, h1), od, 0, 0, 0);
    od = __builtin_amdgcn_mfma_f32_32x32x16_bf16(pa2, SBA_PK(l2, h2), od, 0, 0, 0);
    od = __builtin_amdgcn_mfma_f32_32x32x16_bf16(pa3, SBA_PK(l3, h3), od, 0, 0, 0);
#undef SBA_PK
}
__device__ __forceinline__ void sb_weights(f32x16& p0, f32x16& p1, float& carry, float hmask, bf16x8& pa0, bf16x8& pa1, bf16x8& pa2, bf16x8& pa3) {
    f32x16 l0, l1;
#pragma unroll
    for (int r = 0; r < 16; ++r) {
        const float t0 = __builtin_amdgcn_exp2f(p0[r]), t1 = __builtin_amdgcn_exp2f(p1[r]);
        l0[r] = __builtin_amdgcn_rcpf(1.0f + t0); l1[r] = __builtin_amdgcn_rcpf(1.0f + t1);
        p0[r] = 1.0f - l0[r]; p1[r] = 1.0f - l1[r];
    }
#pragma unroll
    for (int m = 0; m < 4; ++m) {
        p0[4 * m + 2] *= l0[4 * m + 3]; l0[4 * m + 2] *= l0[4 * m + 3]; p0[4 * m + 1] *= l0[4 * m + 2]; l0[4 * m + 1] *= l0[4 * m + 2]; p0[4 * m] *= l0[4 * m + 1]; l0[4 * m] *= l0[4 * m + 1];
        p1[4 * m + 2] *= l1[4 * m + 3]; l1[4 * m + 2] *= l1[4 * m + 3]; p1[4 * m + 1] *= l1[4 * m + 2]; l1[4 * m + 1] *= l1[4 * m + 2]; p1[4 * m] *= l1[4 * m + 1]; l1[4 * m] *= l1[4 * m + 1];
    }
    float Pm[8], Om[8];
#pragma unroll
    for (int m = 0; m < 8; ++m) {
        const float tm = m < 4 ? l0[4 * m] : l1[4 * (m - 4)];
        auto rr = __builtin_amdgcn_permlane32_swap(__float_as_uint(tm), __float_as_uint(tm), false, false);
        const float e = __uint_as_float(rr[0]), o = __uint_as_float(rr[1]);
        Pm[m] = e * o; Om[m] = hmask * o + (1.0f - hmask);
    }
    float sp = carry;
#pragma unroll
    for (int m = 7; m >= 0; --m) {
        const float off = sp * Om[m];
        if (m < 4) {
#pragma unroll
            for (int j = 0; j < 4; ++j) p0[4 * m + j] *= off;
        } else {
#pragma unroll
            for (int j = 0; j < 4; ++j) p1[4 * (m - 4) + j] *= off;
        }
        sp *= Pm[m];
    }
    carry = sp;
#define SBA_PK4(P, BASE, OUT) do { unsigned a0 = cvtpk(P[BASE + 0], P[BASE + 1]), a1 = cvtpk(P[BASE + 2], P[BASE + 3]); \
    unsigned b0 = cvtpk(P[BASE + 4], P[BASE + 5]), b1 = cvtpk(P[BASE + 6], P[BASE + 7]); \
    auto r0 = __builtin_amdgcn_permlane32_swap(a0, b0, false, false); auto r1 = __builtin_amdgcn_permlane32_swap(a1, b1, false, false); \
    u32x4 w = {r0[0], r1[0], r0[1], r1[1]}; OUT = *reinterpret_cast<bf16x8*>(&w); } while (0)
    SBA_PK4(p0, 0, pa0); SBA_PK4(p0, 8, pa1); SBA_PK4(p1, 0, pa2); SBA_PK4(p1, 8, pa3);
#undef SBA_PK4
}
}

__device__ __forceinline__ void p_sb_attn(const Ctx& F, const bf16_t* kvq, bf16_t* ao) {
    using namespace sba;
    LAS char* V_lds = (LAS char*)F.lds; LAS char* K_lds = V_lds + 2 * SHM_V;
    const int tid = F.tid, wid = F.wave, lane = F.lane, r32 = lane & 31, hi = lane >> 5;
    const int sr = tid >> 4, sc = (tid & 15) * 8, vst0 = v_st(sr, sc), vst1 = v_st(32 + sr, sc);
    const int vb0 = (int)(unsigned)(size_t)V_lds + v_rd_base(lane);
    const float hmask = hi ? 0.f : 1.f;
    const int vcu = (F.G % 8 == 0) ? (F.bid % 8) * (F.G / 8) + F.bid / 8 : F.bid;
    for (int unit = vcu; unit < BATCH * SBH * 4; unit += F.G) {
        const int p = unit & 3, bh = unit >> 2, b = bh / SBH, hh = bh % SBH;
        const bf16_t* Kh = kvq + (size_t)(b * SEQ) * KVQ + hh * HD; const bf16_t* Vh = Kh + SBDIM; const bf16_t* Qh = Kh + 2 * SBDIM;
        for (int side = 0; side < 2; ++side) {
            const int qb = side == 0 ? 7 - p : p;
            const int i0 = qb * 256 + wid * 32;
            bf16x8 qr[8];
            { const bf16_t* Qw = Qh + (size_t)(i0 + r32) * KVQ + hi * 8;
#pragma unroll
              for (int d0 = 0; d0 < 8; ++d0) qr[d0] = *(const bf16x8*)(Qw + d0 * 16); }
            f32x16 o[4] = {};
            float carry = 1.f;
            const int NT = 4 * qb + 4;
            bf16x8 vs0, vs1, ks0, ks1;
#define SBA_SLOAD(k0) do { vs0 = *(const bf16x8*)(Vh + (size_t)((k0) + sr) * KVQ + sc); vs1 = *(const bf16x8*)(Vh + (size_t)((k0) + 32 + sr) * KVQ + sc); \
    ks0 = *(const bf16x8*)(Kh + (size_t)((k0) + sr) * KVQ + sc); ks1 = *(const bf16x8*)(Kh + (size_t)((k0) + 32 + sr) * KVQ + sc); } while (0)
#define SBA_SWRITE(bf) do { *(LAS bf16x8*)(V_lds + (bf) * SHM_V + vst0) = vs0; *(LAS bf16x8*)(V_lds + (bf) * SHM_V + vst1) = vs1; const int kc = sc * 2; \
    *(LAS bf16x8*)(K_lds + (bf) * SHM_K + SBA_KSWZ(sr, kc)) = ks0; *(LAS bf16x8*)(K_lds + (bf) * SHM_K + SBA_KSWZ(32 + sr, kc)) = ks1; } while (0)
            __syncthreads();
            SBA_SLOAD((NT - 1) * 64); SBA_SWRITE(0);
            if (NT > 1) SBA_SLOAD((NT - 2) * 64);
            __syncthreads();
            for (int n = 0; n < NT; ++n) {
                const int kt = NT - 1 - n, buf = n & 1;
                if (n + 1 < NT) { SBA_SWRITE(buf ^ 1); if (n + 2 < NT) SBA_SLOAD((kt - 2) * 64); }
                if (64 * kt < i0 + 31) {
                    f32x16 p0, p1;
                    qkt(p0, p1, K_lds + buf * SHM_K, qr, r32, hi);
                    if (64 * kt + 63 >= i0) {
                        const int irow = i0 + r32;
#pragma unroll
                        for (int r = 0; r < 16; ++r) { const int j = 64 * kt + crow(r, hi); p0[r] = (j < irow) ? p0[r] : -1.0e30f; p1[r] = (j + 32 < irow) ? p1[r] : -1.0e30f; }
                    }
                    bf16x8 pa0, pa1, pa2, pa3;
                    sb_weights(p0, p1, carry, hmask, pa0, pa1, pa2, pa3);
                    const int vb = vb0 + buf * SHM_V;
                    pv_one<0>(o[0], vb, pa0, pa1, pa2, pa3); pv_one<1>(o[1], vb, pa0, pa1, pa2, pa3); pv_one<2>(o[2], vb, pa0, pa1, pa2, pa3); pv_one<3>(o[3], vb, pa0, pa1, pa2, pa3);
                }
                __syncthreads();
            }
#undef SBA_SLOAD
#undef SBA_SWRITE
            bf16_t* Ow = ao + (size_t)(b * SEQ + i0) * SBDIM + hh * HD;
#pragma unroll
            for (int r = 0; r < 16; ++r) { const int orow = crow(r, hi);
#pragma unroll
                for (int d0 = 0; d0 < 4; ++d0) Ow[(size_t)orow * SBDIM + d0 * 32 + r32] = (bf16_t)f2bf(o[d0][r]); }
        }
    }
}

constexpr int NPH = 18;
struct Args { const float* in[23]; float* out; unsigned char* ws; int ph_lo, ph_hi; };
__global__ void __launch_bounds__(512, 2) yoco_fwd(Args args) {
    extern __shared__ __attribute__((aligned(16))) unsigned char lds_raw[];
    Ctx F;
    F.lds = (LAS unsigned char*)lds_raw;
    F.tid = threadIdx.x; F.lane = F.tid & 63; F.wave = __builtin_amdgcn_readfirstlane(F.tid >> 6);
    F.G = gridDim.x; F.bid = blockIdx.x;
    unsigned char* ws = args.ws;
    const float* x = args.in[0];
    float* h = args.out;
    bf16_t* Win_t = (bf16_t*)(ws + WS_WIN); bf16_t* Wouta_t = (bf16_t*)(ws + WS_WOUTA); bf16_t* Wkvq_t = (bf16_t*)(ws + WS_WKVQ); bf16_t* Woutb_t = (bf16_t*)(ws + WS_WOUTB);
    bf16_t* Wgu_t = (bf16_t*)(ws + WS_WGU); bf16_t* Wd_t = (bf16_t*)(ws + WS_WD);
    bf16_t* XN = (bf16_t*)(ws + WS_XN); bf16_t* OG = (bf16_t*)(ws + WS_OG); bf16_t* PROJ = (bf16_t*)(ws + WS_BIG);
    bf16_t* XS = (bf16_t*)(ws + WS_XS); bf16_t* HB = (bf16_t*)(ws + WS_HB); bf16_t* YS = (bf16_t*)(ws + WS_YS);
    bf16_t* KVQB = (bf16_t*)(ws + WS_KVQ); bf16_t* AO = (bf16_t*)(ws + WS_AO);
    MoeBufs mb; mb.blk_cnt = (int*)(ws + WS_MISC + MI_BLKCNT); mb.pad_start = (int*)(ws + WS_MISC + MI_PADSTART); mb.tok_e = (int*)(ws + WS_MISC + MI_TOKE);
    mb.tok_w = (float*)(ws + WS_MISC + MI_TOKW); mb.tok_slot = (int*)(ws + WS_MISC + MI_TOKSLOT);

    for (int u = F.tid; u < (LDS_BYTES - LDSCTL_OFF) / 4; u += 512) ((LAS unsigned*)(F.lds + LDSCTL_OFF))[u] = 0u;
    __syncthreads();
    const int lo = args.ph_lo, hi = args.ph_hi;
    const bool multi = (hi - lo) > 1;
    XcdBarrier bar; bar.bar = (unsigned*)(ws + WS_CTL) + CW_BAR; bar.x = 0; bar.st = nullptr;
    if (multi) bar = xcd_barrier_post((unsigned*)(ws + WS_CTL) + CW_BAR, (volatile LAS unsigned*)(F.lds + LDSCTL_OFF));
#define IN(k) (lo <= (k) && (k) < hi)
#define SEAM(k) do { if (IN(k) && IN((k) + 1)) xcd_barrier(bar); } while (0)

    P0Args pa; pa.x = x; pa.norm_a = args.in[1]; pa.w_in = args.in[2]; pa.w_out_a = args.in[7]; pa.norm_kv = args.in[8]; pa.w_kv = args.in[9]; pa.norm_b = args.in[11]; pa.w_q = args.in[12];
    pa.w_out_b = args.in[14]; pa.w_gate = args.in[20]; pa.w_up = args.in[21]; pa.w_down = args.in[22]; pa.w_rg = args.in[16]; pa.w_re = args.in[18]; pa.WR = (float*)(ws + WS_WR);
    pa.Win_t = Win_t; pa.Wouta_t = Wouta_t; pa.Wkvq_t = Wkvq_t; pa.Woutb_t = Woutb_t; pa.Wgu_t = Wgu_t; pa.Wd_t = Wd_t; pa.XN = XN;
    if (IN(0)) { for (int rep = 0; rep < (MK_REP_PHASE == 0 ? 2 : 1); ++rep) p0_prologue(F, pa); }
    SEAM(0);
    if (IN(1)) {
        const int GG = F.G >= 128 ? F.G - 60 : F.G;
        if (F.bid < GG) {
            pg8::Gemm g{XN, Win_t, D}; pg8::StaticOrder S; S.init(T, GIN_PAD, GG, F.bid);
            pg8::EpiBf16 E{PROJ, GIN_PAD};
            pg8::gemm_phase<pg8::EpiBf16, pg8::StaticOrder>(F.lds, g, S, E);
            if (MK_REP_PHASE == 1) { __syncthreads(); pg8::gemm_phase<pg8::EpiBf16, pg8::StaticOrder>(F.lds, g, S, E); }
        }
        __syncthreads();
        p0_queue(F, pa, (unsigned*)(ws + WS_CTL) + CW_TICKET);
    }
    SEAM(1);
    if (IN(2)) { for (int rep = 0; rep < (MK_REP_PHASE == 2 ? 2 : 1); ++rep) p2_gdn(F, PROJ, args.in[3], args.in[4], args.in[5], args.in[6], OG); }
    SEAM(2);
    if (IN(3)) {
        pg8::Gemm g{OG, Wouta_t, GVDIM}; pg8::StaticOrder S; S.init(T, D, F.G, F.bid);
        pg8::EpiResF32 E{x, h, D};
        pg8::gemm_phase<pg8::EpiResF32, pg8::StaticOrder>(F.lds, g, S, E);
        if (MK_REP_PHASE == 3) { __syncthreads(); pg8::gemm_phase<pg8::EpiResF32, pg8::StaticOrder>(F.lds, g, S, E); }
    }
    SEAM(3);
#define MOE_PHASES(layer, pb, XNOUT) \
    if (IN(pb)) for (int rep = 0; rep < ((MK_REP_PHASE == 4 && (layer) == 0) ? 2 : 1); ++rep) p_moe_route(F, h, args.in[15] + (layer) * D, (const float*)(ws + WS_WR) + (size_t)(layer) * D * WRN, args.in[17] + (layer) * NGRP, args.in[19] + (layer) * NE, XN, mb); \
    do { if (IN(pb) && IN((pb) + 2)) xcd_barrier(bar); } while (0); \
    if (IN((pb) + 2)) { pg8::ListOrder S; LAS int* rowtok = (LAS int*)(F.lds + RING_BYTES + 8192); moe_gather_prep(F, mb, 2 * HID / 256, S, rowtok); \
        pg8::Gemm g{XN, Wgu_t + (size_t)(layer) * NE * 2 * HID * D, D}; pg8::EpiSwiGLU E{HB, HID}; \
        pg8::gemm_phase_gather<pg8::EpiSwiGLU, pg8::ListOrder>(F.lds, g, S, E, rowtok); } \
    SEAM((pb) + 2); \
    if (IN((pb) + 3)) { pg8::ListOrder S; moe_units(F, mb, D / 256, S); \
        pg8::Gemm g{HB, Wd_t + (size_t)(layer) * NE * D * HID, HID}; pg8::EpiBf16 E{YS, D}; \
        pg8::gemm_phase<pg8::EpiBf16, pg8::ListOrder>(F.lds, g, S, E); \
        if (MK_REP_PHASE == 7 && (layer) == 0) { __syncthreads(); pg8::gemm_phase<pg8::EpiBf16, pg8::ListOrder>(F.lds, g, S, E); } } \
    SEAM((pb) + 3); \
    if (IN((pb) + 4)) p_moe_combine(F, h, YS, mb, XNOUT);

    MOE_PHASES(0, 4, XN)
    SEAM(8);
    if (IN(9)) {
        pg8::Gemm g{XN, Wkvq_t, D}; pg8::StaticOrder S; S.init(T, KVQ, F.G, F.bid);
        pg8::EpiKvqNorm E{KVQB, args.in[10], args.in[13], (LAS float*)(F.lds + RING_BYTES)};
        pg8::gemm_phase<pg8::EpiKvqNorm, pg8::StaticOrder>(F.lds, g, S, E);
        if (MK_REP_PHASE == 9) { __syncthreads(); pg8::gemm_phase<pg8::EpiKvqNorm, pg8::StaticOrder>(F.lds, g, S, E); }
    }
    do { if (IN(9) && IN(11)) xcd_barrier(bar); } while (0);
    if (IN(11)) { for (int rep = 0; rep < (MK_REP_PHASE == 11 ? 2 : 1); ++rep) p_sb_attn(F, KVQB, AO); }
    SEAM(11);
    if (IN(12)) {
        pg8::Gemm g{AO, Woutb_t, SBDIM}; pg8::StaticOrder S; S.init(T, D, F.G, F.bid);
        pg8::EpiResF32 E{h, h, D};
        pg8::gemm_phase<pg8::EpiResF32, pg8::StaticOrder>(F.lds, g, S, E);
    }
    SEAM(12);
    MOE_PHASES(1, 13, (bf16_t*)nullptr)
#undef MOE_PHASES
#undef IN
#undef SEAM
}

extern "C" void kernel_launch(void* const* d_in, const int* in_sizes, int n_in, void* d_out, int out_size, void* d_ws, size_t ws_size, hipStream_t stream) {
    static int grid = 0;
    if (grid == 0) {
        if (n_in != 23 || out_size != T * D || ws_size < WS_END) { fprintf(stderr, "kernel_launch: unexpected shapes (n_in %d, out %d, ws %zu)\n", n_in, out_size, ws_size); grid = -1; return; }
        int dev = 0, cus = 0, per_cu = 0;
        if (hipGetDevice(&dev) != hipSuccess || hipDeviceGetAttribute(&cus, hipDeviceAttributeMultiprocessorCount, dev) != hipSuccess) { grid = -1; return; }
        if (hipFuncSetAttribute((const void*)yoco_fwd, hipFuncAttributeMaxDynamicSharedMemorySize, LDS_BYTES) != hipSuccess) { fprintf(stderr, "kernel_launch: hipFuncSetAttribute failed\n"); grid = -1; return; }
        if (hipOccupancyMaxActiveBlocksPerMultiprocessor(&per_cu, (const void*)yoco_fwd, 512, LDS_BYTES) != hipSuccess || per_cu < 1) fprintf(stderr, "kernel_launch: occupancy query reports %d\n", per_cu);
        (void)hipGetLastError();
        grid = cus;
        if (grid > 256) grid = 256;
    }
    if (grid < 0) return;
    (void)hipMemsetAsync((char*)d_ws + WS_CTL, 0, CTL_ZERO_BYTES, stream);
    Args a{};
    for (int i = 0; i < 23; ++i) a.in[i] = (const float*)d_in[i];
    a.out = (float*)d_out; a.ws = (unsigned char*)d_ws;
#if MK_ONE_LAUNCH
    a.ph_lo = 0; a.ph_hi = MK_LAST_PHASE;
    hipLaunchKernelGGL(yoco_fwd, dim3(grid), dim3(512), LDS_BYTES, stream, a);
#else
    for (int p = 0; p < MK_LAST_PHASE; ++p) { if (p == 10 || p == 5 || p == 14) continue; a.ph_lo = p; a.ph_hi = p + 1; hipLaunchKernelGGL(yoco_fwd, dim3(grid), dim3(512), LDS_BYTES, stream, a); }
#endif
}
```
